# Optimizing an MI355X kernel written in HIP

```python
import math
import jax, jax.numpy as jnp
from jax import lax
import numpy as np

D_MODEL = 1024
BATCH = 8
SEQ = 4096
DEPTH = 1

MIX_WIDTH = D_MODEL
FOURIER_WIDTH = MIX_WIDTH // 2
N_FOURIER_GROUPS = 4
FOURIER_GROUP = FOURIER_WIDTH // N_FOURIER_GROUPS
N_DIFF_HEADS = 4
DIFF_V_DIM = (MIX_WIDTH - FOURIER_WIDTH) // N_DIFF_HEADS
DIFF_QK_DIM = DIFF_V_DIM // 2
Q_WIDTH = N_DIFF_HEADS * 2 * DIFF_QK_DIM
V_WIDTH = N_DIFF_HEADS * DIFF_V_DIM
IN_COLS = FOURIER_WIDTH + 2 * Q_WIDTH + V_WIDTH
Q_BLOCK = 128
N_BUCKETS = 32
MAX_DISTANCE = 128
N_EXPERTS = 32
TOP_K = 4
D_FF = D_MODEL
SWIGLU_ALPHA = 1.702
SWIGLU_LIMIT = 7.0
MOE_BLOCK = 128
EPS = 1e-6

kernel_name = "hybrid_fourier_diffattn_moe_block"


def rmsnorm(x, g):
    xf = x.astype(jnp.float32)
    y = xf * lax.rsqrt(jnp.mean(xf * xf, axis=-1, keepdims=True) + EPS)
    return (y * g.astype(jnp.float32)).astype(x.dtype)


def modulate(h, shift, scale):
    return h * (1 + scale[:, None, :]) + shift[:, None, :]


def t5_bucket(rel):
    nb = N_BUCKETS // 2
    ret = jnp.where(rel > 0, nb, 0)
    n = jnp.abs(rel)
    max_exact = nb // 2
    nf = jnp.maximum(n, 1).astype(jnp.float32)
    large = max_exact + (jnp.log(nf / max_exact) / math.log(MAX_DISTANCE / max_exact)
                         * (nb - max_exact)).astype(jnp.int32)
    large = jnp.minimum(large, nb - 1)
    return ret + jnp.where(n < max_exact, n, large)


def fourier_mix(u, w_f):
    B, S, _ = u.shape
    ug = u.reshape(B, S, N_FOURIER_GROUPS, FOURIER_GROUP).astype(jnp.float32)
    f = jnp.fft.fftn(ug, axes=(1, 3), norm="ortho").real
    y = jnp.einsum("bsgc,gcd->bsgd", f.astype(u.dtype), w_f)
    return y.reshape(B, S, FOURIER_WIDTH)


def diff_attention(q, k, v, rel_bias, lam, lam_init, g_subln):
    B, S = q.shape[0], q.shape[1]
    H, dqk, dv = N_DIFF_HEADS, DIFF_QK_DIM, DIFF_V_DIM
    scale = dqk ** -0.5
    qh = q.transpose(3, 0, 2, 1, 4)
    kh = k.transpose(3, 0, 2, 1, 4)
    vh = v.transpose(0, 2, 1, 3)
    nqb = S // Q_BLOCK
    qb = qh.reshape(2, B, H, nqb, Q_BLOCK, dqk).transpose(3, 0, 1, 2, 4, 5)
    kpos = jnp.arange(S, dtype=jnp.int32)

    def block(args):
        qblk, start = args
        qpos = start + jnp.arange(Q_BLOCK, dtype=jnp.int32)
        bucket = t5_bucket(kpos[None, :] - qpos[:, None])
        bias = jnp.take(rel_bias, bucket, axis=0).astype(jnp.float32)
        bias = bias.transpose(2, 0, 1)
        logits = jnp.einsum("mbhqd,mbhkd->mbhqk", qblk, kh).astype(jnp.float32) * scale + bias
        p = jax.nn.softmax(logits, axis=-1)
        a = p[0] - lam * p[1]
        return jnp.einsum("bhqk,bhkd->bhqd", a.astype(vh.dtype), vh)

    starts = jnp.arange(nqb, dtype=jnp.int32) * Q_BLOCK
    o = lax.map(block, (qb, starts))
    o = o.transpose(1, 0, 3, 2, 4).reshape(B, S, H, dv)
    o = rmsnorm(o, g_subln) * (1.0 - lam_init)
    return o.reshape(B, S, H * dv)


def clamped_swiglu(z):
    z_glu = jnp.minimum(z[..., ::2], SWIGLU_LIMIT)
    z_lin = jnp.clip(z[..., 1::2], -SWIGLU_LIMIT, SWIGLU_LIMIT)
    return z_glu * jax.nn.sigmoid(SWIGLU_ALPHA * z_glu) * (z_lin + 1)


def moe(h, w_router, b_router, w1, b1, w2, b2):
    B, S, D = h.shape
    T = B * S
    ht = h.reshape(T, D)
    logits = (ht @ w_router + b_router).astype(jnp.float32)
    top_vals, top_idx = lax.top_k(logits, TOP_K)
    gates = jax.nn.softmax(top_vals, axis=-1)
    A = T * TOP_K
    e_flat = top_idx.reshape(A).astype(jnp.int32)
    g_flat = gates.reshape(A)
    tok_flat = jnp.repeat(jnp.arange(T, dtype=jnp.int32), TOP_K)
    order = jnp.argsort(e_flat)
    e_sorted = e_flat[order]
    tok_sorted = tok_flat[order]
    g_sorted = g_flat[order]
    counts = jnp.zeros((N_EXPERTS,), jnp.int32).at[e_flat].add(1)
    padded = (counts + MOE_BLOCK - 1) // MOE_BLOCK * MOE_BLOCK
    starts = jnp.cumsum(counts) - counts
    pstarts = jnp.cumsum(padded) - padded
    pends = jnp.cumsum(padded)
    rank = jnp.arange(A, dtype=jnp.int32) - starts[e_sorted]
    dest = pstarts[e_sorted] + rank
    P = A + N_EXPERTS * MOE_BLOCK
    nblk = P // MOE_BLOCK
    slot_tok = jnp.full((P,), T, jnp.int32).at[dest].set(tok_sorted)
    slot_gate = jnp.zeros((P,), jnp.float32).at[dest].set(g_sorted)
    blk_start = jnp.arange(nblk, dtype=jnp.int32) * MOE_BLOCK
    blk_expert = jnp.minimum(jnp.searchsorted(pends, blk_start, side="right"), N_EXPERTS - 1).astype(jnp.int32)
    h_pad = jnp.concatenate([ht, jnp.zeros((1, D), ht.dtype)], axis=0)

    def expert_block(args):
        tok, gate, e = args
        xb = h_pad[tok]
        z = xb @ w1[e] + b1[e]
        y = clamped_swiglu(z) @ w2[e] + b2[e]
        return y * gate[:, None].astype(y.dtype)

    y_slots = lax.map(expert_block, (slot_tok.reshape(nblk, MOE_BLOCK),
                                     slot_gate.reshape(nblk, MOE_BLOCK), blk_expert))
    out = jnp.zeros((T + 1, D), y_slots.dtype).at[slot_tok].add(y_slots.reshape(P, D))
    return out[:T].reshape(B, S, D).astype(h.dtype)


def setup_inputs(seed: int = 0) -> dict:
    key = jax.random.key(seed)
    ks = jax.random.split(key, 24)
    f32 = jnp.float32
    L, D = DEPTH, D_MODEL
    nrm = lambda k, shape, s: jax.random.normal(k, shape, f32) * s
    return {
        "x": nrm(ks[0], (BATCH, SEQ, D), 1.0),
        "c": nrm(ks[1], (BATCH, D), 1.0),
        "w_ada": nrm(ks[2], (L, D, 6 * D), D ** -0.5),
        "b_ada": nrm(ks[3], (L, 6 * D), 0.1),
        "g_mix": 1.0 + nrm(ks[4], (L, D), 0.05),
        "w_in": nrm(ks[5], (L, D, IN_COLS), D ** -0.5),
        "w_fourier": nrm(ks[6], (L, N_FOURIER_GROUPS, FOURIER_GROUP, FOURIER_GROUP), FOURIER_GROUP ** -0.5),
        "q_norm_g": 1.0 + nrm(ks[7], (L, DIFF_QK_DIM), 0.05),
        "k_norm_g": 1.0 + nrm(ks[8], (L, DIFF_QK_DIM), 0.05),
        "lambda_q1": nrm(ks[9], (L, DIFF_QK_DIM), 0.1),
        "lambda_k1": nrm(ks[10], (L, DIFF_QK_DIM), 0.1),
        "lambda_q2": nrm(ks[11], (L, DIFF_QK_DIM), 0.1),
        "lambda_k2": nrm(ks[12], (L, DIFF_QK_DIM), 0.1),
        "g_subln": 1.0 + nrm(ks[13], (L, DIFF_V_DIM), 0.05),
        "w_out": nrm(ks[14], (L, MIX_WIDTH, D), MIX_WIDTH ** -0.5),
        "rel_bias": nrm(ks[15], (N_BUCKETS, N_DIFF_HEADS), 0.5),
        "g_ffn": 1.0 + nrm(ks[16], (L, D), 0.05),
        "w_router": nrm(ks[17], (L, D, N_EXPERTS), D ** -0.5),
        "b_router": nrm(ks[18], (L, N_EXPERTS), 0.01),
        "w1": nrm(ks[19], (L, N_EXPERTS, D, 2 * D_FF), D ** -0.5),
        "b1": nrm(ks[20], (L, N_EXPERTS, 2 * D_FF), 0.02),
        "w2": nrm(ks[21], (L, N_EXPERTS, D_FF, D), D_FF ** -0.5),
        "b2": nrm(ks[22], (L, N_EXPERTS, D), 0.02),
    }


def reference(x, c, w_ada, b_ada, g_mix, w_in, w_fourier, q_norm_g, k_norm_g,
              lambda_q1, lambda_k1, lambda_q2, lambda_k2, g_subln, w_out, rel_bias,
              g_ffn, w_router, b_router, w1, b1, w2, b2):
    B, S, D = x.shape
    cond = jax.nn.silu(c)
    f0 = FOURIER_WIDTH
    f1 = f0 + Q_WIDTH
    f2 = f1 + Q_WIDTH
    for l in range(DEPTH):
        mod = cond @ w_ada[l] + b_ada[l]
        sh_a, sc_a, gt_a, sh_f, sc_f, gt_f = jnp.split(mod, 6, axis=-1)
        h = modulate(rmsnorm(x, g_mix[l]), sh_a, sc_a)
        proj = h @ w_in[l]
        u_f = proj[..., :f0]
        q = proj[..., f0:f1].reshape(B, S, N_DIFF_HEADS, 2, DIFF_QK_DIM)
        k = proj[..., f1:f2].reshape(B, S, N_DIFF_HEADS, 2, DIFF_QK_DIM)
        v = proj[..., f2:].reshape(B, S, N_DIFF_HEADS, DIFF_V_DIM)
        q = rmsnorm(q, q_norm_g[l])
        k = rmsnorm(k, k_norm_g[l])
        lam_init = 0.8 - 0.6 * math.exp(-0.3 * l)
        lam = (jnp.exp(jnp.sum(lambda_q1[l].astype(jnp.float32) * lambda_k1[l].astype(jnp.float32)))
               - jnp.exp(jnp.sum(lambda_q2[l].astype(jnp.float32) * lambda_k2[l].astype(jnp.float32)))
               + lam_init)
        y_f = fourier_mix(u_f, w_fourier[l])
        y_d = diff_attention(q, k, v, rel_bias, lam, lam_init, g_subln[l])
        mix = jnp.concatenate([y_f, y_d], axis=-1) @ w_out[l]
        x = x + gt_a[:, None, :] * mix
        h = modulate(rmsnorm(x, g_ffn[l]), sh_f, sc_f)
        y = moe(h, w_router[l], b_router[l], w1[l], b1[l], w2[l], b2[l])
        x = x + gt_f[:, None, :] * y
    return x
```

```cpp
#include <hip/hip_runtime.h>
#include <cstdio>
#include <cstdint>
#include <cmath>

#define LAS __attribute__((address_space(3)))
#define GAS __attribute__((address_space(1)))
typedef unsigned short bf16_t;
typedef short bf16x8 __attribute__((ext_vector_type(8)));
typedef short s16x4 __attribute__((ext_vector_type(4)));
typedef float f32x4 __attribute__((ext_vector_type(4)));
typedef float f32x2 __attribute__((ext_vector_type(2)));
typedef float f32x16 __attribute__((ext_vector_type(16)));
typedef unsigned u32x4 __attribute__((ext_vector_type(4)));
typedef unsigned u32x2 __attribute__((ext_vector_type(2)));
typedef GAS unsigned gu32;

#ifndef MK_SPLIT
#define MK_SPLIT 1
#endif

constexpr int NB = 8, SEQ = 4096, DM = 1024, NTOK = NB * SEQ;
constexpr int NEXP = 32, TOPK = 4, DFF = 1024, CAP = NTOK;
constexpr int NQKV = 1536;
constexpr int HSEQ = SEQ / 2;
constexpr float EPS = 1e-6f;
constexpr float LOG2E = 1.4426950408889634f;
constexpr float QSCALE = 0.125f * LOG2E;
constexpr float LAM_INIT = 0.2f;
constexpr int MAXTILES = (NTOK * TOPK) / 256 + NEXP;

constexpr size_t MiB = 1u << 20;
constexpr size_t WS_CTL = 0, CTL_ZERO_BYTES = 1 * MiB;
constexpr size_t WS_MOD = 1 * MiB;
constexpr size_t WS_VR = WS_MOD + 256 * 1024;
constexpr size_t WS_BTAB = WS_MOD + 320 * 1024;
constexpr size_t WS_B1P = WS_MOD + 512 * 1024;
constexpr size_t WS_TOKSLOT = 2 * MiB;
constexpr size_t WS_SLOTTOK = 4 * MiB;
constexpr size_t WS_SLOTGATE = 8 * MiB;
constexpr size_t WS_WQKV = 12 * MiB;
constexpr size_t WS_WCS = 15 * MiB;
constexpr size_t WS_WOUT = 17 * MiB;
constexpr size_t WS_ADFT = 20 * MiB;
constexpr size_t WS_W1 = 52 * MiB;
constexpr size_t WS_W2 = 180 * MiB;
constexpr size_t WS_XN = 256 * MiB;
constexpr size_t WS_XNSA = 320 * MiB;
constexpr size_t WS_Q = 384 * MiB, WS_K = 416 * MiB, WS_V = 448 * MiB;
constexpr size_t WS_BDFT = 480 * MiB;
constexpr size_t WS_AMIX = 512 * MiB;
constexpr size_t WS_ACT = 256 * MiB;
constexpr size_t WS_XN2 = 576 * MiB;
constexpr size_t WS_SLAB = 640 * MiB;
constexpr size_t WS_END = 912 * MiB;
static_assert(WS_ACT + (size_t)MAXTILES * 256 * 1024 * 2 <= WS_XN2 && WS_SLAB + (size_t)MAXTILES * 256 * 1024 * 2 <= WS_END, "d_ws map");
constexpr int CW_BAR = 4096;
constexpr int CW_GCNT = 8192;

constexpr int RING_BYTES = 131072;
constexpr int SP_OFF = RING_BYTES;
constexpr int SP_MISC = SP_OFF;
constexpr int SP_TSTART = SP_OFF + 256;
constexpr int SP_CNT = SP_OFF + 512;
constexpr int SP_TILEE = SP_OFF + 768;
constexpr int SP_BT = SP_OFF + 2048;
constexpr int SP_WS = SP_OFF + 3072;
constexpr int LDS_BYTES = 147456;
constexpr int NWAVES = 8;

__device__ __forceinline__ unsigned cvt_pk_bf16(float lo, float hi) { unsigned r; asm volatile("v_cvt_pk_bf16_f32 %0, %1, %2" : "=v"(r) : "v"(lo), "v"(hi)); return r; }
__device__ __forceinline__ float bf2f(unsigned short h) { return __uint_as_float((unsigned)h << 16); }
__device__ __forceinline__ float wave_sum(float v) {
#pragma unroll
    for (int o = 1; o < 64; o <<= 1) v += __shfl_xor(v, o);
    return v;
}
#define LDS_WAIT() asm volatile("s_waitcnt lgkmcnt(0)" ::: "memory")
#define VM_WAIT() asm volatile("s_waitcnt vmcnt(0)" ::: "memory")
#define RLX_AGENT __ATOMIC_RELAXED, __HIP_MEMORY_SCOPE_AGENT

namespace pg8 {
constexpr int BM = 256, BK = 64, HALF = 128, HTB = HALF * BK * 2, STAGE_BYTES = 8 * HTB, NXCD = 8, WGM = 8;
__host__ __device__ __forceinline__ int lds_byte(int r, int c) { const int st = (r >> 4) * 2 + (c >> 5), rr = r & 15, cc = c & 31, ob = rr * 64 + cc * 2; return st * 1024 + (ob ^ (((ob >> 9) & 1) << 5)); }
__host__ __device__ __forceinline__ void stage_rc(int b, int& R, int& C) { const int st = b / 1024, sb = b % 1024, swz = sb ^ (((sb >> 9) & 1) << 5); R = (st >> 1) * 16 + swz / 64; C = (st & 1) * 32 + (swz % 64) / 2; }
__host__ __device__ __forceinline__ int perm32(int rho) { const int n = rho >> 4, i = rho & 15; return 8 * (i >> 2) + 4 * n + (i & 3); }
struct Unit { int pm, pn; };

__device__ __forceinline__ bool static_unit(int i, int G, int c, int nM, int nN, Unit& u) {
    const int nwg = nM * nN; const long L = (long)i * G + c; if (L >= nwg) return false;
    int wgid = (int)L; { const int q = nwg / NXCD, r = nwg % NXCD, xcd = wgid % NXCD, off = wgid / NXCD; wgid = (xcd < r ? xcd * (q + 1) : r * (q + 1) + (xcd - r) * q) + off; }
    const int nig = WGM * nN, gid = wgid / nig, fm = gid * WGM, gsz = (nM - fm) < WGM ? (nM - fm) : WGM;
    u.pm = fm + ((wgid % nig) % gsz); u.pn = (wgid % nig) / gsz; return true;
}

template <class Epi, class Sched>
__device__ __forceinline__ void gemm_phase(LAS unsigned char* lds, const int K, const Sched& S, const Epi& E) {
    const int tid = threadIdx.x, wid = __builtin_amdgcn_readfirstlane(tid >> 6), lane = tid & 63, wr = wid >> 2, wc = wid & 3, fr = lane & 15, fq = lane >> 4;
    const int nt = K / BK;
    unsigned voffA[2], voffB[2]; int RA[2], CA[2];
#pragma unroll
    for (int i = 0; i < 2; ++i) { int R, C; stage_rc(tid * 16 + i * 8192, R, C); const int Rb = Epi::PERM ? ((R & ~31) + perm32(R & 31)) : R;
        voffA[i] = (unsigned)(R * K + C) * 2u; voffB[i] = (unsigned)(Rb * K + C) * 2u; RA[i] = R; CA[i] = C; }
    const size_t kstep = (size_t)(BK * 2);
    const size_t hstep = (size_t)HALF * K * 2;
    const unsigned ldsw = (unsigned)wid * 1024u;
    const int aoff = lds_byte(wr * 64 + fr, fq * 8), boff = lds_byte(wc * 32 + fr, fq * 8);
    unsigned cvo[2][2], nvo[2][2];
#define PG8_SA(b, h) (((b) * 2 + (h)) * HTB)
#define PG8_SB(b, h) ((4 + (b) * 2 + (h)) * HTB)
#define PG8_STAGE(bufoff, gbase, voff) do { _Pragma("unroll") for (int _i = 0; _i < 2; ++_i) \
        __builtin_amdgcn_global_load_lds((const unsigned*)((const char*)(gbase) + (voff)[_i]), (LAS unsigned*)(lds + (bufoff) + ldsw + _i * 8192), 16, 0, 0); } while (0)
#define PG8_STAGE_A(bufoff, ab, kb, h, nx) do { if constexpr (Sched::GATHER) { _Pragma("unroll") for (int _i = 0; _i < 2; ++_i) \
        __builtin_amdgcn_global_load_lds((const unsigned*)((ab) + (kb) + ((nx) ? nvo[h][_i] : cvo[h][_i])), (LAS unsigned*)(lds + (bufoff) + ldsw + _i * 8192), 16, 0, 0); } \
        else { PG8_STAGE(bufoff, (ab) + (kb) + (h) * hstep, voffA); } } while (0)
#define PG8_LDA(dst, b, h) do { _Pragma("unroll") for (int m = 0; m < 4; ++m) _Pragma("unroll") for (int k = 0; k < 2; ++k) dst[m][k] = *(const LAS bf16x8*)(lds + PG8_SA(b, h) + aoff + m * 2048 + k * 1024); } while (0)
#define PG8_LDB(dst, b, h) do { _Pragma("unroll") for (int n = 0; n < 2; ++n) _Pragma("unroll") for (int k = 0; k < 2; ++k) dst[n][k] = *(const LAS bf16x8*)(lds + PG8_SB(b, h) + boff + n * 2048 + k * 1024); } while (0)
#define PG8_MMA(ai, bj, At, Bt) do { __builtin_amdgcn_s_setprio(1); _Pragma("unroll") for (int m = 0; m < 4; ++m) _Pragma("unroll") for (int n = 0; n < 2; ++n) _Pragma("unroll") for (int k = 0; k < 2; ++k) \
        acc[ai][bj][m][n] = __builtin_amdgcn_mfma_f32_16x16x32_bf16(Bt[n][k], At[m][k], acc[ai][bj][m][n], 0, 0, 0); __builtin_amdgcn_s_setprio(0); } while (0)
#define PG8_WAIT_V(n) asm volatile("s_waitcnt vmcnt(" #n ")" ::: "memory")
#define PG8_WAIT_L(n) asm volatile("s_waitcnt lgkmcnt(" #n ")" ::: "memory")
#define PG8_BAR __builtin_amdgcn_s_barrier()
#define PG8_SCHED __builtin_amdgcn_sched_barrier(0)
    Unit cur, nxt; int ui = 0;
    if (!S.next(0, cur)) return;
    f32x4 acc[2][2][4][2];
#pragma unroll
    for (int a = 0; a < 2; ++a)
#pragma unroll
        for (int b = 0; b < 2; ++b)
#pragma unroll
            for (int m = 0; m < 4; ++m)
#pragma unroll
                for (int n = 0; n < 2; ++n) acc[a][b][m][n] = (f32x4){0.f, 0.f, 0.f, 0.f};
    bf16x8 At[4][2], B0[2][2], B1[2][2];
    const char* cA = S.a_ptr(cur); const char* cB = S.b_ptr(cur);
    if constexpr (Sched::GATHER) { int r[4]; S.a_rows(cur, RA[0], RA[1], r);
#pragma unroll
        for (int h = 0; h < 2; ++h)
#pragma unroll
            for (int i = 0; i < 2; ++i) { cvo[h][i] = (unsigned)(r[2 * h + i] * K + CA[i]) * 2u; nvo[h][i] = cvo[h][i]; } }
    PG8_STAGE(PG8_SB(0, 0), cB, voffB); PG8_STAGE(PG8_SB(0, 1), cB + hstep, voffB); PG8_STAGE_A(PG8_SA(0, 0), cA, 0, 0, false); PG8_STAGE_A(PG8_SA(0, 1), cA, 0, 1, false);
    if (wr == 1) PG8_BAR;
    PG8_WAIT_V(2); PG8_BAR;
    PG8_STAGE(PG8_SB(1, 0), cB + kstep, voffB); PG8_STAGE_A(PG8_SA(1, 0), cA, kstep, 0, false); PG8_STAGE(PG8_SB(1, 1), cB + hstep + kstep, voffB);
    PG8_WAIT_V(6); PG8_BAR;
    for (;;) {
        const bool has_next = S.next(ui + 1, nxt);
        const char* nA = has_next ? S.a_ptr(nxt) : cA; const char* nB = has_next ? S.b_ptr(nxt) : cB;
        if constexpr (Sched::GATHER) { if (has_next) { int r[4]; S.a_rows(nxt, RA[0], RA[1], r);
#pragma unroll
            for (int h = 0; h < 2; ++h)
#pragma unroll
                for (int i = 0; i < 2; ++i) nvo[h][i] = (unsigned)(r[2 * h + i] * K + CA[i]) * 2u; } }
        for (int t = 0; t < nt; t += 2) {
            const bool last = (t == nt - 2);
            const size_t k1 = (size_t)(t + 1) * kstep;
            const char* a2 = last ? nA : cA; const size_t k2 = last ? 0 : (size_t)(t + 2) * kstep; const char* b2 = last ? nB : cB + (size_t)(t + 2) * kstep;
            const size_t k3 = k2 + kstep; const char* b3 = b2 + kstep;
            PG8_LDB(B0, 0, 0); PG8_LDB(B1, 0, 1); PG8_SCHED; PG8_LDA(At, 0, 0); PG8_STAGE_A(PG8_SA(1, 1), cA, k1, 1, false);
            PG8_WAIT_V(8); PG8_WAIT_L(0); PG8_BAR; PG8_MMA(0, 0, At, B0); PG8_MMA(0, 1, At, B1); PG8_BAR; PG8_SCHED;
            PG8_LDA(At, 0, 1); PG8_STAGE(PG8_SB(0, 0), b2, voffB); PG8_STAGE(PG8_SB(0, 1), b2 + hstep, voffB); PG8_STAGE_A(PG8_SA(0, 0), a2, k2, 0, last);
            PG8_WAIT_V(8); PG8_WAIT_L(0); PG8_BAR; PG8_MMA(1, 0, At, B0); PG8_MMA(1, 1, At, B1); PG8_BAR; PG8_SCHED;
            PG8_LDB(B0, 1, 0); PG8_LDB(B1, 1, 1); PG8_SCHED; PG8_LDA(At, 1, 0); PG8_STAGE_A(PG8_SA(0, 1), a2, k2, 1, last);
            PG8_WAIT_V(8); PG8_WAIT_L(0); PG8_BAR; PG8_MMA(0, 0, At, B0); PG8_MMA(0, 1, At, B1); PG8_BAR; PG8_SCHED;
            PG8_LDA(At, 1, 1); PG8_STAGE(PG8_SB(1, 0), b3, voffB); PG8_STAGE(PG8_SB(1, 1), b3 + hstep, voffB); PG8_STAGE_A(PG8_SA(1, 0), a2, k3, 0, last);
            PG8_WAIT_V(8); PG8_WAIT_L(0); PG8_BAR; PG8_MMA(1, 0, At, B0); PG8_MMA(1, 1, At, B1); PG8_BAR; PG8_SCHED;
        }
        if (wr == 0) PG8_BAR;
        E(acc, cur, wr, wc, fr, fq);
        if (!has_next) break;
#pragma unroll
        for (int a = 0; a < 2; ++a)
#pragma unroll
            for (int b = 0; b < 2; ++b)
#pragma unroll
                for (int m = 0; m < 4; ++m)
#pragma unroll
                    for (int n = 0; n < 2; ++n) acc[a][b][m][n] = (f32x4){0.f, 0.f, 0.f, 0.f};
        cur = nxt; cA = nA; cB = nB; ++ui;
        if constexpr (Sched::GATHER) {
#pragma unroll
            for (int h = 0; h < 2; ++h)
#pragma unroll
                for (int i = 0; i < 2; ++i) cvo[h][i] = nvo[h][i]; }
        if (wr == 1) PG8_BAR;
    }
    PG8_WAIT_V(0);
    PG8_BAR;
#undef PG8_SA
#undef PG8_SB
#undef PG8_STAGE
#undef PG8_STAGE_A
#undef PG8_LDA
#undef PG8_LDB
#undef PG8_MMA
#undef PG8_WAIT_V
#undef PG8_WAIT_L
#undef PG8_BAR
#undef PG8_SCHED
}
}

#define XB_TMO      128
#define XB_XCNT(j)  (256  + 64 * (j))
#define XB_XSUB(j)  (1280 + 64 * (j))
#define XB_XGEN(j)  (2304 + 64 * (j))
#define XB_TOP      3328
#define XB_TOPGEN   3392
#define XCD_BAR_WORDS 3456
#define XB_SPIN_CAP (1u << 20)
__device__ __forceinline__ unsigned xb_ld(unsigned* p)              { return __hip_atomic_load(p, __ATOMIC_RELAXED, __HIP_MEMORY_SCOPE_AGENT); }
__device__ __forceinline__ unsigned xb_add(unsigned* p, unsigned v) { return __hip_atomic_fetch_add(p, v, __ATOMIC_RELAXED, __HIP_MEMORY_SCOPE_AGENT); }
__device__ __forceinline__ unsigned xb_xcc_id() { return (unsigned)__builtin_amdgcn_s_getreg((3 << 11) | 20) & 0xFu; }
#define XB_SPIN(cond, bar) do { unsigned _sp = 0; while (cond) { __builtin_amdgcn_s_sleep(1); \
    if ((++_sp & 255u) == 0u) { if (xb_ld(&(bar)[XB_TMO])) break; if (_sp > XB_SPIN_CAP) { atomicAdd(&(bar)[XB_TMO], 1u); break; } } } } while (0)
struct XcdBarrier { unsigned* bar; unsigned x; volatile LAS unsigned* st; };
__device__ __forceinline__ XcdBarrier xcd_barrier_post(unsigned* bar, volatile LAS unsigned* st) {
    XcdBarrier b; b.bar = bar; b.x = xb_xcc_id(); b.st = st;
    if (threadIdx.x == 0) (void)xb_add(&bar[XB_XCNT(b.x)], 1u);
    return b;
}
__device__ __forceinline__ void xcd_barrier_complete(unsigned* bar, unsigned x, unsigned& nloc, unsigned& nx) {
    const unsigned G = gridDim.x * gridDim.y * gridDim.z;
    unsigned sum, cnt, mine, sp = 0u;
    for (;;) {
        sum = 0u; cnt = 0u; mine = 0u;
#pragma unroll
        for (unsigned j = 0; j < 16; ++j) { const unsigned c = xb_ld(&bar[XB_XCNT(j)]); sum += c; cnt += (c > 0u) ? 1u : 0u; mine = (j == x) ? c : mine; }
        if (sum == G) break;
        __builtin_amdgcn_s_sleep(1);
        if ((++sp & 255u) == 0u) { if (xb_ld(&bar[XB_TMO])) break; if (sp > XB_SPIN_CAP) { atomicAdd(&bar[XB_TMO], 1u); break; } }
    }
    nloc = mine > 0u ? mine : 1u; nx = cnt > 0u ? cnt : 1u;
}
__device__ __forceinline__ void xcd_barrier(const XcdBarrier& b) {
    asm volatile("s_waitcnt vmcnt(0)" ::: "memory");
    __syncthreads();
    if (threadIdx.x == 0) {
        unsigned* bar = b.bar;
        __builtin_amdgcn_s_waitcnt(0);
        unsigned nloc = b.st[0], nx = b.st[1];
        if (nloc == 0u) { xcd_barrier_complete(bar, b.x, nloc, nx); b.st[0] = nloc; b.st[1] = nx; }
        const unsigned old = xb_add(&bar[XB_XSUB(b.x)], 1u);
        const unsigned gen = old / nloc;
        if (old + 1u == (gen + 1u) * nloc) {
            __builtin_amdgcn_fence(__ATOMIC_RELEASE, "agent");
            asm volatile("s_waitcnt vmcnt(0)" ::: "memory");
            const unsigned og = xb_add(&bar[XB_TOP], 1u);
            const unsigned tg = og / nx;
            if (og + 1u == (tg + 1u) * nx) xb_add(&bar[XB_TOPGEN], 1u);
            else XB_SPIN(xb_ld(&bar[XB_TOPGEN]) == tg, bar);
            __builtin_amdgcn_fence(__ATOMIC_ACQUIRE, "agent");
            xb_add(&bar[XB_XGEN(b.x)], 1u);
            asm volatile("s_waitcnt vmcnt(0)" ::: "memory");
        } else {
            XB_SPIN(xb_ld(&bar[XB_XGEN(b.x)]) == gen, bar);
            __builtin_amdgcn_fence(__ATOMIC_ACQUIRE, "agent");
            asm volatile("s_waitcnt vmcnt(0)" ::: "memory");
        }
    }
    __syncthreads();
}

struct Frame {
    LAS unsigned char* lds;
    volatile LAS unsigned* MISC;
    unsigned* ctl;
    int tid, lane, wave, vcu, G;
    const float *x, *c, *w_ada, *b_ada, *g_mix, *w_in, *w_fourier, *q_norm_g, *k_norm_g, *lq1, *lk1, *lq2, *lk2, *g_subln, *w_out, *rel_bias,
                *g_ffn, *w_router, *b_router, *w1, *b1, *w2, *b2;
    float* out;
    unsigned char* ws;
};
template <class T> __device__ __forceinline__ T* wsp(const Frame& F, size_t off) { return (T*)(F.ws + off); }

struct SchedPlain {
    static constexpr bool GATHER = false;
    const char* A; const char* Bt; int nM, nN, G, c; size_t tstep;
    __device__ __forceinline__ bool next(int i, pg8::Unit& u) const { return pg8::static_unit(i, G, c, nM, nN, u); }
    __device__ __forceinline__ const char* a_ptr(const pg8::Unit& u) const { return A + (size_t)u.pm * tstep; }
    __device__ __forceinline__ const char* b_ptr(const pg8::Unit& u) const { return Bt + (size_t)u.pn * tstep; }
    __device__ __forceinline__ void a_rows(const pg8::Unit&, int, int, int (&r)[4]) const { r[0] = r[1] = r[2] = r[3] = 0; }
};
struct SchedFourier {
    static constexpr bool GATHER = false;
    const char* A; const char* Bt; int G, c; size_t tstep;
    __device__ __forceinline__ bool next(int i, pg8::Unit& u) const {
        const int L = i * G + c; if (L >= 256) return false;
        const int w = (L % 8) * 32 + L / 8;
        const int half = w >> 7, r = w & 127; u.pm = 2 * half + (r & 1); u.pn = 64 * half + (r >> 1); return true; }
    __device__ __forceinline__ const char* a_ptr(const pg8::Unit& u) const { return A + (size_t)u.pm * tstep; }
    __device__ __forceinline__ const char* b_ptr(const pg8::Unit& u) const { return Bt + (size_t)u.pn * tstep; }
    __device__ __forceinline__ void a_rows(const pg8::Unit&, int, int, int (&r)[4]) const { r[0] = r[1] = r[2] = r[3] = 0; }
};
template <bool GATHER_> struct SchedMoe {
    static constexpr bool GATHER = GATHER_;
    const char* A; const char* Bt; int nM, nN, G, c; size_t a_tstep, b_tstep, e_stride;
    const LAS unsigned char* tile_e; const LAS int* tstart; const LAS int* cnt; const unsigned* slot_tok;
    __device__ __forceinline__ bool next(int i, pg8::Unit& u) const { return pg8::static_unit(i, G, c, nM, nN, u); }
    __device__ __forceinline__ const char* a_ptr(const pg8::Unit& u) const { return GATHER_ ? A : A + (size_t)u.pm * a_tstep; }
    __device__ __forceinline__ const char* b_ptr(const pg8::Unit& u) const { const int e = tile_e[u.pm]; return Bt + (size_t)e * e_stride + (size_t)u.pn * b_tstep; }
    __device__ __forceinline__ void a_rows(const pg8::Unit& u, int R0, int R1, int (&r)[4]) const {
        const int e = tile_e[u.pm]; const int s0 = (u.pm - tstart[e]) * 256, n = cnt[e];
#pragma unroll
        for (int h = 0; h < 2; ++h)
#pragma unroll
            for (int i = 0; i < 2; ++i) { const int s = s0 + h * 128 + (i ? R1 : R0); r[2 * h + i] = (s < n) ? (int)slot_tok[(size_t)e * CAP + s] : 0; }
    }
};

typedef const f32x4 (&AccRef)[2][2][4][2];
__device__ __forceinline__ u32x4 pack8(f32x4 a, f32x4 b) { u32x4 w; w.x = cvt_pk_bf16(a[0], a[1]); w.y = cvt_pk_bf16(a[2], a[3]); w.z = cvt_pk_bf16(b[0], b[1]); w.w = cvt_pk_bf16(b[2], b[3]); return w; }

struct EpiQKV {
    static constexpr bool PERM = true;
    bf16_t *Q, *Kb, *V; const float *gq, *gk;
    __device__ __forceinline__ void operator()(AccRef acc, const pg8::Unit& u, int wr, int wc, int fr, int fq) const {
        const int sec = u.pn >> 1, row0 = u.pm * 256 + wr * 64 + fr;
        if (sec < 2) {
            bf16_t* O = sec == 0 ? Q : Kb; const float* g = sec == 0 ? gq : gk; const float sc = sec == 0 ? QSCALE : 1.0f;
            f32x4 gl[2][2];
#pragma unroll
            for (int bj = 0; bj < 2; ++bj)
#pragma unroll
                for (int n = 0; n < 2; ++n) gl[bj][n] = *(const f32x4*)(g + 32 * bj + 8 * fq + 4 * n);
#pragma unroll
            for (int ai = 0; ai < 2; ++ai)
#pragma unroll
                for (int m = 0; m < 4; ++m) {
                    float ss = 0.f;
#pragma unroll
                    for (int bj = 0; bj < 2; ++bj)
#pragma unroll
                        for (int n = 0; n < 2; ++n) { const f32x4 v = acc[ai][bj][m][n]; ss += (v[0] * v[0] + v[1] * v[1]) + (v[2] * v[2] + v[3] * v[3]); }
                    ss += __shfl_xor(ss, 16); ss += __shfl_xor(ss, 32);
                    const float rr = rsqrtf(ss * (1.0f / 64.0f) + EPS) * sc;
                    bf16_t* rowp = O + (size_t)(row0 + ai * 128 + m * 16) * 512 + (u.pn & 1) * 256 + 64 * wc + 8 * fq;
#pragma unroll
                    for (int bj = 0; bj < 2; ++bj) *(u32x4*)(rowp + 32 * bj) = pack8(acc[ai][bj][m][0] * rr * gl[bj][0], acc[ai][bj][m][1] * rr * gl[bj][1]);
                }
        } else {
#pragma unroll
            for (int ai = 0; ai < 2; ++ai)
#pragma unroll
                for (int m = 0; m < 4; ++m) { bf16_t* rowp = V + (size_t)(row0 + ai * 128 + m * 16) * 512 + (u.pn & 1) * 256 + 32 * wc + 8 * fq;
#pragma unroll
                    for (int bj = 0; bj < 2; ++bj) *(u32x4*)(rowp + 128 * bj) = pack8(acc[ai][bj][m][0], acc[ai][bj][m][1]); }
        }
    }
};
struct EpiFourier {
    static constexpr bool PERM = true;
    bf16_t* Bdft; const float* vr;
    __device__ __forceinline__ void operator()(AccRef acc, const pg8::Unit& u, int wr, int wc, int fr, int fq) const {
        const int half = u.pm >> 1, pnl = u.pn - 64 * half, b = pnl >> 3, j0 = (pnl & 7) * 256;
        const int n0 = (u.pm & 1) * 256 + wr * 64 + fr;
        const bool patch = (half == 1) && (j0 == 0) && (wc == 0) && (fq == 0);
#pragma unroll
        for (int ai = 0; ai < 2; ++ai)
#pragma unroll
            for (int m = 0; m < 4; ++m) { const int n = n0 + ai * 128 + m * 16;
                bf16_t* rowp = Bdft + (size_t)(b * 512 + n) * 4096 + half * 2048 + j0 + 32 * wc + 8 * fq;
#pragma unroll
                for (int bj = 0; bj < 2; ++bj) { f32x4 v0 = acc[ai][bj][m][0]; if (patch && bj == 0) v0[0] = vr[b * 512 + n];
                    *(u32x4*)(rowp + 128 * bj) = pack8(v0, acc[ai][bj][m][1]); } }
    }
};
struct EpiDft {
    static constexpr bool PERM = true;
    bf16_t* Amix;
    __device__ __forceinline__ void operator()(AccRef acc, const pg8::Unit& u, int wr, int wc, int fr, int fq) const {
        const int b = u.pn >> 1, col0 = (u.pn & 1) * 256 + 32 * wc + 8 * fq, k0 = u.pm * 256 + wr * 64 + fr;
#pragma unroll
        for (int ai = 0; ai < 2; ++ai)
#pragma unroll
            for (int m = 0; m < 4; ++m) { bf16_t* rowp = Amix + (size_t)(b * 4096 + k0 + ai * 128 + m * 16) * 1024 + col0;
#pragma unroll
                for (int bj = 0; bj < 2; ++bj) *(u32x4*)(rowp + 128 * bj) = pack8(acc[ai][bj][m][0], acc[ai][bj][m][1]); }
    }
};
struct EpiOut {
    static constexpr bool PERM = false;
    const float* x; const float* mod; float* out;
    __device__ __forceinline__ void operator()(AccRef acc, const pg8::Unit& u, int wr, int wc, int fr, int fq) const {
        const int row0 = u.pm * 256 + wr * 64 + fr, col0 = u.pn * 256 + wc * 32 + 4 * fq, b = (u.pm * 256) >> 12;
        f32x4 gt[2][2];
#pragma unroll
        for (int bj = 0; bj < 2; ++bj)
#pragma unroll
            for (int n = 0; n < 2; ++n) gt[bj][n] = *(const f32x4*)(mod + b * 6144 + 2048 + col0 + bj * 128 + n * 16);
#pragma unroll
        for (int ai = 0; ai < 2; ++ai)
#pragma unroll
            for (int m = 0; m < 4; ++m) { const size_t off = (size_t)(row0 + ai * 128 + m * 16) * 1024 + col0;
#pragma unroll
                for (int bj = 0; bj < 2; ++bj)
#pragma unroll
                    for (int n = 0; n < 2; ++n) { const f32x4 xv = *(const f32x4*)(x + off + bj * 128 + n * 16); *(f32x4*)(out + off + bj * 128 + n * 16) = xv + gt[bj][n] * acc[ai][bj][m][n]; } }
    }
};
struct EpiSwiglu {
    static constexpr bool PERM = true;
    bf16_t* act; const float* b1p; const LAS unsigned char* tile_e;
    __device__ __forceinline__ void operator()(AccRef acc, const pg8::Unit& u, int wr, int wc, int fr, int fq) const {
        const int e = tile_e[u.pm]; const int row0 = u.pm * 256 + wr * 64 + fr, pc = 32 * wc + 8 * fq;
        const float* bp = b1p + e * 2048 + u.pn * 256 + pc;
        f32x4 bg[2], bl[2];
#pragma unroll
        for (int n = 0; n < 2; ++n) { bg[n] = *(const f32x4*)(bp + 4 * n); bl[n] = *(const f32x4*)(bp + 128 + 4 * n); }
#pragma unroll
        for (int ai = 0; ai < 2; ++ai)
#pragma unroll
            for (int m = 0; m < 4; ++m) { f32x4 o[2];
#pragma unroll
                for (int n = 0; n < 2; ++n) { const f32x4 g = acc[ai][0][m][n] + bg[n], l = acc[ai][1][m][n] + bl[n];
#pragma unroll
                    for (int i = 0; i < 4; ++i) { const float gg = fminf(g[i], 7.0f), ll = fminf(fmaxf(l[i], -7.0f), 7.0f);
                        const float sg = __builtin_amdgcn_rcpf(1.0f + __builtin_amdgcn_exp2f(-1.702f * LOG2E * gg)); o[n][i] = gg * sg * (ll + 1.0f); } }
                *(u32x4*)(act + (size_t)(row0 + ai * 128 + m * 16) * 1024 + u.pn * 128 + pc) = pack8(o[0], o[1]); }
    }
};
struct EpiDown {
    static constexpr bool PERM = true;
    bf16_t* slab; const float* b2; const float* slot_gate; const LAS unsigned char* tile_e; const LAS int* tstart;
    __device__ __forceinline__ void operator()(AccRef acc, const pg8::Unit& u, int wr, int wc, int fr, int fq) const {
        const int e = tile_e[u.pm]; const int rl = wr * 64 + fr, col0 = u.pn * 256 + 32 * wc + 8 * fq;
        const float* gp = slot_gate + (size_t)e * CAP + (u.pm - tstart[e]) * 256 + rl;
        f32x4 bv[2][2];
#pragma unroll
        for (int bj = 0; bj < 2; ++bj)
#pragma unroll
            for (int n = 0; n < 2; ++n) bv[bj][n] = *(const f32x4*)(b2 + e * 1024 + col0 + 128 * bj + 4 * n);
#pragma unroll
        for (int ai = 0; ai < 2; ++ai)
#pragma unroll
            for (int m = 0; m < 4; ++m) { const float gate = gp[ai * 128 + m * 16];
                bf16_t* rowp = slab + (size_t)(u.pm * 256 + rl + ai * 128 + m * 16) * 1024 + col0;
#pragma unroll
                for (int bj = 0; bj < 2; ++bj) *(u32x4*)(rowp + 128 * bj) = pack8((acc[ai][bj][m][0] + bv[bj][0]) * gate, (acc[ai][bj][m][1] + bv[bj][1]) * gate); }
    }
};

namespace att {
constexpr int QB = 256, KVB = 64, NT = SEQ / KVB;
constexpr int L_K = 0, L_V = 32768, L_Q = 65536;
#define SBAR() __builtin_amdgcn_sched_barrier(0)
__device__ __forceinline__ int crow(int r, int hi) { return (r & 3) + 8 * (r >> 2) + 4 * hi; }
__device__ __forceinline__ int swap23(int k) { return (k & ~0xC) | ((k & 4) << 1) | ((k & 8) >> 1); }
__device__ __forceinline__ int v_rd_base(int lane) { return ((lane & 3) << 3) | (((lane >> 2) & 3) << 6) | (((lane >> 4) & 1) << 5) | (((lane >> 5) & 1) << 8); }
constexpr int v_rd_off(int d0, int ks, int half) { return d0 * 512 + ks * 4096 + half * 2048; }
template <int OFF> __device__ __forceinline__ s16x4 tr_read(int vb) { s16x4 r; asm volatile("ds_read_b64_tr_b16 %0, %1 offset:%2" : "=&v"(r) : "v"(vb), "i"(OFF) : "memory"); return r; }
#define PKV(L, H) (bf16x8){L[0], L[1], L[2], L[3], H[0], H[1], H[2], H[3]}
template <int D0, int KB> __device__ __forceinline__ void pv_half(f32x16& oa, f32x16& ob, int vb, const bf16x8 (&pa)[2], const bf16x8 (&pb)[2]) {
    const s16x4 l0 = tr_read<v_rd_off(D0, 2 * KB, 0)>(vb), h0 = tr_read<v_rd_off(D0, 2 * KB, 1)>(vb), l1 = tr_read<v_rd_off(D0, 2 * KB + 1, 0)>(vb), h1 = tr_read<v_rd_off(D0, 2 * KB + 1, 1)>(vb);
    asm volatile("s_waitcnt lgkmcnt(0)" ::: "memory"); SBAR();
    oa = __builtin_amdgcn_mfma_f32_32x32x16_bf16(pa[0], PKV(l0, h0), oa, 0, 0, 0);
    ob = __builtin_amdgcn_mfma_f32_32x32x16_bf16(pb[0], PKV(l0, h0), ob, 0, 0, 0);
    oa = __builtin_amdgcn_mfma_f32_32x32x16_bf16(pa[1], PKV(l1, h1), oa, 0, 0, 0);
    ob = __builtin_amdgcn_mfma_f32_32x32x16_bf16(pb[1], PKV(l1, h1), ob, 0, 0, 0);
}
__device__ __forceinline__ void qkt(f32x16& p, const LAS unsigned char* kb, const LAS unsigned char* qb, const int (&co)[4], int off) {
    p = f32x16{};
#pragma unroll
    for (int d0 = 0; d0 < 4; ++d0) {
        const bf16x8 k0 = *(const LAS bf16x8*)(kb + co[d0] + off), qf = *(const LAS bf16x8*)(qb + co[d0] + (off & 255));
        p = __builtin_amdgcn_mfma_f32_32x32x16_bf16(k0, qf, p, 0, 0, 0);
    }
}
__device__ __forceinline__ void add_bias(f32x16& p, const LAS float* bt, int relb, int hi) {
#pragma unroll
    for (int r = 0; r < 16; ++r) { const int i0 = relb + crow(r, hi); p[r] += bt[i0 < 0 ? 0 : (i0 > 254 ? 254 : i0)]; }
}
__device__ __forceinline__ float softmax_pack(f32x16& p, bf16x8 (&pa)[2]) {
#pragma unroll
    for (int r = 0; r < 16; ++r) p[r] = __builtin_amdgcn_exp2f(p[r]);
    float ps = 0.f;
#pragma unroll
    for (int r = 0; r < 16; ++r) ps += p[r];
#define PK4(P, BASE, OUT) do { unsigned a0 = cvt_pk_bf16(P[BASE + 0], P[BASE + 1]), a1 = cvt_pk_bf16(P[BASE + 2], P[BASE + 3]); \
    unsigned b0 = cvt_pk_bf16(P[BASE + 4], P[BASE + 5]), b1 = cvt_pk_bf16(P[BASE + 6], P[BASE + 7]); \
    auto r0 = __builtin_amdgcn_permlane32_swap(a0, b0, false, false); auto r1 = __builtin_amdgcn_permlane32_swap(a1, b1, false, false); \
    u32x4 w = {r0[0], r1[0], r0[1], r1[1]}; OUT = __builtin_bit_cast(bf16x8, w); } while (0)
    PK4(p, 0, pa[0]); PK4(p, 8, pa[1]);
#undef PK4
    return ps;
}

struct Tensors { const bf16_t *Q, *K, *V; bf16_t* Amix; const float* btab; const float* gsub; float lam; };

__device__ __forceinline__ void attn_unit(LAS unsigned char* lds, const Tensors& T, int b, int h, int qb) {
    int tid_ = threadIdx.x; asm volatile("" : "+v"(tid_));
    const int tid = tid_, lane = tid & 63, r32 = lane & 31, hi = lane >> 5; const int wid = __builtin_amdgcn_readfirstlane(tid >> 6);
    const size_t rowbase = (size_t)b * SEQ; const int q0 = qb * QB;
    const bf16_t* Kh = T.K + rowbase * 512 + h * 128; const bf16_t* Vh = T.V + rowbase * 512 + h * 128; const bf16_t* Qh = T.Q + (rowbase + q0) * 512 + h * 128;
    LAS float* bt = (LAS float*)(lds + SP_BT); LAS float* wsf = (LAS float*)(lds + SP_WS) + wid * 64;
    unsigned ksrc[2], vsrc[2];
#pragma unroll
    for (int i = 0; i < 2; ++i) { const int p = wid * 2 + i; const int row = 4 * p + (lane >> 4), ch = (lane & 15) ^ (row & 7); ksrc[i] = (unsigned)(row * 512 + ch * 8) * 2u;
        const int st = 2 * p + (lane >> 5), kk = (st >> 2) * 8 + ((lane & 31) >> 2), cc = (st & 3) * 32 + (lane & 3) * 8; vsrc[i] = (unsigned)(swap23(kk) * 512 + cc) * 2u; }
    const unsigned ldsw = (unsigned)wid * 2048u;
#define DMA_TILE(t, buf) do { const char* kg = (const char*)(Kh + (size_t)(t) * KVB * 512); const char* vg = (const char*)(Vh + (size_t)(t) * KVB * 512); \
    _Pragma("unroll") for (int _i = 0; _i < 2; ++_i) { \
        __builtin_amdgcn_global_load_lds((const unsigned*)(kg + ksrc[_i]), (LAS unsigned*)(lds + L_K + (buf) * 16384 + ldsw + _i * 1024), 16, 0, 0); \
        __builtin_amdgcn_global_load_lds((const unsigned*)(vg + vsrc[_i]), (LAS unsigned*)(lds + L_V + (buf) * 16384 + ldsw + _i * 1024), 16, 0, 0); } } while (0)
    { int lq = lane; asm volatile("" : "+v"(lq));
      const int rq = lq >> 4; const unsigned qo0 = (unsigned)((32 * wid + rq) * 512 + (((lq & 15) ^ (rq & 7)) << 3)) * 2u, qo1 = (unsigned)((32 * wid + 4 + rq) * 512 + (((lq & 15) ^ ((4 + rq) & 7)) << 3)) * 2u;
#pragma unroll
      for (int i = 0; i < 8; ++i) { const int p = wid * 8 + i;
        __builtin_amdgcn_global_load_lds((const unsigned*)((const char*)Qh + ((i & 1) ? qo1 : qo0) + (size_t)(i >> 1) * 8192), (LAS unsigned*)(lds + L_Q + p * 1024), 16, 0, 0); } }
    DMA_TILE(0, 0);
    if (tid < 255) bt[tid] = T.btab[h * 256 + tid];
    int co[4];
#pragma unroll
    for (int d0 = 0; d0 < 4; ++d0) co[d0] = r32 * 256 + (((2 * d0 + hi) ^ (r32 & 7)) << 4);
    const LAS unsigned char* qbase = lds + L_Q + wid * 8192;
    const int vb0 = (int)(uintptr_t)(lds + L_V) + v_rd_base(lane);
    f32x16 o1[4], o2[4];
#pragma unroll
    for (int d = 0; d < 4; ++d) { o1[d] = f32x16{}; o2[d] = f32x16{}; }
    float l1 = 0.f, l2 = 0.f;
    const int qw = q0 + wid * 32;
    int state = (qw >= 154) ? 0 : 1;
    __syncthreads();
    for (int t = 0; t < NT; ++t) {
        const int buf = t & 1;
        if (t + 1 < NT) DMA_TILE(t + 1, buf ^ 1);
        const int k0 = t * KVB;
        const bool isneg = (k0 <= qw - 154), ispos = (k0 >= qw + 122);
        if (state == 0 && !isneg) { const float f = __builtin_amdgcn_exp2f(bt[0]); state = 1;
#pragma unroll
            for (int d = 0; d < 4; ++d) { o1[d] *= f; o2[d] *= f; }
            l1 *= f; l2 *= f; }
        if (state == 1 && ispos) { const float f = __builtin_amdgcn_exp2f(-bt[254]); state = 2;
#pragma unroll
            for (int d = 0; d < 4; ++d) { o1[d] *= f; o2[d] *= f; }
            l1 *= f; l2 *= f; }
        const LAS unsigned char* kbuf = lds + L_K + buf * 16384;
        const int vb = vb0 + buf * 16384; const int relb = k0 - (qw + r32) + 127;
        f32x16 p; bf16x8 pa[2], pb[2];
        qkt(p, kbuf, qbase, co, 0); if (state == 1) add_bias(p, bt, relb, hi); l1 += softmax_pack(p, pa);
        qkt(p, kbuf, qbase, co, 128); if (state == 1) add_bias(p, bt, relb, hi); l2 += softmax_pack(p, pb);
        pv_half<0, 0>(o1[0], o2[0], vb, pa, pb); pv_half<1, 0>(o1[1], o2[1], vb, pa, pb); pv_half<2, 0>(o1[2], o2[2], vb, pa, pb); pv_half<3, 0>(o1[3], o2[3], vb, pa, pb);
        qkt(p, kbuf, qbase, co, 8192); if (state == 1) add_bias(p, bt, relb + 32, hi); l1 += softmax_pack(p, pa);
        qkt(p, kbuf, qbase, co, 8192 + 128); if (state == 1) add_bias(p, bt, relb + 32, hi); l2 += softmax_pack(p, pb);
        pv_half<0, 1>(o1[0], o2[0], vb, pa, pb); pv_half<1, 1>(o1[1], o2[1], vb, pa, pb); pv_half<2, 1>(o1[2], o2[2], vb, pa, pb); pv_half<3, 1>(o1[3], o2[3], vb, pa, pb);
        __syncthreads();
    }
#undef DMA_TILE
    l1 += __shfl_xor(l1, 32); l2 += __shfl_xor(l2, 32);
    if (hi == 0) { wsf[r32] = 1.0f / l1; wsf[32 + r32] = T.lam / l2; }
    LDS_WAIT();
    float gs[4];
#pragma unroll
    for (int d = 0; d < 4; ++d) gs[d] = T.gsub[32 * d + r32] * (1.0f - LAM_INIT);
    bf16_t* Ow = T.Amix + (rowbase + q0 + wid * 32 + 4 * hi) * 1024 + 512 + h * 128 + r32; asm volatile("" : "+v"(Ow));
#pragma unroll
    for (int r = 0; r < 16; ++r) { const int row = crow(r, hi); const float c1 = wsf[row], c2 = wsf[32 + row];
        float y[4], ss = 0.f;
#pragma unroll
        for (int d = 0; d < 4; ++d) { y[d] = o1[d][r] * c1 - o2[d][r] * c2; ss += y[d] * y[d]; }
        ss += __shfl_xor(ss, 1); ss += __shfl_xor(ss, 2); ss += __shfl_xor(ss, 4); ss += __shfl_xor(ss, 8); ss += __shfl_xor(ss, 16);
        const float rr = rsqrtf(ss * (1.0f / 128.0f) + EPS);
#pragma unroll
        for (int d = 0; d < 4; ++d) Ow[(size_t)((r & 3) + 8 * (r >> 2)) * 1024 + 32 * d] = (bf16_t)(cvt_pk_bf16(y[d] * rr * gs[d], 0.f) & 0xffffu); }
    __syncthreads();
}
#undef SBAR
#undef PKV
}

__device__ __forceinline__ void tr_item(const float* W, int ldw, bf16_t* WT, int ldt, LAS float* scr, int lane) {
#pragma unroll 8
    for (int i = 0; i < 32; ++i) { const int kk = 2 * i + (lane >> 5); scr[kk * 33 + (lane & 31)] = W[(size_t)kk * ldw + (lane & 31)]; }
    LDS_WAIT(); asm volatile("" ::: "memory");
    const int c = lane & 7;
#pragma unroll
    for (int j = 0; j < 4; ++j) { const int n = (lane >> 3) + 8 * j; const LAS float* s = scr + (8 * c) * 33 + n;
        u32x4 o; o.x = cvt_pk_bf16(s[0 * 33], s[1 * 33]); o.y = cvt_pk_bf16(s[2 * 33], s[3 * 33]); o.z = cvt_pk_bf16(s[4 * 33], s[5 * 33]); o.w = cvt_pk_bf16(s[6 * 33], s[7 * 33]);
        *(u32x4*)(WT + (size_t)n * ldt + 8 * c) = o; }
    LDS_WAIT(); asm volatile("" ::: "memory");
}
__device__ __forceinline__ void tr_w1_item(const float* W, bf16_t* WT, int kc, int nc, LAS float* scr, int lane) {
    const float* src = W + (size_t)(kc * 32) * 2048 + nc * 64 + lane;
#pragma unroll 8
    for (int kk = 0; kk < 32; ++kk) scr[kk * 65 + lane] = src[(size_t)kk * 2048];
    LDS_WAIT(); asm volatile("" ::: "memory");
    const int pn = nc >> 2, p0 = 32 * (nc & 3);
    const int nl = (lane < 32) ? 2 * lane : 2 * (lane - 32) + 1, prow = pn * 256 + ((lane < 32) ? (p0 + lane) : (128 + p0 + lane - 32));
    bf16_t* dst = WT + (size_t)prow * 1024 + kc * 32;
#pragma unroll
    for (int q = 0; q < 4; ++q) { const LAS float* s = scr + (8 * q) * 65 + nl;
        u32x4 o; o.x = cvt_pk_bf16(s[0 * 65], s[1 * 65]); o.y = cvt_pk_bf16(s[2 * 65], s[3 * 65]); o.z = cvt_pk_bf16(s[4 * 65], s[5 * 65]); o.w = cvt_pk_bf16(s[6 * 65], s[7 * 65]);
        *(u32x4*)(dst + 8 * q) = o; }
    LDS_WAIT(); asm volatile("" ::: "memory");
}
__device__ __forceinline__ int qk_logical(int p) { return 64 * ((p >> 5) & 3) + 32 * (p >> 7) + (p & 31); }

__device__ __forceinline__ int t5_bucket_idx(int rel) {
    const int ret = rel > 0 ? 16 : 0; const int n = rel < 0 ? -rel : rel;
    const float nf = (float)(n < 1 ? 1 : n);
    int large = 8 + (int)(logf(nf / 8.0f) / logf(16.0f) * 8.0f); large = large < 15 ? large : 15;
    if (n == 16) large = 10; if (n == 32) large = 12; if (n == 64) large = 14;
    return ret + (n < 8 ? n : large);
}

constexpr int P0_SCR = 10240;
constexpr int P0_CTAB = 8 * P0_SCR;
__device__ __forceinline__ void p0_prologue(Frame& F) {
    LAS float* scr = (LAS float*)(F.lds + F.wave * P0_SCR);
    LAS float* ctab = (LAS float*)(F.lds + P0_CTAB);
    for (int m = F.tid; m < 4096; m += 512) ctab[m] = cospif((float)m * (1.0f / 2048.0f));
    __syncthreads();
    const int gw = F.vcu * NWAVES + F.wave, NGW = F.G * NWAVES, lane = F.lane;
    constexpr int I_MOD = 96, I_QKV = 16 * 48, I_WOUT = 8 * 32, I_W2 = 32 * 16 * 32, I_W1 = 32 * 32 * 32, I_FCS = 256, I_FOUT = 512, I_ADFT = 4096, I_MISC = 65;
    constexpr int NITEMS = I_MOD + I_QKV + I_WOUT + I_FCS + I_FOUT + I_MISC + I_ADFT + I_W2 + I_W1;
    float* mod = wsp<float>(F, WS_MOD);
    for (int it = gw; it < NITEMS; it += NGW) {
        int r = it;
        if (r < I_MOD) {
            const int col = r * 64 + lane; float acc[8];
#pragma unroll
            for (int b = 0; b < 8; ++b) acc[b] = 0.f;
            for (int kc = 0; kc < 16; ++kc) {
#pragma unroll
                for (int b = 0; b < 8; ++b) { const float cv = F.c[b * 1024 + kc * 64 + lane]; scr[lane * 8 + b] = cv / (1.0f + __expf(-cv)); }
                LDS_WAIT(); asm volatile("" ::: "memory");
#pragma unroll 8
                for (int kk = 0; kk < 64; ++kk) { const float w = F.w_ada[(size_t)(kc * 64 + kk) * 6144 + col];
                    const f32x4 s0 = *(const LAS f32x4*)(scr + kk * 8), s1 = *(const LAS f32x4*)(scr + kk * 8 + 4);
                    acc[0] += s0[0] * w; acc[1] += s0[1] * w; acc[2] += s0[2] * w; acc[3] += s0[3] * w; acc[4] += s1[0] * w; acc[5] += s1[1] * w; acc[6] += s1[2] * w; acc[7] += s1[3] * w; }
                LDS_WAIT(); asm volatile("" ::: "memory");
            }
            const float bb = F.b_ada[col];
#pragma unroll
            for (int b = 0; b < 8; ++b) mod[b * 6144 + col] = acc[b] + bb;
            continue; }
        r -= I_MOD;
        if (r < I_QKV) {
            const int kb = r / 48, nb = r % 48, prow = nb * 32, tile = prow >> 8, p = prow & 255;
            const int lcol = 512 + tile * 256 + (tile < 4 ? qk_logical(p) : p);
            tr_item(F.w_in + (size_t)(kb * 64) * 2048 + lcol, 2048, wsp<bf16_t>(F, WS_WQKV) + (size_t)prow * 1024 + kb * 64, 1024, scr, lane);
            continue; }
        r -= I_QKV;
        if (r < I_WOUT) {
            const int kb = r / 32, nb = r % 32;
            tr_item(F.w_out + (size_t)(512 + kb * 64) * 1024 + nb * 32, 1024, wsp<bf16_t>(F, WS_WOUT) + (size_t)(nb * 32) * 1024 + 512 + kb * 64, 1024, scr, lane);
            continue; }
        r -= I_WOUT;
        if (r < I_FCS) {
            const int g = r >> 6, d0 = (r & 63) * 16;
#pragma unroll
            for (int dd = 0; dd < 16; ++dd) { scr[dd * 129 + lane] = F.w_in[(size_t)(d0 + dd) * 2048 + g * 128 + lane]; scr[dd * 129 + 64 + lane] = F.w_in[(size_t)(d0 + dd) * 2048 + g * 128 + 64 + lane]; }
            LDS_WAIT(); asm volatile("" ::: "memory");
            const int d = lane & 15, kq = lane >> 4; float ac[32], as[32];
#pragma unroll
            for (int i = 0; i < 32; ++i) { ac[i] = 0.f; as[i] = 0.f; }
            for (int c = 0; c < 128; ++c) { const float a = scr[d * 129 + c];
#pragma unroll
                for (int i = 0; i < 32; ++i) { const int idx = (c * (kq * 32 + i)) & 127; ac[i] += a * ctab[idx * 32]; as[i] += a * ctab[((idx - 32) & 127) * 32]; } }
            const float sc = 0.08838834764831845f;
            bf16_t* wc = wsp<bf16_t>(F, WS_WCS);
#pragma unroll
            for (int i = 0; i < 32; ++i) { const int n = g * 128 + kq * 32 + i;
                wc[(size_t)n * 1024 + d0 + d] = (bf16_t)(cvt_pk_bf16(ac[i] * sc, 0.f) & 0xffffu); wc[(size_t)(512 + n) * 1024 + d0 + d] = (bf16_t)(cvt_pk_bf16(-as[i] * sc, 0.f) & 0xffffu); }
            LDS_WAIT(); asm volatile("" ::: "memory");
            continue; }
        r -= I_FCS;
        if (r < I_FOUT) {
            const int g = r >> 7, dc = (r >> 3) & 15, kc0 = (r & 7) * 16;
#pragma unroll
            for (int i = 0; i < 16; ++i) { scr[i * 128 + lane] = F.w_fourier[(size_t)(g * 128 + kc0 + i) * 128 + lane]; scr[i * 128 + 64 + lane] = F.w_fourier[(size_t)(g * 128 + kc0 + i) * 128 + 64 + lane]; }
            LDS_WAIT(); asm volatile("" ::: "memory");
            float acc[16];
#pragma unroll
            for (int i = 0; i < 16; ++i) acc[i] = 0.f;
            const int dout = dc * 64 + lane;
#pragma unroll 4
            for (int d = 0; d < 128; ++d) { const float a = F.w_out[(size_t)(g * 128 + d) * 1024 + dout];
#pragma unroll
                for (int i = 0; i < 16; ++i) acc[i] += scr[i * 128 + d] * a; }
            u32x4 o0, o1; o0.x = cvt_pk_bf16(acc[0], acc[1]); o0.y = cvt_pk_bf16(acc[2], acc[3]); o0.z = cvt_pk_bf16(acc[4], acc[5]); o0.w = cvt_pk_bf16(acc[6], acc[7]);
            o1.x = cvt_pk_bf16(acc[8], acc[9]); o1.y = cvt_pk_bf16(acc[10], acc[11]); o1.z = cvt_pk_bf16(acc[12], acc[13]); o1.w = cvt_pk_bf16(acc[14], acc[15]);
            bf16_t* dst = wsp<bf16_t>(F, WS_WOUT) + (size_t)dout * 1024 + g * 128 + kc0;
            *(u32x4*)dst = o0; *(u32x4*)(dst + 8) = o1;
            LDS_WAIT(); asm volatile("" ::: "memory");
            continue; }
        r -= I_FOUT;
        if (r < I_MISC) {
            if (r == 0) { float* bt = wsp<float>(F, WS_BTAB);
                for (int i = lane; i < 4 * 256; i += 64) { const int h = i >> 8, ri = i & 255; const int rel = (ri > 254 ? 254 : ri) - 127; bt[i] = F.rel_bias[t5_bucket_idx(rel) * 4 + h] * LOG2E; } }
            else { float* bp = wsp<float>(F, WS_B1P); const int base = (r - 1) * 1024;
                for (int i = lane; i < 1024; i += 64) { const int idx = base + i, e = idx >> 11, pc = idx & 2047, pn = pc >> 8, p = pc & 255;
                    bp[idx] = F.b1[e * 2048 + pn * 256 + (p < 128 ? 2 * p : 2 * (p - 128) + 1)]; } }
            continue; }
        r -= I_MISC;
        if (r < I_ADFT) {
            const int k = r; bf16_t* row = wsp<bf16_t>(F, WS_ADFT) + (size_t)k * 4096;
#pragma unroll
            for (int ch = 0; ch < 8; ++ch) { const int j0 = ch * 512 + lane * 8; float v[8];
#pragma unroll
                for (int e = 0; e < 8; ++e) { const int j = j0 + e;
                    if (j < 2048) v[e] = ctab[(k * j) & 4095];
                    else if (j == 2048) v[e] = (k & 1) ? -1.0f : 1.0f;
                    else v[e] = ctab[((k * (j - 2048)) - 1024) & 4095];
                    v[e] *= (1.0f / 64.0f); }
                u32x4 o; o.x = cvt_pk_bf16(v[0], v[1]); o.y = cvt_pk_bf16(v[2], v[3]); o.z = cvt_pk_bf16(v[4], v[5]); o.w = cvt_pk_bf16(v[6], v[7]);
                *(u32x4*)(row + j0) = o; }
            continue; }
        r -= I_ADFT;
        if (r < I_W2) {
            const int e = r >> 9, kb = (r >> 5) & 15, nb = r & 31;
            tr_item(F.w2 + (size_t)e * 1048576 + (size_t)(kb * 64) * 1024 + nb * 32, 1024, wsp<bf16_t>(F, WS_W2) + (size_t)e * 1048576 + (size_t)(nb * 32) * 1024 + kb * 64, 1024, scr, lane);
            continue; }
        r -= I_W2;
        { const int e = r >> 10, kc = (r >> 5) & 31, nc = r & 31;
          tr_w1_item(F.w1 + (size_t)e * 2097152, wsp<bf16_t>(F, WS_W1) + (size_t)e * 2097152, kc, nc, scr, lane); }
    }
}

__device__ __forceinline__ void norm_row(const float* xrow, const float* g, const float* sh, const float* sc, int lane, f32x4 (&h)[4]) {
    float s = 0.f;
#pragma unroll
    for (int j = 0; j < 4; ++j) { h[j] = *((const f32x4*)xrow + lane + 64 * j); s += (h[j][0] * h[j][0] + h[j][1] * h[j][1]) + (h[j][2] * h[j][2] + h[j][3] * h[j][3]); }
    const float rr = rsqrtf(wave_sum(s) * (1.0f / 1024.0f) + EPS);
#pragma unroll
    for (int j = 0; j < 4; ++j) { const f32x4 gv = *((const f32x4*)g + lane + 64 * j), sv = *((const f32x4*)sc + lane + 64 * j), hv = *((const f32x4*)sh + lane + 64 * j);
        h[j] = h[j] * rr * gv * (sv + 1.0f) + hv; }
}
__device__ __forceinline__ void store_row_bf16(bf16_t* row, int lane, const f32x4 (&h)[4]) {
#pragma unroll
    for (int j = 0; j < 4; ++j) { u32x2 w; w.x = cvt_pk_bf16(h[j][0], h[j][1]); w.y = cvt_pk_bf16(h[j][2], h[j][3]); *((u32x2*)row + lane + 64 * j) = w; }
}
__device__ __forceinline__ void p1_rows(Frame& F) {
    const int gw = F.vcu * NWAVES + F.wave, NGW = F.G * NWAVES, lane = F.lane;
    const float* mod = wsp<float>(F, WS_MOD);
    bf16_t* XN = wsp<bf16_t>(F, WS_XN); bf16_t* XS = wsp<bf16_t>(F, WS_XNSA); bf16_t* XA = XS + (size_t)NB * HSEQ * 1024;
    for (int w = gw; w < NB * (HSEQ + 1); w += NGW) {
        const int b = w / (HSEQ + 1), j = w % (HSEQ + 1);
        const float* sh = mod + b * 6144; const float* sc = sh + 1024;
        f32x4 h0[4];
        norm_row(F.x + ((size_t)b * SEQ + j) * 1024, F.g_mix, sh, sc, lane, h0);
        store_row_bf16(XN + ((size_t)b * SEQ + j) * 1024, lane, h0);
        if (j == 0) {
            store_row_bf16(XS + ((size_t)b * HSEQ) * 1024, lane, h0);
            f32x4 z[4];
#pragma unroll
            for (int q = 0; q < 4; ++q) z[q] = (f32x4){0.f, 0.f, 0.f, 0.f};
            store_row_bf16(XA + ((size_t)b * HSEQ) * 1024, lane, z);
        } else if (j == HSEQ) {
            const bf16_t* wc = wsp<bf16_t>(F, WS_WCS); float* vr = wsp<float>(F, WS_VR);
            for (int n = 0; n < 512; ++n) { float s = 0.f;
#pragma unroll
                for (int q = 0; q < 4; ++q) { const u32x2 wv = *((const u32x2*)(wc + (size_t)n * 1024) + lane + 64 * q);
                    s += h0[q][0] * __uint_as_float(wv.x << 16) + h0[q][1] * __uint_as_float(wv.x & 0xffff0000u) + h0[q][2] * __uint_as_float(wv.y << 16) + h0[q][3] * __uint_as_float(wv.y & 0xffff0000u); }
                s = wave_sum(s); if (lane == 0) vr[b * 512 + n] = s; }
        } else {
            f32x4 h1[4], t[4];
            norm_row(F.x + ((size_t)b * SEQ + (SEQ - j)) * 1024, F.g_mix, sh, sc, lane, h1);
            store_row_bf16(XN + ((size_t)b * SEQ + (SEQ - j)) * 1024, lane, h1);
#pragma unroll
            for (int q = 0; q < 4; ++q) t[q] = h0[q] + h1[q];
            store_row_bf16(XS + ((size_t)b * HSEQ + j) * 1024, lane, t);
#pragma unroll
            for (int q = 0; q < 4; ++q) t[q] = h0[q] - h1[q];
            store_row_bf16(XA + ((size_t)b * HSEQ + j) * 1024, lane, t);
        }
    }
}

__device__ __forceinline__ void moe_tables(Frame& F) {
    LAS int* cnt = (LAS int*)(F.lds + SP_CNT); LAS int* tstart = (LAS int*)(F.lds + SP_TSTART); LAS unsigned char* tile_e = F.lds + SP_TILEE;
    __syncthreads();
    if (F.tid < 32) cnt[F.tid] = (int)__hip_atomic_load(F.ctl + CW_GCNT + 64 * F.tid, RLX_AGENT);
    __syncthreads();
    if (F.tid == 0) { int s = 0; for (int e = 0; e < 32; ++e) { tstart[e] = s; s += (cnt[e] + 255) >> 8; } tstart[32] = s; tstart[33] = s; }
    __syncthreads();
    const int total = tstart[32];
    for (int pm = F.tid; pm < total; pm += 512) { int e = 0;
        for (int q = 1; q < 32; ++q) e += (pm >= tstart[q]) ? 1 : 0;
        tile_e[pm] = (unsigned char)e; }
    __syncthreads();
}

constexpr int SP_LCNT = SP_OFF + 5120, SP_LBASE = SP_OFF + 5376, SP_STASH = SP_OFF + 6144;
__device__ __forceinline__ void p5_router(Frame& F) {
    const int lane = F.lane, tid = F.tid;
    LAS f32x4* W4 = (LAS f32x4*)F.lds;
    for (int idx = tid; idx < 1024 * 8; idx += 512) { const int d = idx >> 3, e4 = idx & 7; const f32x4 v = *((const f32x4*)(F.w_router + (size_t)d * 32) + e4);
        const int jj = d >> 8, ln = (d & 255) >> 2, i = d & 3; W4[((jj * 4 + i) * 8 + e4) * 64 + ln] = v; }
    LAS int* lcnt = (LAS int*)(F.lds + SP_LCNT); LAS int* lbase = (LAS int*)(F.lds + SP_LBASE); LAS int* stash = (LAS int*)(F.lds + SP_STASH);
    if (tid < 32) lcnt[tid] = 0;
    __syncthreads();
    const float* mod = wsp<float>(F, WS_MOD); bf16_t* XN2 = wsp<bf16_t>(F, WS_XN2);
    const int e_lane = ((lane >> 5) & 1) * 16 + ((lane >> 4) & 1) * 8 + ((lane >> 3) & 1) * 4 + ((lane >> 2) & 1) * 2 + ((lane >> 1) & 1);
    const float brt = F.b_router[e_lane];
    for (int rl = 0; rl < 16; ++rl) {
        const int trow = F.vcu * 128 + F.wave * 16 + rl, b = trow >> 12;
        f32x4 h[4];
        norm_row(F.out + (size_t)trow * 1024, F.g_ffn, mod + b * 6144 + 3072, mod + b * 6144 + 4096, lane, h);
        store_row_bf16(XN2 + (size_t)trow * 1024, lane, h);
        float acc[32];
#pragma unroll
        for (int e = 0; e < 32; ++e) acc[e] = 0.f;
#pragma unroll
        for (int jj = 0; jj < 4; ++jj)
#pragma unroll
            for (int i = 0; i < 4; ++i) { const float hv = h[jj][i];
#pragma unroll
                for (int e4 = 0; e4 < 8; ++e4) { const f32x4 w = W4[((jj * 4 + i) * 8 + e4) * 64 + lane];
                    acc[4 * e4 + 0] += hv * w[0]; acc[4 * e4 + 1] += hv * w[1]; acc[4 * e4 + 2] += hv * w[2]; acc[4 * e4 + 3] += hv * w[3]; } }
        float s16[16];
#pragma unroll
        for (int i = 0; i < 16; ++i) { const float send = (lane & 32) ? acc[i] : acc[16 + i], keep = (lane & 32) ? acc[16 + i] : acc[i]; s16[i] = keep + __shfl_xor(send, 32); }
        float s8[8];
#pragma unroll
        for (int i = 0; i < 8; ++i) { const float send = (lane & 16) ? s16[i] : s16[8 + i], keep = (lane & 16) ? s16[8 + i] : s16[i]; s8[i] = keep + __shfl_xor(send, 16); }
        float s4[4];
#pragma unroll
        for (int i = 0; i < 4; ++i) { const float send = (lane & 8) ? s8[i] : s8[4 + i], keep = (lane & 8) ? s8[4 + i] : s8[i]; s4[i] = keep + __shfl_xor(send, 8); }
        float s2[2];
#pragma unroll
        for (int i = 0; i < 2; ++i) { const float send = (lane & 4) ? s4[i] : s4[2 + i], keep = (lane & 4) ? s4[2 + i] : s4[i]; s2[i] = keep + __shfl_xor(send, 4); }
        float lg; { const float send = (lane & 2) ? s2[0] : s2[1], keep = (lane & 2) ? s2[1] : s2[0]; lg = keep + __shfl_xor(send, 2); }
        lg += __shfl_xor(lg, 1); lg += brt;
        float tv[4]; int te[4]; float cur = lg;
#pragma unroll
        for (int k = 0; k < 4; ++k) { float bv = cur; int be = e_lane;
#pragma unroll
            for (int o = 2; o < 64; o <<= 1) { const float ov = __shfl_xor(bv, o); const int oe = __shfl_xor(be, o); const bool take = (ov > bv) || (ov == bv && oe < be); bv = take ? ov : bv; be = take ? oe : be; }
            tv[k] = bv; te[k] = be; if (e_lane == be) cur = -INFINITY; }
        const float e1 = __expf(tv[1] - tv[0]), e2 = __expf(tv[2] - tv[0]), e3 = __expf(tv[3] - tv[0]); const float inv = 1.0f / (1.0f + e1 + e2 + e3);
        if (lane < 4) { const int k = lane; const int e = (k == 0) ? te[0] : (k == 1) ? te[1] : (k == 2) ? te[2] : te[3];
            const float gk = ((k == 0) ? 1.0f : (k == 1) ? e1 : (k == 2) ? e2 : e3) * inv;
            const int lr = atomicAdd((int*)(lcnt + e), 1);
            const int si = ((F.wave * 16 + rl) * 4 + k) * 4; stash[si] = trow * 4 + k; stash[si + 1] = e; stash[si + 2] = lr; stash[si + 3] = __float_as_int(gk); }
    }
    __syncthreads();
    if (tid < 32) lbase[tid] = (int)__hip_atomic_fetch_add(F.ctl + CW_GCNT + 64 * tid, (unsigned)lcnt[tid], RLX_AGENT);
    __syncthreads();
    { const int si = tid * 4; const int tk = stash[si], e = stash[si + 1], slot = lbase[e] + stash[si + 2];
      wsp<unsigned>(F, WS_SLOTTOK)[(size_t)e * CAP + slot] = (unsigned)(tk >> 2);
      wsp<int>(F, WS_SLOTGATE)[(size_t)e * CAP + slot] = stash[si + 3];
      wsp<unsigned>(F, WS_TOKSLOT)[tk] = (unsigned)(e * CAP + slot); }
}

__device__ __forceinline__ void p8_combine(Frame& F) {
    const int lane = F.lane; const LAS int* tstart = (const LAS int*)(F.lds + SP_TSTART);
    const float* mod = wsp<float>(F, WS_MOD); const bf16_t* slab = wsp<bf16_t>(F, WS_SLAB); const unsigned* ts = wsp<unsigned>(F, WS_TOKSLOT);
    for (int rl = 0; rl < 16; ++rl) {
        const int trow = F.vcu * 128 + F.wave * 16 + rl, b = trow >> 12;
        const u32x4 sl = *(const u32x4*)(ts + (size_t)trow * 4);
        size_t ar[4];
#pragma unroll
        for (int k = 0; k < 4; ++k) { const unsigned v = sl[k]; const int e = v >> 15, slot = v & 32767; ar[k] = (size_t)(tstart[e] * 256 + slot) * 1024; }
        float* orow = F.out + (size_t)trow * 1024;
#pragma unroll
        for (int j = 0; j < 4; ++j) { f32x4 s = (f32x4){0.f, 0.f, 0.f, 0.f};
#pragma unroll
            for (int k = 0; k < 4; ++k) { const u32x2 wv = *((const u32x2*)(slab + ar[k]) + lane + 64 * j);
                s[0] += __uint_as_float(wv.x << 16); s[1] += __uint_as_float(wv.x & 0xffff0000u); s[2] += __uint_as_float(wv.y << 16); s[3] += __uint_as_float(wv.y & 0xffff0000u); }
            const f32x4 gt = *((const f32x4*)(mod + b * 6144 + 5120) + lane + 64 * j); f32x4* op = (f32x4*)orow + lane + 64 * j;
            *op = *op + gt * s; }
    }
}

constexpr int NPHASE = 9;
struct Args { const float* in[23]; float* out; unsigned char* ws; int ph_lo, ph_hi; };
__global__ void __launch_bounds__(NWAVES * 64, 2) mk_fwd(Args args) {
    extern __shared__ __attribute__((aligned(16))) unsigned char lds_[];
    Frame F;
    F.lds = (LAS unsigned char*)lds_;
    F.MISC = (volatile LAS unsigned*)(F.lds + SP_MISC);
    F.tid = threadIdx.x; F.lane = F.tid & 63; F.wave = __builtin_amdgcn_readfirstlane(F.tid >> 6);
    F.G = gridDim.x; { const int bx = blockIdx.x; F.vcu = (F.G % 8 == 0) ? (bx % 8) * (F.G / 8) + bx / 8 : bx; }
    F.ws = args.ws; F.ctl = (unsigned*)(args.ws + WS_CTL); F.out = args.out;
    F.x = args.in[0]; F.c = args.in[1]; F.w_ada = args.in[2]; F.b_ada = args.in[3]; F.g_mix = args.in[4]; F.w_in = args.in[5]; F.w_fourier = args.in[6];
    F.q_norm_g = args.in[7]; F.k_norm_g = args.in[8]; F.lq1 = args.in[9]; F.lk1 = args.in[10]; F.lq2 = args.in[11]; F.lk2 = args.in[12]; F.g_subln = args.in[13];
    F.w_out = args.in[14]; F.rel_bias = args.in[15]; F.g_ffn = args.in[16]; F.w_router = args.in[17]; F.b_router = args.in[18]; F.w1 = args.in[19]; F.b1 = args.in[20];
    F.w2 = args.in[21]; F.b2 = args.in[22];
    if (F.tid < 64) ((LAS unsigned*)(F.lds + SP_MISC))[F.tid] = 0u;
    __syncthreads();
    const int lo = args.ph_lo, hi = args.ph_hi;
    XcdBarrier bar; bar.bar = F.ctl + CW_BAR; bar.x = 0; bar.st = nullptr;
    if (hi - lo > 1) bar = xcd_barrier_post(F.ctl + CW_BAR, F.MISC + 8);
#ifndef PH_MASK
#define PH_MASK 0x1ff
#endif
#define IN(k) (((PH_MASK >> (k)) & 1) && lo <= (k) && (k) < hi)
#define SEAM(k) do { if (IN(k) && IN((k) + 1)) xcd_barrier(bar); } while (0)
    const int cblk = (int)blockIdx.x;

    if (IN(0)) { p0_prologue(F); }
    SEAM(0);
    if (IN(1)) { p1_rows(F); }
    SEAM(1);
    if (IN(2)) {
        { SchedPlain S{(const char*)wsp<bf16_t>(F, WS_XN), (const char*)wsp<bf16_t>(F, WS_WQKV), NTOK / 256, NQKV / 256, F.G, cblk, (size_t)256 * 1024 * 2};
          EpiQKV E{wsp<bf16_t>(F, WS_Q), wsp<bf16_t>(F, WS_K), wsp<bf16_t>(F, WS_V), F.q_norm_g, F.k_norm_g};
          pg8::gemm_phase<EpiQKV, SchedPlain>(F.lds, 1024, S, E); }
        { SchedFourier S{(const char*)wsp<bf16_t>(F, WS_WCS), (const char*)wsp<bf16_t>(F, WS_XNSA), F.G, cblk, (size_t)256 * 1024 * 2};
          EpiFourier E{wsp<bf16_t>(F, WS_BDFT), wsp<float>(F, WS_VR)};
          pg8::gemm_phase<EpiFourier, SchedFourier>(F.lds, 1024, S, E); }
    }
    SEAM(2);
    if (IN(3)) {
        float lam;
        { const float a = F.lq1[F.lane] * F.lk1[F.lane], b = F.lq2[F.lane] * F.lk2[F.lane]; lam = __expf(wave_sum(a)) - __expf(wave_sum(b)) + LAM_INIT; }
        att::Tensors T{wsp<bf16_t>(F, WS_Q), wsp<bf16_t>(F, WS_K), wsp<bf16_t>(F, WS_V), wsp<bf16_t>(F, WS_AMIX), wsp<float>(F, WS_BTAB), F.g_subln, lam};
        for (int L = F.vcu; L < NB * 4 * (SEQ / att::QB); L += F.G) { const int bh = L >> 4, qb = L & 15; att::attn_unit(F.lds, T, bh >> 2, bh & 3, qb); }
        { SchedPlain S{(const char*)wsp<bf16_t>(F, WS_ADFT), (const char*)wsp<bf16_t>(F, WS_BDFT), 16, 16, F.G, cblk, (size_t)256 * 4096 * 2};
          EpiDft E{wsp<bf16_t>(F, WS_AMIX)};
          pg8::gemm_phase<EpiDft, SchedPlain>(F.lds, 4096, S, E); }
    }
    SEAM(3);
    if (IN(4)) {
        SchedPlain S{(const char*)wsp<bf16_t>(F, WS_AMIX), (const char*)wsp<bf16_t>(F, WS_WOUT), NTOK / 256, 4, F.G, cblk, (size_t)256 * 1024 * 2};
        EpiOut E{F.x, wsp<float>(F, WS_MOD), F.out};
        pg8::gemm_phase<EpiOut, SchedPlain>(F.lds, 1024, S, E);
    }
    SEAM(4);
    if (IN(5)) { p5_router(F); }
    SEAM(5);
    if (IN(6)) {
        moe_tables(F);
        const LAS int* tstart = (const LAS int*)(F.lds + SP_TSTART);
        SchedMoe<true> S{(const char*)wsp<bf16_t>(F, WS_XN2), (const char*)wsp<bf16_t>(F, WS_W1), tstart[32], 8, F.G, cblk, 0, (size_t)256 * 1024 * 2, (size_t)2048 * 1024 * 2,
                         F.lds + SP_TILEE, tstart, (const LAS int*)(F.lds + SP_CNT), wsp<unsigned>(F, WS_SLOTTOK)};
        EpiSwiglu E{wsp<bf16_t>(F, WS_ACT), wsp<float>(F, WS_B1P), F.lds + SP_TILEE};
        pg8::gemm_phase<EpiSwiglu, SchedMoe<true>>(F.lds, 1024, S, E);
    }
    SEAM(6);
    if (IN(7)) {
        moe_tables(F);
        const LAS int* tstart = (const LAS int*)(F.lds + SP_TSTART);
        SchedMoe<false> S{(const char*)wsp<bf16_t>(F, WS_ACT), (const char*)wsp<bf16_t>(F, WS_W2), tstart[32], 4, F.G, cblk, (size_t)256 * 1024 * 2, (size_t)256 * 1024 * 2, (size_t)1024 * 1024 * 2,
                          F.lds + SP_TILEE, tstart, (const LAS int*)(F.lds + SP_CNT), wsp<unsigned>(F, WS_SLOTTOK)};
        EpiDown E{wsp<bf16_t>(F, WS_SLAB), F.b2, wsp<float>(F, WS_SLOTGATE), F.lds + SP_TILEE, tstart};
        pg8::gemm_phase<EpiDown, SchedMoe<false>>(F.lds, 1024, S, E);
    }
    SEAM(7);
    if (IN(8)) { moe_tables(F); p8_combine(F); }
#undef IN
#undef SEAM
}

extern "C" void kernel_launch(void* const* d_in, const int* in_sizes, int n_in, void* d_out, int out_size, void* d_ws, size_t ws_size, hipStream_t stream) {
    static int grid = 0;
    if (grid == 0) {
        if (n_in != 23 || in_sizes[0] != NTOK * DM || out_size != NTOK * DM || ws_size < WS_END) {
            fprintf(stderr, "kernel_launch: unexpected shapes: n_in %d in0 %d out %d ws %zu (need >= %zu)\n", n_in, n_in > 0 ? in_sizes[0] : -1, out_size, ws_size, (size_t)WS_END); grid = -1; return; }
        int dev = 0, cus = 0, per_cu = 0;
        if (hipGetDevice(&dev) != hipSuccess || hipDeviceGetAttribute(&cus, hipDeviceAttributeMultiprocessorCount, dev) != hipSuccess) { fprintf(stderr, "kernel_launch: device query failed\n"); grid = -1; return; }
        if (hipFuncSetAttribute((const void*)mk_fwd, hipFuncAttributeMaxDynamicSharedMemorySize, LDS_BYTES) != hipSuccess) { fprintf(stderr, "kernel_launch: hipFuncSetAttribute failed\n"); grid = -1; return; }
        if (hipOccupancyMaxActiveBlocksPerMultiprocessor(&per_cu, (const void*)mk_fwd, NWAVES * 64, LDS_BYTES) != hipSuccess || per_cu < 1) { fprintf(stderr, "kernel_launch: occupancy query says %d blocks per CU\n", per_cu); grid = -1; (void)hipGetLastError(); return; }
        grid = cus;
        if (grid % 8 != 0 || grid < 8) fprintf(stderr, "kernel_launch: note: %d CUs\n", grid);
    }
    if (grid < 0) return;
    if (hipMemsetAsync((char*)d_ws + WS_CTL, 0, CTL_ZERO_BYTES, stream) != hipSuccess) { fprintf(stderr, "kernel_launch: memset failed\n"); return; }
    Args a{};
    for (int i = 0; i < 23; ++i) a.in[i] = (const float*)d_in[i];
    a.out = (float*)d_out; a.ws = (unsigned char*)d_ws;
#if MK_SPLIT
    for (int p = 0; p < NPHASE; ++p) { a.ph_lo = p; a.ph_hi = p + 1; hipLaunchKernelGGL(mk_fwd, dim3(grid), dim3(NWAVES * 64), LDS_BYTES, stream, a); }
#else
    a.ph_lo = 0; a.ph_hi = NPHASE;
    void* kargs[] = {(void*)&a};
    const hipError_t le = hipLaunchCooperativeKernel((const void*)mk_fwd, dim3(grid), dim3(NWAVES * 64), kargs, LDS_BYTES, stream);
    if (le != hipSuccess) fprintf(stderr, "kernel_launch: cooperative launch failed: %s (grid %d)\n", hipGetErrorName(le), grid);
#endif
}
```

```cpp
#include <hip/hip_runtime.h>
#include <cstdio>
#include <cstdint>
#include <cmath>

#define LAS __attribute__((address_space(3)))
#define GAS __attribute__((address_space(1)))
typedef unsigned short bf16_t;
typedef short bf16x8 __attribute__((ext_vector_type(8)));
typedef short s16x4 __attribute__((ext_vector_type(4)));
typedef float f32x4 __attribute__((ext_vector_type(4)));
typedef float f32x2 __attribute__((ext_vector_type(2)));
typedef float f32x16 __attribute__((ext_vector_type(16)));
typedef unsigned u32x4 __attribute__((ext_vector_type(4)));
typedef unsigned u32x2 __attribute__((ext_vector_type(2)));
typedef GAS unsigned gu32;

#ifndef MK_SPLIT
#define MK_SPLIT 0
#endif

constexpr int NB = 8, SEQ = 4096, DM = 1024, NTOK = NB * SEQ;
constexpr int NEXP = 32, TOPK = 4, DFF = 1024, CAP = NTOK;
constexpr int NQKV = 1536;
constexpr int HSEQ = SEQ / 2;
constexpr float EPS = 1e-6f;
constexpr float LOG2E = 1.4426950408889634f;
constexpr float QSCALE = 0.125f * LOG2E;
constexpr float LAM_INIT = 0.2f;
constexpr int MAXTILES = (NTOK * TOPK) / 256 + NEXP;

constexpr size_t MiB = 1u << 20;
constexpr size_t WS_CTL = 0, CTL_ZERO_BYTES = 1 * MiB;
constexpr size_t WS_MOD = 1 * MiB;
constexpr size_t WS_VR = WS_MOD + 256 * 1024;
constexpr size_t WS_BTAB = WS_MOD + 320 * 1024;
constexpr size_t WS_B1P = WS_MOD + 512 * 1024;
constexpr size_t WS_TOKSLOT = 2 * MiB;
constexpr size_t WS_SLOTTOK = 4 * MiB;
constexpr size_t WS_SLOTGATE = 8 * MiB;
constexpr size_t WS_WQKV = 12 * MiB;
constexpr size_t WS_WCS = 15 * MiB;
constexpr size_t WS_WOUT = 17 * MiB;
constexpr size_t WS_ADFT = 20 * MiB;
constexpr size_t WS_W1 = 52 * MiB;
constexpr size_t WS_W2 = 180 * MiB;
constexpr size_t WS_XN = 256 * MiB;
constexpr size_t WS_XNSA = 320 * MiB;
constexpr size_t WS_Q = 384 * MiB, WS_K = 416 * MiB, WS_V = 448 * MiB;
constexpr size_t WS_BDFT = 480 * MiB;
constexpr size_t WS_AMIX = 512 * MiB;
constexpr size_t WS_ACT = 256 * MiB;
constexpr size_t WS_XN2 = 576 * MiB;
constexpr size_t WS_SLAB = 640 * MiB;
constexpr size_t WS_END = 912 * MiB;
static_assert(WS_ACT + (size_t)MAXTILES * 256 * 1024 * 2 <= WS_XN2 && WS_SLAB + (size_t)MAXTILES * 256 * 1024 * 2 <= WS_END, "d_ws map");
constexpr int CW_BAR = 4096;
constexpr int CW_GCNT = 8192;

constexpr int RING_BYTES = 131072;
constexpr int SP_OFF = RING_BYTES;
constexpr int SP_MISC = SP_OFF;
constexpr int SP_TSTART = SP_OFF + 256;
constexpr int SP_CNT = SP_OFF + 512;
constexpr int SP_TILEE = SP_OFF + 768;
constexpr int SP_BT = SP_OFF + 2048;
constexpr int SP_WS = SP_OFF + 3072;
constexpr int LDS_BYTES = 147456;
constexpr int NWAVES = 8;

__device__ __forceinline__ unsigned cvt_pk_bf16(float lo, float hi) { unsigned r; asm volatile("v_cvt_pk_bf16_f32 %0, %1, %2" : "=v"(r) : "v"(lo), "v"(hi)); return r; }
__device__ __forceinline__ float bf2f(unsigned short h) { return __uint_as_float((unsigned)h << 16); }
__device__ __forceinline__ float wave_sum(float v) {
#pragma unroll
    for (int o = 1; o < 64; o <<= 1) v += __shfl_xor(v, o);
    return v;
}
#define LDS_WAIT() asm volatile("s_waitcnt lgkmcnt(0)" ::: "memory")
#define VM_WAIT() asm volatile("s_waitcnt vmcnt(0)" ::: "memory")
#define RLX_AGENT __ATOMIC_RELAXED, __HIP_MEMORY_SCOPE_AGENT

namespace pg8 {
constexpr int BM = 256, BK = 64, HALF = 128, HTB = HALF * BK * 2, STAGE_BYTES = 8 * HTB, NXCD = 8, WGM = 8;
__host__ __device__ __forceinline__ int lds_byte(int r, int c) { const int st = (r >> 4) * 2 + (c >> 5), rr = r & 15, cc = c & 31, ob = rr * 64 + cc * 2; return st * 1024 + (ob ^ (((ob >> 9) & 1) << 5)); }
__host__ __device__ __forceinline__ void stage_rc(int b, int& R, int& C) { const int st = b / 1024, sb = b % 1024, swz = sb ^ (((sb >> 9) & 1) << 5); R = (st >> 1) * 16 + swz / 64; C = (st & 1) * 32 + (swz % 64) / 2; }
__host__ __device__ __forceinline__ int perm32(int rho) { const int n = rho >> 4, i = rho & 15; return 8 * (i >> 2) + 4 * n + (i & 3); }
struct Unit { int pm, pn; };

__device__ __forceinline__ bool static_unit(int i, int G, int c, int nM, int nN, Unit& u) {
    const int nwg = nM * nN; const long L = (long)i * G + c; if (L >= nwg) return false;
    int wgid = (int)L; { const int q = nwg / NXCD, r = nwg % NXCD, xcd = wgid % NXCD, off = wgid / NXCD; wgid = (xcd < r ? xcd * (q + 1) : r * (q + 1) + (xcd - r) * q) + off; }
    const int nig = WGM * nN, gid = wgid / nig, fm = gid * WGM, gsz = (nM - fm) < WGM ? (nM - fm) : WGM;
    u.pm = fm + ((wgid % nig) % gsz); u.pn = (wgid % nig) / gsz; return true;
}

template <class Epi, class Sched>
__device__ __forceinline__ void gemm_phase(LAS unsigned char* lds, const int K, const Sched& S, const Epi& E) {
    const int tid = threadIdx.x, wid = __builtin_amdgcn_readfirstlane(tid >> 6), lane = tid & 63, wr = wid >> 2, wc = wid & 3, fr = lane & 15, fq = lane >> 4;
    const int nt = K / BK;
    unsigned voffA[2], voffB[2]; int RA[2], CA[2];
#pragma unroll
    for (int i = 0; i < 2; ++i) { int R, C; stage_rc(tid * 16 + i * 8192, R, C); const int Rb = Epi::PERM ? ((R & ~31) + perm32(R & 31)) : R;
        voffA[i] = (unsigned)(R * K + C) * 2u; voffB[i] = (unsigned)(Rb * K + C) * 2u; RA[i] = R; CA[i] = C; }
    const size_t kstep = (size_t)(BK * 2);
    const size_t hstep = (size_t)HALF * K * 2;
    const unsigned ldsw = (unsigned)wid * 1024u;
    const int aoff = lds_byte(wr * 64 + fr, fq * 8), boff = lds_byte(wc * 32 + fr, fq * 8);
    unsigned cvo[2][2], nvo[2][2];
#define PG8_SA(b, h) (((b) * 2 + (h)) * HTB)
#define PG8_SB(b, h) ((4 + (b) * 2 + (h)) * HTB)
#define PG8_STAGE(bufoff, gbase, voff) do { _Pragma("unroll") for (int _i = 0; _i < 2; ++_i) \
        __builtin_amdgcn_global_load_lds((const unsigned*)((const char*)(gbase) + (voff)[_i]), (LAS unsigned*)(lds + (bufoff) + ldsw + _i * 8192), 16, 0, 0); } while (0)
#define PG8_STAGE_A(bufoff, ab, kb, h, nx) do { if constexpr (Sched::GATHER) { _Pragma("unroll") for (int _i = 0; _i < 2; ++_i) \
        __builtin_amdgcn_global_load_lds((const unsigned*)((ab) + (kb) + ((nx) ? nvo[h][_i] : cvo[h][_i])), (LAS unsigned*)(lds + (bufoff) + ldsw + _i * 8192), 16, 0, 0); } \
        else { PG8_STAGE(bufoff, (ab) + (kb) + (h) * hstep, voffA); } } while (0)
#define PG8_LDA(dst, b, h) do { _Pragma("unroll") for (int m = 0; m < 4; ++m) _Pragma("unroll") for (int k = 0; k < 2; ++k) dst[m][k] = *(const LAS bf16x8*)(lds + PG8_SA(b, h) + aoff + m * 2048 + k * 1024); } while (0)
#define PG8_LDB(dst, b, h) do { _Pragma("unroll") for (int n = 0; n < 2; ++n) _Pragma("unroll") for (int k = 0; k < 2; ++k) dst[n][k] = *(const LAS bf16x8*)(lds + PG8_SB(b, h) + boff + n * 2048 + k * 1024); } while (0)
#define PG8_MMA(ai, bj, At, Bt) do { __builtin_amdgcn_s_setprio(1); _Pragma("unroll") for (int m = 0; m < 4; ++m) _Pragma("unroll") for (int n = 0; n < 2; ++n) _Pragma("unroll") for (int k = 0; k < 2; ++k) \
        acc[ai][bj][m][n] = __builtin_amdgcn_mfma_f32_16x16x32_bf16(Bt[n][k], At[m][k], acc[ai][bj][m][n], 0, 0, 0); __builtin_amdgcn_s_setprio(0); } while (0)
#define PG8_WAIT_V(n) asm volatile("s_waitcnt vmcnt(" #n ")" ::: "memory")
#define PG8_WAIT_L(n) asm volatile("s_waitcnt lgkmcnt(" #n ")" ::: "memory")
#define PG8_BAR __builtin_amdgcn_s_barrier()
#define PG8_SCHED __builtin_amdgcn_sched_barrier(0)
    Unit cur, nxt; int ui = 0;
    if (!S.next(0, cur)) return;
    f32x4 acc[2][2][4][2];
#pragma unroll
    for (int a = 0; a < 2; ++a)
#pragma unroll
        for (int b = 0; b < 2; ++b)
#pragma unroll
            for (int m = 0; m < 4; ++m)
#pragma unroll
                for (int n = 0; n < 2; ++n) acc[a][b][m][n] = (f32x4){0.f, 0.f, 0.f, 0.f};
    bf16x8 At[4][2], B0[2][2], B1[2][2];
    const char* cA = S.a_ptr(cur); const char* cB = S.b_ptr(cur);
    if constexpr (Sched::GATHER) { int r[4]; S.a_rows(cur, RA[0], RA[1], r);
#pragma unroll
        for (int h = 0; h < 2; ++h)
#pragma unroll
            for (int i = 0; i < 2; ++i) { cvo[h][i] = (unsigned)(r[2 * h + i] * K + CA[i]) * 2u; nvo[h][i] = cvo[h][i]; } }
    PG8_STAGE(PG8_SB(0, 0), cB, voffB); PG8_STAGE(PG8_SB(0, 1), cB + hstep, voffB); PG8_STAGE_A(PG8_SA(0, 0), cA, 0, 0, false); PG8_STAGE_A(PG8_SA(0, 1), cA, 0, 1, false);
    if (wr == 1) PG8_BAR;
    PG8_WAIT_V(2); PG8_BAR;
    PG8_STAGE(PG8_SB(1, 0), cB + kstep, voffB); PG8_STAGE_A(PG8_SA(1, 0), cA, kstep, 0, false); PG8_STAGE(PG8_SB(1, 1), cB + hstep + kstep, voffB);
    PG8_WAIT_V(6); PG8_BAR;
    for (;;) {
        const bool has_next = S.next(ui + 1, nxt);
        const char* nA = has_next ? S.a_ptr(nxt) : cA; const char* nB = has_next ? S.b_ptr(nxt) : cB;
        if constexpr (Sched::GATHER) { if (has_next) { int r[4]; S.a_rows(nxt, RA[0], RA[1], r);
#pragma unroll
            for (int h = 0; h < 2; ++h)
#pragma unroll
                for (int i = 0; i < 2; ++i) nvo[h][i] = (unsigned)(r[2 * h + i] * K + CA[i]) * 2u; } }
        for (int t = 0; t < nt; t += 2) {
            const bool last = (t == nt - 2);
            const size_t k1 = (size_t)(t + 1) * kstep;
            const char* a2 = last ? nA : cA; const size_t k2 = last ? 0 : (size_t)(t + 2) * kstep; const char* b2 = last ? nB : cB + (size_t)(t + 2) * kstep;
            const size_t k3 = k2 + kstep; const char* b3 = b2 + kstep;
            PG8_LDB(B0, 0, 0); PG8_LDB(B1, 0, 1); PG8_SCHED; PG8_LDA(At, 0, 0); PG8_STAGE_A(PG8_SA(1, 1), cA, k1, 1, false);
            PG8_WAIT_V(8); PG8_WAIT_L(0); PG8_BAR; PG8_MMA(0, 0, At, B0); PG8_MMA(0, 1, At, B1); PG8_BAR; PG8_SCHED;
            PG8_LDA(At, 0, 1); PG8_STAGE(PG8_SB(0, 0), b2, voffB); PG8_STAGE(PG8_SB(0, 1), b2 + hstep, voffB); PG8_STAGE_A(PG8_SA(0, 0), a2, k2, 0, last);
            PG8_WAIT_V(8); PG8_WAIT_L(0); PG8_BAR; PG8_MMA(1, 0, At, B0); PG8_MMA(1, 1, At, B1); PG8_BAR; PG8_SCHED;
            PG8_LDB(B0, 1, 0); PG8_LDB(B1, 1, 1); PG8_SCHED; PG8_LDA(At, 1, 0); PG8_STAGE_A(PG8_SA(0, 1), a2, k2, 1, last);
            PG8_WAIT_V(8); PG8_WAIT_L(0); PG8_BAR; PG8_MMA(0, 0, At, B0); PG8_MMA(0, 1, At, B1); PG8_BAR; PG8_SCHED;
            PG8_LDA(At, 1, 1); PG8_STAGE(PG8_SB(1, 0), b3, voffB); PG8_STAGE(PG8_SB(1, 1), b3 + hstep, voffB); PG8_STAGE_A(PG8_SA(1, 0), a2, k3, 0, last);
            PG8_WAIT_V(8); PG8_WAIT_L(0); PG8_BAR; PG8_MMA(1, 0, At, B0); PG8_MMA(1, 1, At, B1); PG8_BAR; PG8_SCHED;
        }
        if (wr == 0) PG8_BAR;
        E(acc, cur, wr, wc, fr, fq);
        if (!has_next) break;
#pragma unroll
        for (int a = 0; a < 2; ++a)
#pragma unroll
            for (int b = 0; b < 2; ++b)
#pragma unroll
                for (int m = 0; m < 4; ++m)
#pragma unroll
                    for (int n = 0; n < 2; ++n) acc[a][b][m][n] = (f32x4){0.f, 0.f, 0.f, 0.f};
        cur = nxt; cA = nA; cB = nB; ++ui;
        if constexpr (Sched::GATHER) {
#pragma unroll
            for (int h = 0; h < 2; ++h)
#pragma unroll
                for (int i = 0; i < 2; ++i) cvo[h][i] = nvo[h][i]; }
        if (wr == 1) PG8_BAR;
    }
    PG8_WAIT_V(0);
    PG8_BAR;
#undef PG8_SA
#undef PG8_SB
#undef PG8_STAGE
#undef PG8_STAGE_A
#undef PG8_LDA
#undef PG8_LDB
#undef PG8_MMA
#undef PG8_WAIT_V
#undef PG8_WAIT_L
#undef PG8_BAR
#undef PG8_SCHED
}
}

#define XB_TMO      128
#define XB_XCNT(j)  (256  + 64 * (j))
#define XB_XSUB(j)  (1280 + 64 * (j))
#define XB_XGEN(j)  (2304 + 64 * (j))
#define XB_TOP      3328
#define XB_TOPGEN   3392
#define XCD_BAR_WORDS 3456
#define XB_SPIN_CAP (1u << 20)
__device__ __forceinline__ unsigned xb_ld(unsigned* p)              { return __hip_atomic_load(p, __ATOMIC_RELAXED, __HIP_MEMORY_SCOPE_AGENT); }
__device__ __forceinline__ unsigned xb_add(unsigned* p, unsigned v) { return __hip_atomic_fetch_add(p, v, __ATOMIC_RELAXED, __HIP_MEMORY_SCOPE_AGENT); }
__device__ __forceinline__ unsigned xb_xcc_id() { return (unsigned)__builtin_amdgcn_s_getreg((3 << 11) | 20) & 0xFu; }
#define XB_SPIN(cond, bar) do { unsigned _sp = 0; while (cond) { __builtin_amdgcn_s_sleep(1); \
    if ((++_sp & 255u) == 0u) { if (xb_ld(&(bar)[XB_TMO])) break; if (_sp > XB_SPIN_CAP) { atomicAdd(&(bar)[XB_TMO], 1u); break; } } } } while (0)
struct XcdBarrier { unsigned* bar; unsigned x; volatile LAS unsigned* st; };
__device__ __forceinline__ XcdBarrier xcd_barrier_post(unsigned* bar, volatile LAS unsigned* st) {
    XcdBarrier b; b.bar = bar; b.x = xb_xcc_id(); b.st = st;
    if (threadIdx.x == 0) (void)xb_add(&bar[XB_XCNT(b.x)], 1u);
    return b;
}
__device__ __forceinline__ void xcd_barrier_complete(unsigned* bar, unsigned x, unsigned& nloc, unsigned& nx) {
    const unsigned G = gridDim.x * gridDim.y * gridDim.z;
    unsigned sum, cnt, mine, sp = 0u;
    for (;;) {
        sum = 0u; cnt = 0u; mine = 0u;
#pragma unroll
        for (unsigned j = 0; j < 16; ++j) { const unsigned c = xb_ld(&bar[XB_XCNT(j)]); sum += c; cnt += (c > 0u) ? 1u : 0u; mine = (j == x) ? c : mine; }
        if (sum == G) break;
        __builtin_amdgcn_s_sleep(1);
        if ((++sp & 255u) == 0u) { if (xb_ld(&bar[XB_TMO])) break; if (sp > XB_SPIN_CAP) { atomicAdd(&bar[XB_TMO], 1u); break; } }
    }
    nloc = mine > 0u ? mine : 1u; nx = cnt > 0u ? cnt : 1u;
}
__device__ __forceinline__ void xcd_barrier(const XcdBarrier& b) {
    asm volatile("s_waitcnt vmcnt(0)" ::: "memory");
    __syncthreads();
    if (threadIdx.x == 0) {
        unsigned* bar = b.bar;
        __builtin_amdgcn_s_waitcnt(0);
        unsigned nloc = b.st[0], nx = b.st[1];
        if (nloc == 0u) { xcd_barrier_complete(bar, b.x, nloc, nx); b.st[0] = nloc; b.st[1] = nx; }
        const unsigned old = xb_add(&bar[XB_XSUB(b.x)], 1u);
        const unsigned gen = old / nloc;
        if (old + 1u == (gen + 1u) * nloc) {
            __builtin_amdgcn_fence(__ATOMIC_RELEASE, "agent");
            asm volatile("s_waitcnt vmcnt(0)" ::: "memory");
            const unsigned og = xb_add(&bar[XB_TOP], 1u);
            const unsigned tg = og / nx;
            if (og + 1u == (tg + 1u) * nx) xb_add(&bar[XB_TOPGEN], 1u);
            else XB_SPIN(xb_ld(&bar[XB_TOPGEN]) == tg, bar);
            __builtin_amdgcn_fence(__ATOMIC_ACQUIRE, "agent");
            xb_add(&bar[XB_XGEN(b.x)], 1u);
            asm volatile("s_waitcnt vmcnt(0)" ::: "memory");
        } else {
            XB_SPIN(xb_ld(&bar[XB_XGEN(b.x)]) == gen, bar);
            __builtin_amdgcn_fence(__ATOMIC_ACQUIRE, "agent");
            asm volatile("s_waitcnt vmcnt(0)" ::: "memory");
        }
    }
    __syncthreads();
}

struct Frame {
    LAS unsigned char* lds;
    volatile LAS unsigned* MISC;
    unsigned* ctl;
    int tid, lane, wave, vcu, G;
    const float *x, *c, *w_ada, *b_ada, *g_mix, *w_in, *w_fourier, *q_norm_g, *k_norm_g, *lq1, *lk1, *lq2, *lk2, *g_subln, *w_out, *rel_bias,
                *g_ffn, *w_router, *b_router, *w1, *b1, *w2, *b2;
    float* out;
    unsigned char* ws;
};
template <class T> __device__ __forceinline__ T* wsp(const Frame& F, size_t off) { return (T*)(F.ws + off); }

struct SchedPlain {
    static constexpr bool GATHER = false;
    const char* A; const char* Bt; int nM, nN, G, c; size_t tstep;
    __device__ __forceinline__ bool next(int i, pg8::Unit& u) const { return pg8::static_unit(i, G, c, nM, nN, u); }
    __device__ __forceinline__ const char* a_ptr(const pg8::Unit& u) const { return A + (size_t)u.pm * tstep; }
    __device__ __forceinline__ const char* b_ptr(const pg8::Unit& u) const { return Bt + (size_t)u.pn * tstep; }
    __device__ __forceinline__ void a_rows(const pg8::Unit&, int, int, int (&r)[4]) const { r[0] = r[1] = r[2] = r[3] = 0; }
};
struct SchedFourier {
    static constexpr bool GATHER = false;
    const char* A; const char* Bt; int G, c; size_t tstep;
    __device__ __forceinline__ bool next(int i, pg8::Unit& u) const {
        const int L = i * G + c; if (L >= 256) return false;
        const int w = (L % 8) * 32 + L / 8;
        const int half = w >> 7, r = w & 127; u.pm = 2 * half + (r & 1); u.pn = 64 * half + (r >> 1); return true; }
    __device__ __forceinline__ const char* a_ptr(const pg8::Unit& u) const { return A + (size_t)u.pm * tstep; }
    __device__ __forceinline__ const char* b_ptr(const pg8::Unit& u) const { return Bt + (size_t)u.pn * tstep; }
    __device__ __forceinline__ void a_rows(const pg8::Unit&, int, int, int (&r)[4]) const { r[0] = r[1] = r[2] = r[3] = 0; }
};
template <bool GATHER_> struct SchedMoe {
    static constexpr bool GATHER = GATHER_;
    const char* A; const char* Bt; int nM, nN, G, c; size_t a_tstep, b_tstep, e_stride;
    const LAS unsigned char* tile_e; const LAS int* tstart; const LAS int* cnt; const unsigned* slot_tok;
    __device__ __forceinline__ bool next(int i, pg8::Unit& u) const { return pg8::static_unit(i, G, c, nM, nN, u); }
    __device__ __forceinline__ const char* a_ptr(const pg8::Unit& u) const { return GATHER_ ? A : A + (size_t)u.pm * a_tstep; }
    __device__ __forceinline__ const char* b_ptr(const pg8::Unit& u) const { const int e = tile_e[u.pm]; return Bt + (size_t)e * e_stride + (size_t)u.pn * b_tstep; }
    __device__ __forceinline__ void a_rows(const pg8::Unit& u, int R0, int R1, int (&r)[4]) const {
        const int e = tile_e[u.pm]; const int s0 = (u.pm - tstart[e]) * 256, n = cnt[e];
#pragma unroll
        for (int h = 0; h < 2; ++h)
#pragma unroll
            for (int i = 0; i < 2; ++i) { const int s = s0 + h * 128 + (i ? R1 : R0); r[2 * h + i] = (s < n) ? (int)slot_tok[(size_t)e * CAP + s] : 0; }
    }
};

typedef const f32x4 (&AccRef)[2][2][4][2];
__device__ __forceinline__ u32x4 pack8(f32x4 a, f32x4 b) { u32x4 w; w.x = cvt_pk_bf16(a[0], a[1]); w.y = cvt_pk_bf16(a[2], a[3]); w.z = cvt_pk_bf16(b[0], b[1]); w.w = cvt_pk_bf16(b[2], b[3]); return w; }

struct EpiQKV {
    static constexpr bool PERM = true;
    bf16_t *Q, *Kb, *V; const float *gq, *gk;
    __device__ __forceinline__ void operator()(AccRef acc, const pg8::Unit& u, int wr, int wc, int fr, int fq) const {
        const int sec = u.pn >> 1, row0 = u.pm * 256 + wr * 64 + fr;
        if (sec < 2) {
            bf16_t* O = sec == 0 ? Q : Kb; const float* g = sec == 0 ? gq : gk; const float sc = sec == 0 ? QSCALE : 1.0f;
            f32x4 gl[2][2];
#pragma unroll
            for (int bj = 0; bj < 2; ++bj)
#pragma unroll
                for (int n = 0; n < 2; ++n) gl[bj][n] = *(const f32x4*)(g + 32 * bj + 8 * fq + 4 * n);
#pragma unroll
            for (int ai = 0; ai < 2; ++ai)
#pragma unroll
                for (int m = 0; m < 4; ++m) {
                    float ss = 0.f;
#pragma unroll
                    for (int bj = 0; bj < 2; ++bj)
#pragma unroll
                        for (int n = 0; n < 2; ++n) { const f32x4 v = acc[ai][bj][m][n]; ss += (v[0] * v[0] + v[1] * v[1]) + (v[2] * v[2] + v[3] * v[3]); }
                    ss += __shfl_xor(ss, 16); ss += __shfl_xor(ss, 32);
                    const float rr = rsqrtf(ss * (1.0f / 64.0f) + EPS) * sc;
                    bf16_t* rowp = O + (size_t)(row0 + ai * 128 + m * 16) * 512 + (u.pn & 1) * 256 + 64 * wc + 8 * fq;
#pragma unroll
                    for (int bj = 0; bj < 2; ++bj) *(u32x4*)(rowp + 32 * bj) = pack8(acc[ai][bj][m][0] * rr * gl[bj][0], acc[ai][bj][m][1] * rr * gl[bj][1]);
                }
        } else {
#pragma unroll
            for (int ai = 0; ai < 2; ++ai)
#pragma unroll
                for (int m = 0; m < 4; ++m) { bf16_t* rowp = V + (size_t)(row0 + ai * 128 + m * 16) * 512 + (u.pn & 1) * 256 + 32 * wc + 8 * fq;
#pragma unroll
                    for (int bj = 0; bj < 2; ++bj) *(u32x4*)(rowp + 128 * bj) = pack8(acc[ai][bj][m][0], acc[ai][bj][m][1]); }
        }
    }
};
struct EpiFourier {
    static constexpr bool PERM = true;
    bf16_t* Bdft; const float* vr;
    __device__ __forceinline__ void operator()(AccRef acc, const pg8::Unit& u, int wr, int wc, int fr, int fq) const {
        const int half = u.pm >> 1, pnl = u.pn - 64 * half, b = pnl >> 3, j0 = (pnl & 7) * 256;
        const int n0 = (u.pm & 1) * 256 + wr * 64 + fr;
        const bool patch = (half == 1) && (j0 == 0) && (wc == 0) && (fq == 0);
#pragma unroll
        for (int ai = 0; ai < 2; ++ai)
#pragma unroll
            for (int m = 0; m < 4; ++m) { const int n = n0 + ai * 128 + m * 16;
                bf16_t* rowp = Bdft + (size_t)(b * 512 + n) * 4096 + half * 2048 + j0 + 32 * wc + 8 * fq;
#pragma unroll
                for (int bj = 0; bj < 2; ++bj) { f32x4 v0 = acc[ai][bj][m][0]; if (patch && bj == 0) v0[0] = vr[b * 512 + n];
                    *(u32x4*)(rowp + 128 * bj) = pack8(v0, acc[ai][bj][m][1]); } }
    }
};
struct EpiDft {
    static constexpr bool PERM = true;
    bf16_t* Amix;
    __device__ __forceinline__ void operator()(AccRef acc, const pg8::Unit& u, int wr, int wc, int fr, int fq) const {
        const int b = u.pn >> 1, col0 = (u.pn & 1) * 256 + 32 * wc + 8 * fq, k0 = u.pm * 256 + wr * 64 + fr;
#pragma unroll
        for (int ai = 0; ai < 2; ++ai)
#pragma unroll
            for (int m = 0; m < 4; ++m) { bf16_t* rowp = Amix + (size_t)(b * 4096 + k0 + ai * 128 + m * 16) * 1024 + col0;
#pragma unroll
                for (int bj = 0; bj < 2; ++bj) *(u32x4*)(rowp + 128 * bj) = pack8(acc[ai][bj][m][0], acc[ai][bj][m][1]); }
    }
};
struct EpiOut {
    static constexpr bool PERM = false;
    const float* x; const float* mod; float* out;
    __device__ __forceinline__ void operator()(AccRef acc, const pg8::Unit& u, int wr, int wc, int fr, int fq) const {
        const int row0 = u.pm * 256 + wr * 64 + fr, col0 = u.pn * 256 + wc * 32 + 4 * fq, b = (u.pm * 256) >> 12;
        f32x4 gt[2][2];
#pragma unroll
        for (int bj = 0; bj < 2; ++bj)
#pragma unroll
            for (int n = 0; n < 2; ++n) gt[bj][n] = *(const f32x4*)(mod + b * 6144 + 2048 + col0 + bj * 128 + n * 16);
#pragma unroll
        for (int ai = 0; ai < 2; ++ai)
#pragma unroll
            for (int m = 0; m < 4; ++m) { const size_t off = (size_t)(row0 + ai * 128 + m * 16) * 1024 + col0;
#pragma unroll
                for (int bj = 0; bj < 2; ++bj)
#pragma unroll
                    for (int n = 0; n < 2; ++n) { const f32x4 xv = *(const f32x4*)(x + off + bj * 128 + n * 16); *(f32x4*)(out + off + bj * 128 + n * 16) = xv + gt[bj][n] * acc[ai][bj][m][n]; } }
    }
};
struct EpiSwiglu {
    static constexpr bool PERM = true;
    bf16_t* act; const float* b1p; const LAS unsigned char* tile_e;
    __device__ __forceinline__ void operator()(AccRef acc, const pg8::Unit& u, int wr, int wc, int fr, int fq) const {
        const int e = tile_e[u.pm]; const int row0 = u.pm * 256 + wr * 64 + fr, pc = 32 * wc + 8 * fq;
        const float* bp = b1p + e * 2048 + u.pn * 256 + pc;
        f32x4 bg[2], bl[2];
#pragma unroll
        for (int n = 0; n < 2; ++n) { bg[n] = *(const f32x4*)(bp + 4 * n); bl[n] = *(const f32x4*)(bp + 128 + 4 * n); }
#pragma unroll
        for (int ai = 0; ai < 2; ++ai)
#pragma unroll
            for (int m = 0; m < 4; ++m) { f32x4 o[2];
#pragma unroll
                for (int n = 0; n < 2; ++n) { const f32x4 g = acc[ai][0][m][n] + bg[n], l = acc[ai][1][m][n] + bl[n];
#pragma unroll
                    for (int i = 0; i < 4; ++i) { const float gg = fminf(g[i], 7.0f), ll = fminf(fmaxf(l[i], -7.0f), 7.0f);
                        const float sg = __builtin_amdgcn_rcpf(1.0f + __builtin_amdgcn_exp2f(-1.702f * LOG2E * gg)); o[n][i] = gg * sg * (ll + 1.0f); } }
                *(u32x4*)(act + (size_t)(row0 + ai * 128 + m * 16) * 1024 + u.pn * 128 + pc) = pack8(o[0], o[1]); }
    }
};
struct EpiDown {
    static constexpr bool PERM = true;
    bf16_t* slab; const float* b2; const float* slot_gate; const LAS unsigned char* tile_e; const LAS int* tstart;
    __device__ __forceinline__ void operator()(AccRef acc, const pg8::Unit& u, int wr, int wc, int fr, int fq) const {
        const int e = tile_e[u.pm]; const int rl = wr * 64 + fr, col0 = u.pn * 256 + 32 * wc + 8 * fq;
        const float* gp = slot_gate + (size_t)e * CAP + (u.pm - tstart[e]) * 256 + rl;
        f32x4 bv[2][2];
#pragma unroll
        for (int bj = 0; bj < 2; ++bj)
#pragma unroll
            for (int n = 0; n < 2; ++n) bv[bj][n] = *(const f32x4*)(b2 + e * 1024 + col0 + 128 * bj + 4 * n);
#pragma unroll
        for (int ai = 0; ai < 2; ++ai)
#pragma unroll
            for (int m = 0; m < 4; ++m) { const float gate = gp[ai * 128 + m * 16];
                bf16_t* rowp = slab + (size_t)(u.pm * 256 + rl + ai * 128 + m * 16) * 1024 + col0;
#pragma unroll
                for (int bj = 0; bj < 2; ++bj) *(u32x4*)(rowp + 128 * bj) = pack8((acc[ai][bj][m][0] + bv[bj][0]) * gate, (acc[ai][bj][m][1] + bv[bj][1]) * gate); }
    }
};

namespace att {
constexpr int QB = 256, KVB = 64, NT = SEQ / KVB;
constexpr int L_K = 0, L_V = 32768, L_Q = 65536;
#define SBAR() __builtin_amdgcn_sched_barrier(0)
__device__ __forceinline__ int crow(int r, int hi) { return (r & 3) + 8 * (r >> 2) + 4 * hi; }
__device__ __forceinline__ int swap23(int k) { return (k & ~0xC) | ((k & 4) << 1) | ((k & 8) >> 1); }
__device__ __forceinline__ int v_rd_base(int lane) { return ((lane & 3) << 3) | (((lane >> 2) & 3) << 6) | (((lane >> 4) & 1) << 5) | (((lane >> 5) & 1) << 8); }
constexpr int v_rd_off(int d0, int ks, int half) { return d0 * 512 + ks * 4096 + half * 2048; }
template <int OFF> __device__ __forceinline__ s16x4 tr_read(int vb) { s16x4 r; asm volatile("ds_read_b64_tr_b16 %0, %1 offset:%2" : "=&v"(r) : "v"(vb), "i"(OFF) : "memory"); return r; }
#define PKV(L, H) (bf16x8){L[0], L[1], L[2], L[3], H[0], H[1], H[2], H[3]}
template <int D0, int KB> __device__ __forceinline__ void pv_half(f32x16& oa, f32x16& ob, int vb, const bf16x8 (&pa)[2], const bf16x8 (&pb)[2]) {
    const s16x4 l0 = tr_read<v_rd_off(D0, 2 * KB, 0)>(vb), h0 = tr_read<v_rd_off(D0, 2 * KB, 1)>(vb), l1 = tr_read<v_rd_off(D0, 2 * KB + 1, 0)>(vb), h1 = tr_read<v_rd_off(D0, 2 * KB + 1, 1)>(vb);
    asm volatile("s_waitcnt lgkmcnt(0)" ::: "memory"); SBAR();
    oa = __builtin_amdgcn_mfma_f32_32x32x16_bf16(pa[0], PKV(l0, h0), oa, 0, 0, 0);
    ob = __builtin_amdgcn_mfma_f32_32x32x16_bf16(pb[0], PKV(l0, h0), ob, 0, 0, 0);
    oa = __builtin_amdgcn_mfma_f32_32x32x16_bf16(pa[1], PKV(l1, h1), oa, 0, 0, 0);
    ob = __builtin_amdgcn_mfma_f32_32x32x16_bf16(pb[1], PKV(l1, h1), ob, 0, 0, 0);
}
__device__ __forceinline__ void qkt(f32x16& p, const LAS unsigned char* kb, const LAS unsigned char* qb, const int (&co)[4], int off) {
    p = f32x16{};
#pragma unroll
    for (int d0 = 0; d0 < 4; ++d0) {
        const bf16x8 k0 = *(const LAS bf16x8*)(kb + co[d0] + off), qf = *(const LAS bf16x8*)(qb + co[d0] + (off & 255));
        p = __builtin_amdgcn_mfma_f32_32x32x16_bf16(k0, qf, p, 0, 0, 0);
    }
}
__device__ __forceinline__ void add_bias(f32x16& p, const LAS float* bt, int relb, int hi) {
#pragma unroll
    for (int r = 0; r < 16; ++r) { const int i0 = relb + crow(r, hi); p[r] += bt[i0 < 0 ? 0 : (i0 > 254 ? 254 : i0)]; }
}
__device__ __forceinline__ float softmax_pack(f32x16& p, bf16x8 (&pa)[2]) {
#pragma unroll
    for (int r = 0; r < 16; ++r) p[r] = __builtin_amdgcn_exp2f(p[r]);
    float ps = 0.f;
#pragma unroll
    for (int r = 0; r < 16; ++r) ps += p[r];
#define PK4(P, BASE, OUT) do { unsigned a0 = cvt_pk_bf16(P[BASE + 0], P[BASE + 1]), a1 = cvt_pk_bf16(P[BASE + 2], P[BASE + 3]); \
    unsigned b0 = cvt_pk_bf16(P[BASE + 4], P[BASE + 5]), b1 = cvt_pk_bf16(P[BASE + 6], P[BASE + 7]); \
    auto r0 = __builtin_amdgcn_permlane32_swap(a0, b0, false, false); auto r1 = __builtin_amdgcn_permlane32_swap(a1, b1, false, false); \
    u32x4 w = {r0[0], r1[0], r0[1], r1[1]}; OUT = __builtin_bit_cast(bf16x8, w); } while (0)
    PK4(p, 0, pa[0]); PK4(p, 8, pa[1]);
#undef PK4
    return ps;
}

struct Tensors { const bf16_t *Q, *K, *V; bf16_t* Amix; const float* btab; const float* gsub; float lam; };

__device__ __forceinline__ void attn_unit(LAS unsigned char* lds, const Tensors& T, int b, int h, int qb) {
    int tid_ = threadIdx.x; asm volatile("" : "+v"(tid_));
    const int tid = tid_, lane = tid & 63, r32 = lane & 31, hi = lane >> 5; const int wid = __builtin_amdgcn_readfirstlane(tid >> 6);
    const size_t rowbase = (size_t)b * SEQ; const int q0 = qb * QB;
    const bf16_t* Kh = T.K + rowbase * 512 + h * 128; const bf16_t* Vh = T.V + rowbase * 512 + h * 128; const bf16_t* Qh = T.Q + (rowbase + q0) * 512 + h * 128;
    LAS float* bt = (LAS float*)(lds + SP_BT); LAS float* wsf = (LAS float*)(lds + SP_WS) + wid * 64;
    unsigned ksrc[2], vsrc[2];
#pragma unroll
    for (int i = 0; i < 2; ++i) { const int p = wid * 2 + i; const int row = 4 * p + (lane >> 4), ch = (lane & 15) ^ (row & 7); ksrc[i] = (unsigned)(row * 512 + ch * 8) * 2u;
        const int st = 2 * p + (lane >> 5), kk = (st >> 2) * 8 + ((lane & 31) >> 2), cc = (st & 3) * 32 + (lane & 3) * 8; vsrc[i] = (unsigned)(swap23(kk) * 512 + cc) * 2u; }
    const unsigned ldsw = (unsigned)wid * 2048u;
#define DMA_TILE(t, buf) do { const char* kg = (const char*)(Kh + (size_t)(t) * KVB * 512); const char* vg = (const char*)(Vh + (size_t)(t) * KVB * 512); \
    _Pragma("unroll") for (int _i = 0; _i < 2; ++_i) { \
        __builtin_amdgcn_global_load_lds((const unsigned*)(kg + ksrc[_i]), (LAS unsigned*)(lds + L_K + (buf) * 16384 + ldsw + _i * 1024), 16, 0, 0); \
        __builtin_amdgcn_global_load_lds((const unsigned*)(vg + vsrc[_i]), (LAS unsigned*)(lds + L_V + (buf) * 16384 + ldsw + _i * 1024), 16, 0, 0); } } while (0)
    { int lq = lane; asm volatile("" : "+v"(lq));
      const int rq = lq >> 4; const unsigned qo0 = (unsigned)((32 * wid + rq) * 512 + (((lq & 15) ^ (rq & 7)) << 3)) * 2u, qo1 = (unsigned)((32 * wid + 4 + rq) * 512 + (((lq & 15) ^ ((4 + rq) & 7)) << 3)) * 2u;
#pragma unroll
      for (int i = 0; i < 8; ++i) { const int p = wid * 8 + i;
        __builtin_amdgcn_global_load_lds((const unsigned*)((const char*)Qh + ((i & 1) ? qo1 : qo0) + (size_t)(i >> 1) * 8192), (LAS unsigned*)(lds + L_Q + p * 1024), 16, 0, 0); } }
    DMA_TILE(0, 0);
    if (tid < 255) bt[tid] = T.btab[h * 256 + tid];
    int co[4];
#pragma unroll
    for (int d0 = 0; d0 < 4; ++d0) co[d0] = r32 * 256 + (((2 * d0 + hi) ^ (r32 & 7)) << 4);
    const LAS unsigned char* qbase = lds + L_Q + wid * 8192;
    const int vb0 = (int)(uintptr_t)(lds + L_V) + v_rd_base(lane);
    f32x16 o1[4], o2[4];
#pragma unroll
    for (int d = 0; d < 4; ++d) { o1[d] = f32x16{}; o2[d] = f32x16{}; }
    float l1 = 0.f, l2 = 0.f;
    const int qw = q0 + wid * 32;
    int state = (qw >= 154) ? 0 : 1;
    __syncthreads();
    for (int t = 0; t < NT; ++t) {
        const int buf = t & 1;
        if (t + 1 < NT) DMA_TILE(t + 1, buf ^ 1);
        const int k0 = t * KVB;
        const bool isneg = (k0 <= qw - 154), ispos = (k0 >= qw + 122);
        if (state == 0 && !isneg) { const float f = __builtin_amdgcn_exp2f(bt[0]); state = 1;
#pragma unroll
            for (int d = 0; d < 4; ++d) { o1[d] *= f; o2[d] *= f; }
            l1 *= f; l2 *= f; }
        if (state == 1 && ispos) { const float f = __builtin_amdgcn_exp2f(-bt[254]); state = 2;
#pragma unroll
            for (int d = 0; d < 4; ++d) { o1[d] *= f; o2[d] *= f; }
            l1 *= f; l2 *= f; }
        const LAS unsigned char* kbuf = lds + L_K + buf * 16384;
        const int vb = vb0 + buf * 16384; const int relb = k0 - (qw + r32) + 127;
        f32x16 p; bf16x8 pa[2], pb[2];
        qkt(p, kbuf, qbase, co, 0); if (state == 1) add_bias(p, bt, relb, hi); l1 += softmax_pack(p, pa);
        qkt(p, kbuf, qbase, co, 128); if (state == 1) add_bias(p, bt, relb, hi); l2 += softmax_pack(p, pb);
        pv_half<0, 0>(o1[0], o2[0], vb, pa, pb); pv_half<1, 0>(o1[1], o2[1], vb, pa, pb); pv_half<2, 0>(o1[2], o2[2], vb, pa, pb); pv_half<3, 0>(o1[3], o2[3], vb, pa, pb);
        qkt(p, kbuf, qbase, co, 8192); if (state == 1) add_bias(p, bt, relb + 32, hi); l1 += softmax_pack(p, pa);
        qkt(p, kbuf, qbase, co, 8192 + 128); if (state == 1) add_bias(p, bt, relb + 32, hi); l2 += softmax_pack(p, pb);
        pv_half<0, 1>(o1[0], o2[0], vb, pa, pb); pv_half<1, 1>(o1[1], o2[1], vb, pa, pb); pv_half<2, 1>(o1[2], o2[2], vb, pa, pb); pv_half<3, 1>(o1[3], o2[3], vb, pa, pb);
        __syncthreads();
    }
#undef DMA_TILE
    l1 += __shfl_xor(l1, 32); l2 += __shfl_xor(l2, 32);
    if (hi == 0) { wsf[r32] = 1.0f / l1; wsf[32 + r32] = T.lam / l2; }
    LDS_WAIT();
    float gs[4];
#pragma unroll
    for (int d = 0; d < 4; ++d) gs[d] = T.gsub[32 * d + r32] * (1.0f - LAM_INIT);
    bf16_t* Ow = T.Amix + (rowbase + q0 + wid * 32 + 4 * hi) * 1024 + 512 + h * 128 + r32; asm volatile("" : "+v"(Ow));
#pragma unroll
    for (int r = 0; r < 16; ++r) { const int row = crow(r, hi); const float c1 = wsf[row], c2 = wsf[32 + row];
        float y[4], ss = 0.f;
#pragma unroll
        for (int d = 0; d < 4; ++d) { y[d] = o1[d][r] * c1 - o2[d][r] * c2; ss += y[d] * y[d]; }
        ss += __shfl_xor(ss, 1); ss += __shfl_xor(ss, 2); ss += __shfl_xor(ss, 4); ss += __shfl_xor(ss, 8); ss += __shfl_xor(ss, 16);
        const float rr = rsqrtf(ss * (1.0f / 128.0f) + EPS);
#pragma unroll
        for (int d = 0; d < 4; ++d) Ow[(size_t)((r & 3) + 8 * (r >> 2)) * 1024 + 32 * d] = (bf16_t)(cvt_pk_bf16(y[d] * rr * gs[d], 0.f) & 0xffffu); }
    __syncthreads();
}
#undef SBAR
#undef PKV
}

__device__ __forceinline__ void tr_item(const float* W, int ldw, bf16_t* WT, int ldt, LAS float* scr, int lane) {
#pragma unroll 8
    for (int i = 0; i < 32; ++i) { const int kk = 2 * i + (lane >> 5); scr[kk * 33 + (lane & 31)] = W[(size_t)kk * ldw + (lane & 31)]; }
    LDS_WAIT(); asm volatile("" ::: "memory");
    const int c = lane & 7;
#pragma unroll
    for (int j = 0; j < 4; ++j) { const int n = (lane >> 3) + 8 * j; const LAS float* s = scr + (8 * c) * 33 + n;
        u32x4 o; o.x = cvt_pk_bf16(s[0 * 33], s[1 * 33]); o.y = cvt_pk_bf16(s[2 * 33], s[3 * 33]); o.z = cvt_pk_bf16(s[4 * 33], s[5 * 33]); o.w = cvt_pk_bf16(s[6 * 33], s[7 * 33]);
        *(u32x4*)(WT + (size_t)n * ldt + 8 * c) = o; }
    LDS_WAIT(); asm volatile("" ::: "memory");
}
__device__ __forceinline__ void tr_w1_item(const float* W, bf16_t* WT, int kc, int nc, LAS float* scr, int lane) {
    const float* src = W + (size_t)(kc * 32) * 2048 + nc * 64 + lane;
#pragma unroll 8
    for (int kk = 0; kk < 32; ++kk) scr[kk * 65 + lane] = src[(size_t)kk * 2048];
    LDS_WAIT(); asm volatile("" ::: "memory");
    const int pn = nc >> 2, p0 = 32 * (nc & 3);
    const int nl = (lane < 32) ? 2 * lane : 2 * (lane - 32) + 1, prow = pn * 256 + ((lane < 32) ? (p0 + lane) : (128 + p0 + lane - 32));
    bf16_t* dst = WT + (size_t)prow * 1024 + kc * 32;
#pragma unroll
    for (int q = 0; q < 4; ++q) { const LAS float* s = scr + (8 * q) * 65 + nl;
        u32x4 o; o.x = cvt_pk_bf16(s[0 * 65], s[1 * 65]); o.y = cvt_pk_bf16(s[2 * 65], s[3 * 65]); o.z = cvt_pk_bf16(s[4 * 65], s[5 * 65]); o.w = cvt_pk_bf16(s[6 * 65], s[7 * 65]);
        *(u32x4*)(dst + 8 * q) = o; }
    LDS_WAIT(); asm volatile("" ::: "memory");
}
__device__ __forceinline__ int qk_logical(int p) { return 64 * ((p >> 5) & 3) + 32 * (p >> 7) + (p & 31); }

__device__ __forceinline__ int t5_bucket_idx(int rel) {
    const int ret = rel > 0 ? 16 : 0; const int n = rel < 0 ? -rel : rel;
    const float nf = (float)(n < 1 ? 1 : n);
    int large = 8 + (int)(logf(nf / 8.0f) / logf(16.0f) * 8.0f); large = large < 15 ? large : 15;
    if (n == 16) large = 10; if (n == 32) large = 12; if (n == 64) large = 14;
    return ret + (n < 8 ? n : large);
}

constexpr int P0_SCR = 10240;
constexpr int P0_CTAB = 8 * P0_SCR;
__device__ __forceinline__ void p0_prologue(Frame& F) {
    LAS float* scr = (LAS float*)(F.lds + F.wave * P0_SCR);
    LAS float* ctab = (LAS float*)(F.lds + P0_CTAB);
    for (int m = F.tid; m < 4096; m += 512) ctab[m] = cospif((float)m * (1.0f / 2048.0f));
    __syncthreads();
    const int gw = F.vcu * NWAVES + F.wave, NGW = F.G * NWAVES, lane = F.lane;
    constexpr int I_MOD = 96, I_QKV = 16 * 48, I_WOUT = 8 * 32, I_W2 = 32 * 16 * 32, I_W1 = 32 * 32 * 32, I_FCS = 256, I_FOUT = 512, I_ADFT = 4096, I_MISC = 65;
    constexpr int NITEMS = I_MOD + I_QKV + I_WOUT + I_FCS + I_FOUT + I_MISC + I_ADFT + I_W2 + I_W1;
    float* mod = wsp<float>(F, WS_MOD);
    for (int it = gw; it < NITEMS; it += NGW) {
        int r = it;
        if (r < I_MOD) {
            const int col = r * 64 + lane; float acc[8];
#pragma unroll
            for (int b = 0; b < 8; ++b) acc[b] = 0.f;
            for (int kc = 0; kc < 16; ++kc) {
#pragma unroll
                for (int b = 0; b < 8; ++b) { const float cv = F.c[b * 1024 + kc * 64 + lane]; scr[lane * 8 + b] = cv / (1.0f + __expf(-cv)); }
                LDS_WAIT(); asm volatile("" ::: "memory");
#pragma unroll 8
                for (int kk = 0; kk < 64; ++kk) { const float w = F.w_ada[(size_t)(kc * 64 + kk) * 6144 + col];
                    const f32x4 s0 = *(const LAS f32x4*)(scr + kk * 8), s1 = *(const LAS f32x4*)(scr + kk * 8 + 4);
                    acc[0] += s0[0] * w; acc[1] += s0[1] * w; acc[2] += s0[2] * w; acc[3] += s0[3] * w; acc[4] += s1[0] * w; acc[5] += s1[1] * w; acc[6] += s1[2] * w; acc[7] += s1[3] * w; }
                LDS_WAIT(); asm volatile("" ::: "memory");
            }
            const float bb = F.b_ada[col];
#pragma unroll
            for (int b = 0; b < 8; ++b) mod[b * 6144 + col] = acc[b] + bb;
            continue; }
        r -= I_MOD;
        if (r < I_QKV) {
            const int kb = r / 48, nb = r % 48, prow = nb * 32, tile = prow >> 8, p = prow & 255;
            const int lcol = 512 + tile * 256 + (tile < 4 ? qk_logical(p) : p);
            tr_item(F.w_in + (size_t)(kb * 64) * 2048 + lcol, 2048, wsp<bf16_t>(F, WS_WQKV) + (size_t)prow * 1024 + kb * 64, 1024, scr, lane);
            continue; }
        r -= I_QKV;
        if (r < I_WOUT) {
            const int kb = r / 32, nb = r % 32;
            tr_item(F.w_out + (size_t)(512 + kb * 64) * 1024 + nb * 32, 1024, wsp<bf16_t>(F, WS_WOUT) + (size_t)(nb * 32) * 1024 + 512 + kb * 64, 1024, scr, lane);
            continue; }
        r -= I_WOUT;
        if (r < I_FCS) {
            const int g = r >> 6, d0 = (r & 63) * 16;
#pragma unroll
            for (int dd = 0; dd < 16; ++dd) { scr[dd * 129 + lane] = F.w_in[(size_t)(d0 + dd) * 2048 + g * 128 + lane]; scr[dd * 129 + 64 + lane] = F.w_in[(size_t)(d0 + dd) * 2048 + g * 128 + 64 + lane]; }
            LDS_WAIT(); asm volatile("" ::: "memory");
            const int d = lane & 15, kq = lane >> 4; float ac[32], as[32];
#pragma unroll
            for (int i = 0; i < 32; ++i) { ac[i] = 0.f; as[i] = 0.f; }
            for (int c = 0; c < 128; ++c) { const float a = scr[d * 129 + c];
#pragma unroll
                for (int i = 0; i < 32; ++i) { const int idx = (c * (kq * 32 + i)) & 127; ac[i] += a * ctab[idx * 32]; as[i] += a * ctab[((idx - 32) & 127) * 32]; } }
            const float sc = 0.08838834764831845f;
            bf16_t* wc = wsp<bf16_t>(F, WS_WCS);
#pragma unroll
            for (int i = 0; i < 32; ++i) { const int n = g * 128 + kq * 32 + i;
                wc[(size_t)n * 1024 + d0 + d] = (bf16_t)(cvt_pk_bf16(ac[i] * sc, 0.f) & 0xffffu); wc[(size_t)(512 + n) * 1024 + d0 + d] = (bf16_t)(cvt_pk_bf16(-as[i] * sc, 0.f) & 0xffffu); }
            LDS_WAIT(); asm volatile("" ::: "memory");
            continue; }
        r -= I_FCS;
        if (r < I_FOUT) {
            const int g = r >> 7, dc = (r >> 3) & 15, kc0 = (r & 7) * 16;
#pragma unroll
            for (int i = 0; i < 16; ++i) { scr[i * 128 + lane] = F.w_fourier[(size_t)(g * 128 + kc0 + i) * 128 + lane]; scr[i * 128 + 64 + lane] = F.w_fourier[(size_t)(g * 128 + kc0 + i) * 128 + 64 + lane]; }
            LDS_WAIT(); asm volatile("" ::: "memory");
            float acc[16];
#pragma unroll
            for (int i = 0; i < 16; ++i) acc[i] = 0.f;
            const int dout = dc * 64 + lane;
#pragma unroll 4
            for (int d = 0; d < 128; ++d) { const float a = F.w_out[(size_t)(g * 128 + d) * 1024 + dout];
#pragma unroll
                for (int i = 0; i < 16; ++i) acc[i] += scr[i * 128 + d] * a; }
            u32x4 o0, o1; o0.x = cvt_pk_bf16(acc[0], acc[1]); o0.y = cvt_pk_bf16(acc[2], acc[3]); o0.z = cvt_pk_bf16(acc[4], acc[5]); o0.w = cvt_pk_bf16(acc[6], acc[7]);
            o1.x = cvt_pk_bf16(acc[8], acc[9]); o1.y = cvt_pk_bf16(acc[10], acc[11]); o1.z = cvt_pk_bf16(acc[12], acc[13]); o1.w = cvt_pk_bf16(acc[14], acc[15]);
            bf16_t* dst = wsp<bf16_t>(F, WS_WOUT) + (size_t)dout * 1024 + g * 128 + kc0;
            *(u32x4*)dst = o0; *(u32x4*)(dst + 8) = o1;
            LDS_WAIT(); asm volatile("" ::: "memory");
            continue; }
        r -= I_FOUT;
        if (r < I_MISC) {
            if (r == 0) { float* bt = wsp<float>(F, WS_BTAB);
                for (int i = lane; i < 4 * 256; i += 64) { const int h = i >> 8, ri = i & 255; const int rel = (ri > 254 ? 254 : ri) - 127; bt[i] = F.rel_bias[t5_bucket_idx(rel) * 4 + h] * LOG2E; } }
            else { float* bp = wsp<float>(F, WS_B1P); const int base = (r - 1) * 1024;
                for (int i = lane; i < 1024; i += 64) { const int idx = base + i, e = idx >> 11, pc = idx & 2047, pn = pc >> 8, p = pc & 255;
                    bp[idx] = F.b1[e * 2048 + pn * 256 + (p < 128 ? 2 * p : 2 * (p - 128) + 1)]; } }
            continue; }
        r -= I_MISC;
        if (r < I_ADFT) {
            const int k = r; bf16_t* row = wsp<bf16_t>(F, WS_ADFT) + (size_t)k * 4096;
#pragma unroll
            for (int ch = 0; ch < 8; ++ch) { const int j0 = ch * 512 + lane * 8; float v[8];
#pragma unroll
                for (int e = 0; e < 8; ++e) { const int j = j0 + e;
                    if (j < 2048) v[e] = ctab[(k * j) & 4095];
                    else if (j == 2048) v[e] = (k & 1) ? -1.0f : 1.0f;
                    else v[e] = ctab[((k * (j - 2048)) - 1024) & 4095];
                    v[e] *= (1.0f / 64.0f); }
                u32x4 o; o.x = cvt_pk_bf16(v[0], v[1]); o.y = cvt_pk_bf16(v[2], v[3]); o.z = cvt_pk_bf16(v[4], v[5]); o.w = cvt_pk_bf16(v[6], v[7]);
                *(u32x4*)(row + j0) = o; }
            continue; }
        r -= I_ADFT;
        if (r < I_W2) {
            const int e = r >> 9, kb = (r >> 5) & 15, nb = r & 31;
            tr_item(F.w2 + (size_t)e * 1048576 + (size_t)(kb * 64) * 1024 + nb * 32, 1024, wsp<bf16_t>(F, WS_W2) + (size_t)e * 1048576 + (size_t)(nb * 32) * 1024 + kb * 64, 1024, scr, lane);
            continue; }
        r -= I_W2;
        { const int e = r >> 10, kc = (r >> 5) & 31, nc = r & 31;
          tr_w1_item(F.w1 + (size_t)e * 2097152, wsp<bf16_t>(F, WS_W1) + (size_t)e * 2097152, kc, nc, scr, lane); }
    }
}

__device__ __forceinline__ void norm_row(const float* xrow, const float* g, const float* sh, const float* sc, int lane, f32x4 (&h)[4]) {
    float s = 0.f;
#pragma unroll
    for (int j = 0; j < 4; ++j) { h[j] = *((const f32x4*)xrow + lane + 64 * j); s += (h[j][0] * h[j][0] + h[j][1] * h[j][1]) + (h[j][2] * h[j][2] + h[j][3] * h[j][3]); }
    const float rr = rsqrtf(wave_sum(s) * (1.0f / 1024.0f) + EPS);
#pragma unroll
    for (int j = 0; j < 4; ++j) { const f32x4 gv = *((const f32x4*)g + lane + 64 * j), sv = *((const f32x4*)sc + lane + 64 * j), hv = *((const f32x4*)sh + lane + 64 * j);
        h[j] = h[j] * rr * gv * (sv + 1.0f) + hv; }
}
__device__ __forceinline__ void store_row_bf16(bf16_t* row, int lane, const f32x4 (&h)[4]) {
#pragma unroll
    for (int j = 0; j < 4; ++j) { u32x2 w; w.x = cvt_pk_bf16(h[j][0], h[j][1]); w.y = cvt_pk_bf16(h[j][2], h[j][3]); *((u32x2*)row + lane + 64 * j) = w; }
}
__device__ __forceinline__ void p1_rows(Frame& F) {
    const int gw = F.vcu * NWAVES + F.wave, NGW = F.G * NWAVES, lane = F.lane;
    const float* mod = wsp<float>(F, WS_MOD);
    bf16_t* XN = wsp<bf16_t>(F, WS_XN); bf16_t* XS = wsp<bf16_t>(F, WS_XNSA); bf16_t* XA = XS + (size_t)NB * HSEQ * 1024;
    for (int w = gw; w < NB * (HSEQ + 1); w += NGW) {
        const int b = w / (HSEQ + 1), j = w % (HSEQ + 1);
        const float* sh = mod + b * 6144; const float* sc = sh + 1024;
        f32x4 h0[4];
        norm_row(F.x + ((size_t)b * SEQ + j) * 1024, F.g_mix, sh, sc, lane, h0);
        store_row_bf16(XN + ((size_t)b * SEQ + j) * 1024, lane, h0);
        if (j == 0) {
            store_row_bf16(XS + ((size_t)b * HSEQ) * 1024, lane, h0);
            f32x4 z[4];
#pragma unroll
            for (int q = 0; q < 4; ++q) z[q] = (f32x4){0.f, 0.f, 0.f, 0.f};
            store_row_bf16(XA + ((size_t)b * HSEQ) * 1024, lane, z);
        } else if (j == HSEQ) {
            const bf16_t* wc = wsp<bf16_t>(F, WS_WCS); float* vr = wsp<float>(F, WS_VR);
            for (int n = 0; n < 512; ++n) { float s = 0.f;
#pragma unroll
                for (int q = 0; q < 4; ++q) { const u32x2 wv = *((const u32x2*)(wc + (size_t)n * 1024) + lane + 64 * q);
                    s += h0[q][0] * __uint_as_float(wv.x << 16) + h0[q][1] * __uint_as_float(wv.x & 0xffff0000u) + h0[q][2] * __uint_as_float(wv.y << 16) + h0[q][3] * __uint_as_float(wv.y & 0xffff0000u); }
                s = wave_sum(s); if (lane == 0) vr[b * 512 + n] = s; }
        } else {
            f32x4 h1[4], t[4];
            norm_row(F.x + ((size_t)b * SEQ + (SEQ - j)) * 1024, F.g_mix, sh, sc, lane, h1);
            store_row_bf16(XN + ((size_t)b * SEQ + (SEQ - j)) * 1024, lane, h1);
#pragma unroll
            for (int q = 0; q < 4; ++q) t[q] = h0[q] + h1[q];
            store_row_bf16(XS + ((size_t)b * HSEQ + j) * 1024, lane, t);
#pragma unroll
            for (int q = 0; q < 4; ++q) t[q] = h0[q] - h1[q];
            store_row_bf16(XA + ((size_t)b * HSEQ + j) * 1024, lane, t);
        }
    }
}

__device__ __forceinline__ void moe_tables(Frame& F) {
    LAS int* cnt = (LAS int*)(F.lds + SP_CNT); LAS int* tstart = (LAS int*)(F.lds + SP_TSTART); LAS unsigned char* tile_e = F.lds + SP_TILEE;
    __syncthreads();
    if (F.tid < 32) cnt[F.tid] = (int)__hip_atomic_load(F.ctl + CW_GCNT + 64 * F.tid, RLX_AGENT);
    __syncthreads();
    if (F.tid == 0) { int s = 0; for (int e = 0; e < 32; ++e) { tstart[e] = s; s += (cnt[e] + 255) >> 8; } tstart[32] = s; tstart[33] = s; }
    __syncthreads();
    const int total = tstart[32];
    for (int pm = F.tid; pm < total; pm += 512) { int e = 0;
        for (int q = 1; q < 32; ++q) e += (pm >= tstart[q]) ? 1 : 0;
        tile_e[pm] = (unsigned char)e; }
    __syncthreads();
}

constexpr int SP_LCNT = SP_OFF + 5120, SP_LBASE = SP_OFF + 5376, SP_STASH = SP_OFF + 6144;
__device__ __forceinline__ void p5_router(Frame& F) {
    const int lane = F.lane, tid = F.tid;
    LAS f32x4* W4 = (LAS f32x4*)F.lds;
    for (int idx = tid; idx < 1024 * 8; idx += 512) { const int d = idx >> 3, e4 = idx & 7; const f32x4 v = *((const f32x4*)(F.w_router + (size_t)d * 32) + e4);
        const int jj = d >> 8, ln = (d & 255) >> 2, i = d & 3; W4[((jj * 4 + i) * 8 + e4) * 64 + ln] = v; }
    LAS int* lcnt = (LAS int*)(F.lds + SP_LCNT); LAS int* lbase = (LAS int*)(F.lds + SP_LBASE); LAS int* stash = (LAS int*)(F.lds + SP_STASH);
    if (tid < 32) lcnt[tid] = 0;
    __syncthreads();
    const float* mod = wsp<float>(F, WS_MOD); bf16_t* XN2 = wsp<bf16_t>(F, WS_XN2);
    const int e_lane = ((lane >> 5) & 1) * 16 + ((lane >> 4) & 1) * 8 + ((lane >> 3) & 1) * 4 + ((lane >> 2) & 1) * 2 + ((lane >> 1) & 1);
    const float brt = F.b_router[e_lane];
    for (int rl = 0; rl < 16; ++rl) {
        const int trow = F.vcu * 128 + F.wave * 16 + rl, b = trow >> 12;
        f32x4 h[4];
        norm_row(F.out + (size_t)trow * 1024, F.g_ffn, mod + b * 6144 + 3072, mod + b * 6144 + 4096, lane, h);
        store_row_bf16(XN2 + (size_t)trow * 1024, lane, h);
        float acc[32];
#pragma unroll
        for (int e = 0; e < 32; ++e) acc[e] = 0.f;
#pragma unroll
        for (int jj = 0; jj < 4; ++jj)
#pragma unroll
            for (int i = 0; i < 4; ++i) { const float hv = h[jj][i];
#pragma unroll
                for (int e4 = 0; e4 < 8; ++e4) { const f32x4 w = W4[((jj * 4 + i) * 8 + e4) * 64 + lane];
                    acc[4 * e4 + 0] += hv * w[0]; acc[4 * e4 + 1] += hv * w[1]; acc[4 * e4 + 2] += hv * w[2]; acc[4 * e4 + 3] += hv * w[3]; } }
        float s16[16];
#pragma unroll
        for (int i = 0; i < 16; ++i) { const float send = (lane & 32) ? acc[i] : acc[16 + i], keep = (lane & 32) ? acc[16 + i] : acc[i]; s16[i] = keep + __shfl_xor(send, 32); }
        float s8[8];
#pragma unroll
        for (int i = 0; i < 8; ++i) { const float send = (lane & 16) ? s16[i] : s16[8 + i], keep = (lane & 16) ? s16[8 + i] : s16[i]; s8[i] = keep + __shfl_xor(send, 16); }
        float s4[4];
#pragma unroll
        for (int i = 0; i < 4; ++i) { const float send = (lane & 8) ? s8[i] : s8[4 + i], keep = (lane & 8) ? s8[4 + i] : s8[i]; s4[i] = keep + __shfl_xor(send, 8); }
        float s2[2];
#pragma unroll
        for (int i = 0; i < 2; ++i) { const float send = (lane & 4) ? s4[i] : s4[2 + i], keep = (lane & 4) ? s4[2 + i] : s4[i]; s2[i] = keep + __shfl_xor(send, 4); }
        float lg; { const float send = (lane & 2) ? s2[0] : s2[1], keep = (lane & 2) ? s2[1] : s2[0]; lg = keep + __shfl_xor(send, 2); }
        lg += __shfl_xor(lg, 1); lg += brt;
        float tv[4]; int te[4]; float cur = lg;
#pragma unroll
        for (int k = 0; k < 4; ++k) { float bv = cur; int be = e_lane;
#pragma unroll
            for (int o = 2; o < 64; o <<= 1) { const float ov = __shfl_xor(bv, o); const int oe = __shfl_xor(be, o); const bool take = (ov > bv) || (ov == bv && oe < be); bv = take ? ov : bv; be = take ? oe : be; }
            tv[k] = bv; te[k] = be; if (e_lane == be) cur = -INFINITY; }
        const float e1 = __expf(tv[1] - tv[0]), e2 = __expf(tv[2] - tv[0]), e3 = __expf(tv[3] - tv[0]); const float inv = 1.0f / (1.0f + e1 + e2 + e3);
        if (lane < 4) { const int k = lane; const int e = (k == 0) ? te[0] : (k == 1) ? te[1] : (k == 2) ? te[2] : te[3];
            const float gk = ((k == 0) ? 1.0f : (k == 1) ? e1 : (k == 2) ? e2 : e3) * inv;
            const int lr = atomicAdd((int*)(lcnt + e), 1);
            const int si = ((F.wave * 16 + rl) * 4 + k) * 4; stash[si] = trow * 4 + k; stash[si + 1] = e; stash[si + 2] = lr; stash[si + 3] = __float_as_int(gk); }
    }
    __syncthreads();
    if (tid < 32) lbase[tid] = (int)__hip_atomic_fetch_add(F.ctl + CW_GCNT + 64 * tid, (unsigned)lcnt[tid], RLX_AGENT);
    __syncthreads();
    { const int si = tid * 4; const int tk = stash[si], e = stash[si + 1], slot = lbase[e] + stash[si + 2];
      wsp<unsigned>(F, WS_SLOTTOK)[(size_t)e * CAP + slot] = (unsigned)(tk >> 2);
      wsp<int>(F, WS_SLOTGATE)[(size_t)e * CAP + slot] = stash[si + 3];
      wsp<unsigned>(F, WS_TOKSLOT)[tk] = (unsigned)(e * CAP + slot); }
}

__device__ __forceinline__ void p8_combine(Frame& F) {
    const int lane = F.lane; const LAS int* tstart = (const LAS int*)(F.lds + SP_TSTART);
    const float* mod = wsp<float>(F, WS_MOD); const bf16_t* slab = wsp<bf16_t>(F, WS_SLAB); const unsigned* ts = wsp<unsigned>(F, WS_TOKSLOT);
    for (int rl = 0; rl < 16; ++rl) {
        const int trow = F.vcu * 128 + F.wave * 16 + rl, b = trow >> 12;
        const u32x4 sl = *(const u32x4*)(ts + (size_t)trow * 4);
        size_t ar[4];
#pragma unroll
        for (int k = 0; k < 4; ++k) { const unsigned v = sl[k]; const int e = v >> 15, slot = v & 32767; ar[k] = (size_t)(tstart[e] * 256 + slot) * 1024; }
        float* orow = F.out + (size_t)trow * 1024;
#pragma unroll
        for (int j = 0; j < 4; ++j) { f32x4 s = (f32x4){0.f, 0.f, 0.f, 0.f};
#pragma unroll
            for (int k = 0; k < 4; ++k) { const u32x2 wv = *((const u32x2*)(slab + ar[k]) + lane + 64 * j);
                s[0] += __uint_as_float(wv.x << 16); s[1] += __uint_as_float(wv.x & 0xffff0000u); s[2] += __uint_as_float(wv.y << 16); s[3] += __uint_as_float(wv.y & 0xffff0000u); }
            const f32x4 gt = *((const f32x4*)(mod + b * 6144 + 5120) + lane + 64 * j); f32x4* op = (f32x4*)orow + lane + 64 * j;
            *op = *op + gt * s; }
    }
}

constexpr int NPHASE = 9;
struct Args { const float* in[23]; float* out; unsigned char* ws; int ph_lo, ph_hi; };
__global__ void __launch_bounds__(NWAVES * 64, 2) mk_fwd(Args args) {
    extern __shared__ __attribute__((aligned(16))) unsigned char lds_[];
    Frame F;
    F.lds = (LAS unsigned char*)lds_;
    F.MISC = (volatile LAS unsigned*)(F.lds + SP_MISC);
    F.tid = threadIdx.x; F.lane = F.tid & 63; F.wave = __builtin_amdgcn_readfirstlane(F.tid >> 6);
    F.G = gridDim.x; { const int bx = blockIdx.x; F.vcu = (F.G % 8 == 0) ? (bx % 8) * (F.G / 8) + bx / 8 : bx; }
    F.ws = args.ws; F.ctl = (unsigned*)(args.ws + WS_CTL); F.out = args.out;
    F.x = args.in[0]; F.c = args.in[1]; F.w_ada = args.in[2]; F.b_ada = args.in[3]; F.g_mix = args.in[4]; F.w_in = args.in[5]; F.w_fourier = args.in[6];
    F.q_norm_g = args.in[7]; F.k_norm_g = args.in[8]; F.lq1 = args.in[9]; F.lk1 = args.in[10]; F.lq2 = args.in[11]; F.lk2 = args.in[12]; F.g_subln = args.in[13];
    F.w_out = args.in[14]; F.rel_bias = args.in[15]; F.g_ffn = args.in[16]; F.w_router = args.in[17]; F.b_router = args.in[18]; F.w1 = args.in[19]; F.b1 = args.in[20];
    F.w2 = args.in[21]; F.b2 = args.in[22];
    if (F.tid < 64) ((LAS unsigned*)(F.lds + SP_MISC))[F.tid] = 0u;
    __syncthreads();
    const int lo = args.ph_lo, hi = args.ph_hi;
    XcdBarrier bar; bar.bar = F.ctl + CW_BAR; bar.x = 0; bar.st = nullptr;
    if (hi - lo > 1) bar = xcd_barrier_post(F.ctl + CW_BAR, F.MISC + 8);
#ifndef PH_MASK
#define PH_MASK 0x1ff
#endif
#define IN(k) (((PH_MASK >> (k)) & 1) && lo <= (k) && (k) < hi)
#define SEAM(k) do { if (IN(k) && IN((k) + 1)) xcd_barrier(bar); } while (0)
    const int cblk = (int)blockIdx.x;

    if (IN(0)) { p0_prologue(F); }
    SEAM(0);
    if (IN(1)) { p1_rows(F); }
    SEAM(1);
    if (IN(2)) {
        { SchedPlain S{(const char*)wsp<bf16_t>(F, WS_XN), (const char*)wsp<bf16_t>(F, WS_WQKV), NTOK / 256, NQKV / 256, F.G, cblk, (size_t)256 * 1024 * 2};
          EpiQKV E{wsp<bf16_t>(F, WS_Q), wsp<bf16_t>(F, WS_K), wsp<bf16_t>(F, WS_V), F.q_norm_g, F.k_norm_g};
          pg8::gemm_phase<EpiQKV, SchedPlain>(F.lds, 1024, S, E); }
        { SchedFourier S{(const char*)wsp<bf16_t>(F, WS_WCS), (const char*)wsp<bf16_t>(F, WS_XNSA), F.G, cblk, (size_t)256 * 1024 * 2};
          EpiFourier E{wsp<bf16_t>(F, WS_BDFT), wsp<float>(F, WS_VR)};
          pg8::gemm_phase<EpiFourier, SchedFourier>(F.lds, 1024, S, E); }
    }
    SEAM(2);
    if (IN(3)) {
        float lam;
        { const float a = F.lq1[F.lane] * F.lk1[F.lane], b = F.lq2[F.lane] * F.lk2[F.lane]; lam = __expf(wave_sum(a)) - __expf(wave_sum(b)) + LAM_INIT; }
        att::Tensors T{wsp<bf16_t>(F, WS_Q), wsp<bf16_t>(F, WS_K), wsp<bf16_t>(F, WS_V), wsp<bf16_t>(F, WS_AMIX), wsp<float>(F, WS_BTAB), F.g_subln, lam};
        for (int L = F.vcu; L < NB * 4 * (SEQ / att::QB); L += F.G) { const int bh = L >> 4, qb = L & 15; att::attn_unit(F.lds, T, bh >> 2, bh & 3, qb); }
        { SchedPlain S{(const char*)wsp<bf16_t>(F, WS_ADFT), (const char*)wsp<bf16_t>(F, WS_BDFT), 16, 16, F.G, cblk, (size_t)256 * 4096 * 2};
          EpiDft E{wsp<bf16_t>(F, WS_AMIX)};
          pg8::gemm_phase<EpiDft, SchedPlain>(F.lds, 4096, S, E); }
    }
    SEAM(3);
    if (IN(4)) {
        SchedPlain S{(const char*)wsp<bf16_t>(F, WS_AMIX), (const char*)wsp<bf16_t>(F, WS_WOUT), NTOK / 256, 4, F.G, cblk, (size_t)256 * 1024 * 2};
        EpiOut E{F.x, wsp<float>(F, WS_MOD), F.out};
        pg8::gemm_phase<EpiOut, SchedPlain>(F.lds, 1024, S, E);
    }
    SEAM(4);
    if (IN(5)) { p5_router(F); }
    SEAM(5);
    if (IN(6)) {
        moe_tables(F);
        const LAS int* tstart = (const LAS int*)(F.lds + SP_TSTART);
        SchedMoe<true> S{(const char*)wsp<bf16_t>(F, WS_XN2), (const char*)wsp<bf16_t>(F, WS_W1), tstart[32], 8, F.G, cblk, 0, (size_t)256 * 1024 * 2, (size_t)2048 * 1024 * 2,
                         F.lds + SP_TILEE, tstart, (const LAS int*)(F.lds + SP_CNT), wsp<unsigned>(F, WS_SLOTTOK)};
        EpiSwiglu E{wsp<bf16_t>(F, WS_ACT), wsp<float>(F, WS_B1P), F.lds + SP_TILEE};
        pg8::gemm_phase<EpiSwiglu, SchedMoe<true>>(F.lds, 1024, S, E);
    }
    SEAM(6);
    if (IN(7)) {
        moe_tables(F);
        const LAS int* tstart = (const LAS int*)(F.lds + SP_TSTART);
        SchedMoe<false> S{(const char*)wsp<bf16_t>(F, WS_ACT), (const char*)wsp<bf16_t>(F, WS_W2), tstart[32], 4, F.G, cblk, (size_t)256 * 1024 * 2, (size_t)256 * 1024 * 2, (size_t)1024 * 1024 * 2,
                          F.lds + SP_TILEE, tstart, (const LAS int*)(F.lds + SP_CNT), wsp<unsigned>(F, WS_SLOTTOK)};
        EpiDown E{wsp<bf16_t>(F, WS_SLAB), F.b2, wsp<float>(F, WS_SLOTGATE), F.lds + SP_TILEE, tstart};
        pg8::gemm_phase<EpiDown, SchedMoe<false>>(F.lds, 1024, S, E);
    }
    SEAM(7);
    if (IN(8)) { moe_tables(F); p8_combine(F); }
#undef IN
#undef SEAM
}

extern "C" void kernel_launch(void* const* d_in, const int* in_sizes, int n_in, void* d_out, int out_size, void* d_ws, size_t ws_size, hipStream_t stream) {
    static int grid = 0;
    if (grid == 0) {
        if (n_in != 23 || in_sizes[0] != NTOK * DM || out_size != NTOK * DM || ws_size < WS_END) {
            fprintf(stderr, "kernel_launch: unexpected shapes: n_in %d in0 %d out %d ws %zu (need >= %zu)\n", n_in, n_in > 0 ? in_sizes[0] : -1, out_size, ws_size, (size_t)WS_END); grid = -1; return; }
        int dev = 0, cus = 0, per_cu = 0;
        if (hipGetDevice(&dev) != hipSuccess || hipDeviceGetAttribute(&cus, hipDeviceAttributeMultiprocessorCount, dev) != hipSuccess) { fprintf(stderr, "kernel_launch: device query failed\n"); grid = -1; return; }
        if (hipFuncSetAttribute((const void*)mk_fwd, hipFuncAttributeMaxDynamicSharedMemorySize, LDS_BYTES) != hipSuccess) { fprintf(stderr, "kernel_launch: hipFuncSetAttribute failed\n"); grid = -1; return; }
        if (hipOccupancyMaxActiveBlocksPerMultiprocessor(&per_cu, (const void*)mk_fwd, NWAVES * 64, LDS_BYTES) != hipSuccess || per_cu < 1) { fprintf(stderr, "kernel_launch: occupancy query says %d blocks per CU\n", per_cu); grid = -1; (void)hipGetLastError(); return; }
        grid = cus;
        if (grid % 8 != 0 || grid < 8) fprintf(stderr, "kernel_launch: note: %d CUs\n", grid);
    }
    if (grid < 0) return;
    if (hipMemsetAsync((char*)d_ws + WS_CTL, 0, CTL_ZERO_BYTES, stream) != hipSuccess) { fprintf(stderr, "kernel_launch: memset failed\n"); return; }
    Args a{};
    for (int i = 0; i < 23; ++i) a.in[i] = (const float*)d_in[i];
    a.out = (float*)d_out; a.ws = (unsigned char*)d_ws;
#if MK_SPLIT
    for (int p = 0; p < NPHASE; ++p) { a.ph_lo = p; a.ph_hi = p + 1; hipLaunchKernelGGL(mk_fwd, dim3(grid), dim3(NWAVES * 64), LDS_BYTES, stream, a); }
#else
    a.ph_lo = 0; a.ph_hi = NPHASE;
    void* kargs[] = {(void*)&a};
    const hipError_t le = hipLaunchCooperativeKernel((const void*)mk_fwd, dim3(grid), dim3(NWAVES * 64), kargs, LDS_BYTES, stream);
    if (le != hipSuccess) fprintf(stderr, "kernel_launch: cooperative launch failed: %s (grid %d)\n", hipGetErrorName(le), grid);
#endif
}
```

```cpp
#include <hip/hip_runtime.h>
#include <cstdio>
#include <cstdint>
#include <cmath>

#define LAS __attribute__((address_space(3)))
#define GAS __attribute__((address_space(1)))
typedef unsigned short bf16_t;
typedef short bf16x8 __attribute__((ext_vector_type(8)));
typedef short s16x4 __attribute__((ext_vector_type(4)));
typedef float f32x4 __attribute__((ext_vector_type(4)));
typedef float f32x2 __attribute__((ext_vector_type(2)));
typedef float f32x16 __attribute__((ext_vector_type(16)));
typedef unsigned u32x4 __attribute__((ext_vector_type(4)));
typedef unsigned u32x2 __attribute__((ext_vector_type(2)));
typedef GAS unsigned gu32;

#ifndef MK_PROBE
#define MK_PROBE -1
#endif
#ifndef MK_PROBE_SKIP
#define MK_PROBE_SKIP 0
#endif
#ifndef MK_SPLIT
#define MK_SPLIT 0
#endif

constexpr int NB = 8, SEQ = 4096, DM = 1024, NTOK = NB * SEQ;
constexpr int NEXP = 32, TOPK = 4, DFF = 1024, CAP = NTOK;
constexpr int NQKV = 1536;
constexpr int HSEQ = SEQ / 2;
constexpr float EPS = 1e-6f;
constexpr float LOG2E = 1.4426950408889634f;
constexpr float QSCALE = 0.125f * LOG2E;
constexpr float LAM_INIT = 0.2f;
constexpr int MAXTILES = (NTOK * TOPK) / 256 + NEXP;

constexpr size_t MiB = 1u << 20;
constexpr size_t WS_CTL = 0, CTL_ZERO_BYTES = 1 * MiB;
constexpr size_t WS_MOD = 1 * MiB;
constexpr size_t WS_VR = WS_MOD + 256 * 1024;
constexpr size_t WS_BTAB = WS_MOD + 320 * 1024;
constexpr size_t WS_B1P = WS_MOD + 512 * 1024;
constexpr size_t WS_TOKSLOT = 2 * MiB;
constexpr size_t WS_SLOTTOK = 4 * MiB;
constexpr size_t WS_SLOTGATE = 8 * MiB;
constexpr size_t WS_WQKV = 12 * MiB;
constexpr size_t WS_WCS = 15 * MiB;
constexpr size_t WS_WOUT = 17 * MiB;
constexpr size_t WS_ADFT = 20 * MiB;
constexpr size_t WS_W1 = 52 * MiB;
constexpr size_t WS_W2 = 180 * MiB;
constexpr size_t WS_XN = 256 * MiB;
constexpr size_t WS_XNSA = 320 * MiB;
constexpr size_t WS_Q = 384 * MiB, WS_K = 416 * MiB, WS_V = 448 * MiB;
constexpr size_t WS_BDFT = 480 * MiB;
constexpr size_t WS_AMIX = 512 * MiB;
constexpr size_t WS_ACT = 256 * MiB;
constexpr size_t WS_XN2 = 576 * MiB;
constexpr size_t WS_SLAB = 640 * MiB;
constexpr size_t WS_END = 912 * MiB;
static_assert(WS_ACT + (size_t)MAXTILES * 256 * 1024 * 2 <= WS_XN2 && WS_SLAB + (size_t)MAXTILES * 256 * 1024 * 2 <= WS_END, "d_ws map");
constexpr int CW_BAR = 4096;
constexpr int CW_GCNT = 8192;

constexpr int RING_BYTES = 131072;
constexpr int SP_OFF = 147456;
constexpr int SP_MISC = SP_OFF;
constexpr int SP_TSTART = SP_OFF + 256;
constexpr int SP_CNT = SP_OFF + 512;
constexpr int SP_TILEE = SP_OFF + 768;
constexpr int SP_BT = SP_OFF + 2048;
constexpr int SP_WS = SP_OFF + 3072;
constexpr int LDS_BYTES = 163840;
constexpr int NWAVES = 8;

__device__ __forceinline__ unsigned cvt_pk_bf16(float lo, float hi) { unsigned r; asm volatile("v_cvt_pk_bf16_f32 %0, %1, %2" : "=v"(r) : "v"(lo), "v"(hi)); return r; }
__device__ __forceinline__ float bf2f(unsigned short h) { return __uint_as_float((unsigned)h << 16); }
__device__ __forceinline__ float wave_sum(float v) {
#pragma unroll
    for (int o = 1; o < 64; o <<= 1) v += __shfl_xor(v, o);
    return v;
}
#define LDS_WAIT() asm volatile("s_waitcnt lgkmcnt(0)" ::: "memory")
#define VM_WAIT() asm volatile("s_waitcnt vmcnt(0)" ::: "memory")
#define RLX_AGENT __ATOMIC_RELAXED, __HIP_MEMORY_SCOPE_AGENT

namespace pg8 {
constexpr int BM = 256, BK = 64, HALF = 128, HTB = HALF * BK * 2, STAGE_BYTES = 8 * HTB, NXCD = 8, WGM = 8;
__host__ __device__ __forceinline__ int lds_byte(int r, int c) { const int st = (r >> 4) * 2 + (c >> 5), rr = r & 15, cc = c & 31, ob = rr * 64 + cc * 2; return st * 1024 + (ob ^ (((ob >> 9) & 1) << 5)); }
__host__ __device__ __forceinline__ void stage_rc(int b, int& R, int& C) { const int st = b / 1024, sb = b % 1024, swz = sb ^ (((sb >> 9) & 1) << 5); R = (st >> 1) * 16 + swz / 64; C = (st & 1) * 32 + (swz % 64) / 2; }
__host__ __device__ __forceinline__ int perm32(int rho) { const int n = rho >> 4, i = rho & 15; return 8 * (i >> 2) + 4 * n + (i & 3); }
struct Unit { int pm, pn; };

__device__ __forceinline__ bool static_unit(int i, int G, int c, int nM, int nN, Unit& u) {
    const int nwg = nM * nN; const long L = (long)i * G + c; if (L >= nwg) return false;
    int wgid = (int)L; { const int q = nwg / NXCD, r = nwg % NXCD, xcd = wgid % NXCD, off = wgid / NXCD; wgid = (xcd < r ? xcd * (q + 1) : r * (q + 1) + (xcd - r) * q) + off; }
    const int nig = WGM * nN, gid = wgid / nig, fm = gid * WGM, gsz = (nM - fm) < WGM ? (nM - fm) : WGM;
    u.pm = fm + ((wgid % nig) % gsz); u.pn = (wgid % nig) / gsz; return true;
}

template <class Epi, class Sched>
__device__ __forceinline__ void gemm_phase(LAS unsigned char* lds, const int K, const Sched& S, const Epi& E) {
    int tid_ = threadIdx.x; asm volatile("" : "+v"(tid_));
    const int tid = tid_, wid = __builtin_amdgcn_readfirstlane(tid >> 6), lane = tid & 63, wr = wid >> 2, wc = wid & 3, fr = lane & 15, fq = lane >> 4;
    const int nt = K / BK;
    unsigned voffA[2], voffB[2]; int RA[2], CA[2];
#pragma unroll
    for (int i = 0; i < 2; ++i) { int R, C; stage_rc(tid * 16 + i * 8192, R, C); const int Rb = Epi::PERM ? ((R & ~31) + perm32(R & 31)) : R;
        voffA[i] = (unsigned)(R * K + C) * 2u; voffB[i] = (unsigned)(Rb * K + C) * 2u; RA[i] = R; CA[i] = C; }
    const size_t kstep = (size_t)(BK * 2);
    const size_t hstep = (size_t)HALF * K * 2;
    const unsigned ldsw = (unsigned)wid * 1024u;
    const int aoff = lds_byte(wr * 64 + fr, fq * 8), boff = lds_byte(wc * 32 + fr, fq * 8);
    unsigned cvo[2][2], nvo[2][2];
#define PG8_SA(b, h) (((b) * 2 + (h)) * HTB)
#define PG8_SB(b, h) ((4 + (b) * 2 + (h)) * HTB)
#define PG8_STAGE(bufoff, gbase, voff) do { _Pragma("unroll") for (int _i = 0; _i < 2; ++_i) \
        __builtin_amdgcn_global_load_lds((const unsigned*)((const char*)(gbase) + (voff)[_i]), (LAS unsigned*)(lds + (bufoff) + ldsw + _i * 8192), 16, 0, 0); } while (0)
#define PG8_STAGE_A(bufoff, ab, kb, h, nx) do { if constexpr (Sched::GATHER) { _Pragma("unroll") for (int _i = 0; _i < 2; ++_i) \
        __builtin_amdgcn_global_load_lds((const unsigned*)((ab) + (kb) + ((nx) ? nvo[h][_i] : cvo[h][_i])), (LAS unsigned*)(lds + (bufoff) + ldsw + _i * 8192), 16, 0, 0); } \
        else { PG8_STAGE(bufoff, (ab) + (kb) + (h) * hstep, voffA); } } while (0)
#define PG8_LDA(dst, b, h) do { _Pragma("unroll") for (int m = 0; m < 4; ++m) _Pragma("unroll") for (int k = 0; k < 2; ++k) dst[m][k] = *(const LAS bf16x8*)(lds + PG8_SA(b, h) + aoff + m * 2048 + k * 1024); } while (0)
#define PG8_LDB(dst, b, h) do { _Pragma("unroll") for (int n = 0; n < 2; ++n) _Pragma("unroll") for (int k = 0; k < 2; ++k) dst[n][k] = *(const LAS bf16x8*)(lds + PG8_SB(b, h) + boff + n * 2048 + k * 1024); } while (0)
#define PG8_MMA(ai, bj, At, Bt) do { __builtin_amdgcn_s_setprio(1); _Pragma("unroll") for (int m = 0; m < 4; ++m) _Pragma("unroll") for (int n = 0; n < 2; ++n) _Pragma("unroll") for (int k = 0; k < 2; ++k) \
        acc[ai][bj][m][n] = __builtin_amdgcn_mfma_f32_16x16x32_bf16(Bt[n][k], At[m][k], acc[ai][bj][m][n], 0, 0, 0); __builtin_amdgcn_s_setprio(0); } while (0)
#define PG8_WAIT_V(n) asm volatile("s_waitcnt vmcnt(" #n ")" ::: "memory")
#define PG8_WAIT_L(n) asm volatile("s_waitcnt lgkmcnt(" #n ")" ::: "memory")
#define PG8_BAR __builtin_amdgcn_s_barrier()
#define PG8_SCHED __builtin_amdgcn_sched_barrier(0)
    Unit cur, nxt; int ui = 0;
    if (!S.next(0, cur)) return;
    f32x4 acc[2][2][4][2];
#pragma unroll
    for (int a = 0; a < 2; ++a)
#pragma unroll
        for (int b = 0; b < 2; ++b)
#pragma unroll
            for (int m = 0; m < 4; ++m)
#pragma unroll
                for (int n = 0; n < 2; ++n) acc[a][b][m][n] = (f32x4){0.f, 0.f, 0.f, 0.f};
    bf16x8 At[4][2], B0[2][2], B1[2][2];
    const char* cA = S.a_ptr(cur); const char* cB = S.b_ptr(cur);
    if constexpr (Sched::GATHER) { int r[4]; S.a_rows(cur, RA[0], RA[1], r);
#pragma unroll
        for (int h = 0; h < 2; ++h)
#pragma unroll
            for (int i = 0; i < 2; ++i) { cvo[h][i] = (unsigned)(r[2 * h + i] * K + CA[i]) * 2u; nvo[h][i] = cvo[h][i]; } }
    PG8_STAGE(PG8_SB(0, 0), cB, voffB); PG8_STAGE(PG8_SB(0, 1), cB + hstep, voffB); PG8_STAGE_A(PG8_SA(0, 0), cA, 0, 0, false); PG8_STAGE_A(PG8_SA(0, 1), cA, 0, 1, false);
    if (wr == 1) PG8_BAR;
    PG8_WAIT_V(2); PG8_BAR;
    PG8_STAGE(PG8_SB(1, 0), cB + kstep, voffB); PG8_STAGE_A(PG8_SA(1, 0), cA, kstep, 0, false); PG8_STAGE(PG8_SB(1, 1), cB + hstep + kstep, voffB);
    PG8_WAIT_V(6); PG8_BAR;
    for (;;) {
        const bool has_next = S.next(ui + 1, nxt);
        const char* nA = has_next ? S.a_ptr(nxt) : cA; const char* nB = has_next ? S.b_ptr(nxt) : cB;
        if constexpr (Sched::GATHER) { if (has_next) { int r[4]; S.a_rows(nxt, RA[0], RA[1], r);
#pragma unroll
            for (int h = 0; h < 2; ++h)
#pragma unroll
                for (int i = 0; i < 2; ++i) nvo[h][i] = (unsigned)(r[2 * h + i] * K + CA[i]) * 2u; } }
        for (int t = 0; t < nt; t += 2) {
            const bool last = (t == nt - 2);
            const size_t k1 = (size_t)(t + 1) * kstep;
            const char* a2 = last ? nA : cA; const size_t k2 = last ? 0 : (size_t)(t + 2) * kstep; const char* b2 = last ? nB : cB + (size_t)(t + 2) * kstep;
            const size_t k3 = k2 + kstep; const char* b3 = b2 + kstep;
            PG8_LDB(B0, 0, 0); PG8_LDB(B1, 0, 1); PG8_SCHED; PG8_LDA(At, 0, 0); PG8_STAGE_A(PG8_SA(1, 1), cA, k1, 1, false);
            PG8_WAIT_V(8); PG8_WAIT_L(0); PG8_BAR; PG8_MMA(0, 0, At, B0); PG8_MMA(0, 1, At, B1); PG8_BAR; PG8_SCHED;
            PG8_LDA(At, 0, 1); PG8_STAGE(PG8_SB(0, 0), b2, voffB); PG8_STAGE(PG8_SB(0, 1), b2 + hstep, voffB); PG8_STAGE_A(PG8_SA(0, 0), a2, k2, 0, last);
            PG8_WAIT_V(8); PG8_WAIT_L(0); PG8_BAR; PG8_MMA(1, 0, At, B0); PG8_MMA(1, 1, At, B1); PG8_BAR; PG8_SCHED;
            PG8_LDB(B0, 1, 0); PG8_LDB(B1, 1, 1); PG8_SCHED; PG8_LDA(At, 1, 0); PG8_STAGE_A(PG8_SA(0, 1), a2, k2, 1, last);
            PG8_WAIT_V(8); PG8_WAIT_L(0); PG8_BAR; PG8_MMA(0, 0, At, B0); PG8_MMA(0, 1, At, B1); PG8_BAR; PG8_SCHED;
            PG8_LDA(At, 1, 1); PG8_STAGE(PG8_SB(1, 0), b3, voffB); PG8_STAGE(PG8_SB(1, 1), b3 + hstep, voffB); PG8_STAGE_A(PG8_SA(1, 0), a2, k3, 0, last);
            PG8_WAIT_V(8); PG8_WAIT_L(0); PG8_BAR; PG8_MMA(1, 0, At, B0); PG8_MMA(1, 1, At, B1); PG8_BAR; PG8_SCHED;
        }
        if (wr == 0) PG8_BAR;
        E(acc, cur, wr, wc, fr, fq);
        if (!has_next) break;
#pragma unroll
        for (int a = 0; a < 2; ++a)
#pragma unroll
            for (int b = 0; b < 2; ++b)
#pragma unroll
                for (int m = 0; m < 4; ++m)
#pragma unroll
                    for (int n = 0; n < 2; ++n) acc[a][b][m][n] = (f32x4){0.f, 0.f, 0.f, 0.f};
        cur = nxt; cA = nA; cB = nB; ++ui;
        if constexpr (Sched::GATHER) {
#pragma unroll
            for (int h = 0; h < 2; ++h)
#pragma unroll
                for (int i = 0; i < 2; ++i) cvo[h][i] = nvo[h][i]; }
        if (wr == 1) PG8_BAR;
    }
    PG8_WAIT_V(0);
    PG8_BAR;
#undef PG8_SA
#undef PG8_SB
#undef PG8_STAGE
#undef PG8_STAGE_A
#undef PG8_LDA
#undef PG8_LDB
#undef PG8_MMA
#undef PG8_WAIT_V
#undef PG8_WAIT_L
#undef PG8_BAR
#undef PG8_SCHED
}
}

#define XB_TMO      128
#define XB_XCNT(j)  (256  + 64 * (j))
#define XB_XSUB(j)  (1280 + 64 * (j))
#define XB_XGEN(j)  (2304 + 64 * (j))
#define XB_TOP      3328
#define XB_TOPGEN   3392
#define XCD_BAR_WORDS 3456
#define XB_SPIN_CAP (1u << 20)
__device__ __forceinline__ unsigned xb_ld(unsigned* p)              { return __hip_atomic_load(p, __ATOMIC_RELAXED, __HIP_MEMORY_SCOPE_AGENT); }
__device__ __forceinline__ unsigned xb_add(unsigned* p, unsigned v) { return __hip_atomic_fetch_add(p, v, __ATOMIC_RELAXED, __HIP_MEMORY_SCOPE_AGENT); }
__device__ __forceinline__ unsigned xb_xcc_id() { return (unsigned)__builtin_amdgcn_s_getreg((3 << 11) | 20) & 0xFu; }
#define XB_SPIN(cond, bar) do { unsigned _sp = 0; while (cond) { __builtin_amdgcn_s_sleep(1); \
    if ((++_sp & 255u) == 0u) { if (xb_ld(&(bar)[XB_TMO])) break; if (_sp > XB_SPIN_CAP) { atomicAdd(&(bar)[XB_TMO], 1u); break; } } } } while (0)
struct XcdBarrier { unsigned* bar; unsigned x; volatile LAS unsigned* st; };
__device__ __forceinline__ XcdBarrier xcd_barrier_post(unsigned* bar, volatile LAS unsigned* st) {
    XcdBarrier b; b.bar = bar; b.x = xb_xcc_id(); b.st = st;
    if (threadIdx.x == 0) (void)xb_add(&bar[XB_XCNT(b.x)], 1u);
    return b;
}
__device__ __forceinline__ void xcd_barrier_complete(unsigned* bar, unsigned x, unsigned& nloc, unsigned& nx) {
    const unsigned G = gridDim.x * gridDim.y * gridDim.z;
    unsigned sum, cnt, mine, sp = 0u;
    for (;;) {
        sum = 0u; cnt = 0u; mine = 0u;
#pragma unroll
        for (unsigned j = 0; j < 16; ++j) { const unsigned c = xb_ld(&bar[XB_XCNT(j)]); sum += c; cnt += (c > 0u) ? 1u : 0u; mine = (j == x) ? c : mine; }
        if (sum == G) break;
        __builtin_amdgcn_s_sleep(1);
        if ((++sp & 255u) == 0u) { if (xb_ld(&bar[XB_TMO])) break; if (sp > XB_SPIN_CAP) { atomicAdd(&bar[XB_TMO], 1u); break; } }
    }
    nloc = mine > 0u ? mine : 1u; nx = cnt > 0u ? cnt : 1u;
}
__device__ __forceinline__ void xcd_barrier(const XcdBarrier& b) {
    asm volatile("s_waitcnt vmcnt(0)" ::: "memory");
    __syncthreads();
    if (threadIdx.x == 0) {
        unsigned* bar = b.bar;
        __builtin_amdgcn_s_waitcnt(0);
        unsigned nloc = b.st[0], nx = b.st[1];
        if (nloc == 0u) { xcd_barrier_complete(bar, b.x, nloc, nx); b.st[0] = nloc; b.st[1] = nx; }
        const unsigned old = xb_add(&bar[XB_XSUB(b.x)], 1u);
        const unsigned gen = old / nloc;
        if (old + 1u == (gen + 1u) * nloc) {
            __builtin_amdgcn_fence(__ATOMIC_RELEASE, "agent");
            asm volatile("s_waitcnt vmcnt(0)" ::: "memory");
            const unsigned og = xb_add(&bar[XB_TOP], 1u);
            const unsigned tg = og / nx;
            if (og + 1u == (tg + 1u) * nx) xb_add(&bar[XB_TOPGEN], 1u);
            else XB_SPIN(xb_ld(&bar[XB_TOPGEN]) == tg, bar);
            __builtin_amdgcn_fence(__ATOMIC_ACQUIRE, "agent");
            xb_add(&bar[XB_XGEN(b.x)], 1u);
            asm volatile("s_waitcnt vmcnt(0)" ::: "memory");
        } else {
            XB_SPIN(xb_ld(&bar[XB_XGEN(b.x)]) == gen, bar);
            __builtin_amdgcn_fence(__ATOMIC_ACQUIRE, "agent");
            asm volatile("s_waitcnt vmcnt(0)" ::: "memory");
        }
    }
    __syncthreads();
}

struct Frame {
    LAS unsigned char* lds;
    volatile LAS unsigned* MISC;
    unsigned* ctl;
    int tid, lane, wave, vcu, G;
    const float *x, *c, *w_ada, *b_ada, *g_mix, *w_in, *w_fourier, *q_norm_g, *k_norm_g, *lq1, *lk1, *lq2, *lk2, *g_subln, *w_out, *rel_bias,
                *g_ffn, *w_router, *b_router, *w1, *b1, *w2, *b2;
    float* out;
    unsigned char* ws;
};
template <class T> __device__ __forceinline__ T* wsp(const Frame& F, size_t off) { return (T*)(F.ws + off); }

struct SchedPlain {
    static constexpr bool GATHER = false;
    const char* A; const char* Bt; int nM, nN, G, c; size_t tstep;
    __device__ __forceinline__ bool next(int i, pg8::Unit& u) const { return pg8::static_unit(i, G, c, nM, nN, u); }
    __device__ __forceinline__ const char* a_ptr(const pg8::Unit& u) const { return A + (size_t)u.pm * tstep; }
    __device__ __forceinline__ const char* b_ptr(const pg8::Unit& u) const { return Bt + (size_t)u.pn * tstep; }
    __device__ __forceinline__ void a_rows(const pg8::Unit&, int, int, int (&r)[4]) const { r[0] = r[1] = r[2] = r[3] = 0; }
};
struct SchedFourier {
    static constexpr bool GATHER = false;
    const char* A; const char* Bt; int G, c; size_t tstep;
    __device__ __forceinline__ bool next(int i, pg8::Unit& u) const {
        const int L = i * G + c; if (L >= 256) return false;
        const int w = (L % 8) * 32 + L / 8;
        const int half = w >> 7, r = w & 127; u.pm = 2 * half + (r & 1); u.pn = 64 * half + (r >> 1); return true; }
    __device__ __forceinline__ const char* a_ptr(const pg8::Unit& u) const { return A + (size_t)u.pm * tstep; }
    __device__ __forceinline__ const char* b_ptr(const pg8::Unit& u) const { return Bt + (size_t)u.pn * tstep; }
    __device__ __forceinline__ void a_rows(const pg8::Unit&, int, int, int (&r)[4]) const { r[0] = r[1] = r[2] = r[3] = 0; }
};
template <bool GATHER_> struct SchedMoe {
    static constexpr bool GATHER = GATHER_;
    const char* A; const char* Bt; int nM, nN, G, c; size_t a_tstep, b_tstep, e_stride;
    const LAS unsigned char* tile_e; const LAS int* tstart; const LAS int* cnt; const unsigned* slot_tok;
    __device__ __forceinline__ bool next(int i, pg8::Unit& u) const { return pg8::static_unit(i, G, c, nM, nN, u); }
    __device__ __forceinline__ const char* a_ptr(const pg8::Unit& u) const { return GATHER_ ? A : A + (size_t)u.pm * a_tstep; }
    __device__ __forceinline__ const char* b_ptr(const pg8::Unit& u) const { const int e = tile_e[u.pm]; return Bt + (size_t)e * e_stride + (size_t)u.pn * b_tstep; }
    __device__ __forceinline__ void a_rows(const pg8::Unit& u, int R0, int R1, int (&r)[4]) const {
        const int e = tile_e[u.pm]; const int s0 = (u.pm - tstart[e]) * 256, n = cnt[e];
#pragma unroll
        for (int h = 0; h < 2; ++h)
#pragma unroll
            for (int i = 0; i < 2; ++i) { const int s = s0 + h * 128 + (i ? R1 : R0); r[2 * h + i] = (s < n) ? (int)slot_tok[(size_t)e * CAP + s] : 0; }
    }
};

typedef const f32x4 (&AccRef)[2][2][4][2];
__device__ __forceinline__ u32x4 pack8(f32x4 a, f32x4 b) { u32x4 w; w.x = cvt_pk_bf16(a[0], a[1]); w.y = cvt_pk_bf16(a[2], a[3]); w.z = cvt_pk_bf16(b[0], b[1]); w.w = cvt_pk_bf16(b[2], b[3]); return w; }

struct EpiQKV {
    static constexpr bool PERM = true;
    bf16_t *Q, *Kb, *V; const float *gq, *gk;
    __device__ __forceinline__ void operator()(AccRef acc, const pg8::Unit& u, int wr, int wc, int fr, int fq) const {
        const int sec = u.pn >> 1, row0 = u.pm * 256 + wr * 64 + fr;
        if (sec < 2) {
            bf16_t* O = sec == 0 ? Q : Kb; const float* g = sec == 0 ? gq : gk; const float sc = sec == 0 ? QSCALE : 1.0f;
            f32x4 gl[2][2];
#pragma unroll
            for (int bj = 0; bj < 2; ++bj)
#pragma unroll
                for (int n = 0; n < 2; ++n) gl[bj][n] = *(const f32x4*)(g + 32 * bj + 8 * fq + 4 * n);
#pragma unroll
            for (int ai = 0; ai < 2; ++ai)
#pragma unroll
                for (int m = 0; m < 4; ++m) {
                    float ss = 0.f;
#pragma unroll
                    for (int bj = 0; bj < 2; ++bj)
#pragma unroll
                        for (int n = 0; n < 2; ++n) { const f32x4 v = acc[ai][bj][m][n]; ss += (v[0] * v[0] + v[1] * v[1]) + (v[2] * v[2] + v[3] * v[3]); }
                    ss += __shfl_xor(ss, 16); ss += __shfl_xor(ss, 32);
                    const float rr = rsqrtf(ss * (1.0f / 64.0f) + EPS) * sc;
                    bf16_t* rowp = O + (size_t)(row0 + ai * 128 + m * 16) * 512 + (u.pn & 1) * 256 + 64 * wc + 8 * fq;
#pragma unroll
                    for (int bj = 0; bj < 2; ++bj) *(u32x4*)(rowp + 32 * bj) = pack8(acc[ai][bj][m][0] * rr * gl[bj][0], acc[ai][bj][m][1] * rr * gl[bj][1]);
                }
        } else {
#pragma unroll
            for (int ai = 0; ai < 2; ++ai)
#pragma unroll
                for (int m = 0; m < 4; ++m) { bf16_t* rowp = V + (size_t)(row0 + ai * 128 + m * 16) * 512 + (u.pn & 1) * 256 + 32 * wc + 8 * fq;
#pragma unroll
                    for (int bj = 0; bj < 2; ++bj) *(u32x4*)(rowp + 128 * bj) = pack8(acc[ai][bj][m][0], acc[ai][bj][m][1]); }
        }
    }
};
struct EpiFourier {
    static constexpr bool PERM = true;
    bf16_t* Bdft; const float* vr;
    __device__ __forceinline__ void operator()(AccRef acc, const pg8::Unit& u, int wr, int wc, int fr, int fq) const {
        const int half = u.pm >> 1, pnl = u.pn - 64 * half, b = pnl >> 3, j0 = (pnl & 7) * 256;
        const int n0 = (u.pm & 1) * 256 + wr * 64 + fr;
        const bool patch = (half == 1) && (j0 == 0) && (wc == 0) && (fq == 0);
#pragma unroll
        for (int ai = 0; ai < 2; ++ai)
#pragma unroll
            for (int m = 0; m < 4; ++m) { const int n = n0 + ai * 128 + m * 16;
                bf16_t* rowp = Bdft + (size_t)(b * 512 + n) * 4096 + half * 2048 + j0 + 32 * wc + 8 * fq;
#pragma unroll
                for (int bj = 0; bj < 2; ++bj) { f32x4 v0 = acc[ai][bj][m][0]; if (patch && bj == 0) v0[0] = vr[b * 512 + n];
                    *(u32x4*)(rowp + 128 * bj) = pack8(v0, acc[ai][bj][m][1]); } }
    }
};
struct EpiDft {
    static constexpr bool PERM = true;
    bf16_t* Amix;
    __device__ __forceinline__ void operator()(AccRef acc, const pg8::Unit& u, int wr, int wc, int fr, int fq) const {
        const int b = u.pn >> 1, col0 = (u.pn & 1) * 256 + 32 * wc + 8 * fq, k0 = u.pm * 256 + wr * 64 + fr;
#pragma unroll
        for (int ai = 0; ai < 2; ++ai)
#pragma unroll
            for (int m = 0; m < 4; ++m) { bf16_t* rowp = Amix + (size_t)(b * 4096 + k0 + ai * 128 + m * 16) * 1024 + col0;
#pragma unroll
                for (int bj = 0; bj < 2; ++bj) *(u32x4*)(rowp + 128 * bj) = pack8(acc[ai][bj][m][0], acc[ai][bj][m][1]); }
    }
};
struct EpiOut {
    static constexpr bool PERM = false;
    const float* x; const float* mod; float* out;
    __device__ __forceinline__ void operator()(AccRef acc, const pg8::Unit& u, int wr, int wc, int fr, int fq) const {
        const int row0 = u.pm * 256 + wr * 64 + fr, col0 = u.pn * 256 + wc * 32 + 4 * fq, b = (u.pm * 256) >> 12;
        f32x4 gt[2][2];
#pragma unroll
        for (int bj = 0; bj < 2; ++bj)
#pragma unroll
            for (int n = 0; n < 2; ++n) gt[bj][n] = *(const f32x4*)(mod + b * 6144 + 2048 + col0 + bj * 128 + n * 16);
#pragma unroll
        for (int ai = 0; ai < 2; ++ai)
#pragma unroll
            for (int m = 0; m < 4; ++m) { const size_t off = (size_t)(row0 + ai * 128 + m * 16) * 1024 + col0;
#pragma unroll
                for (int bj = 0; bj < 2; ++bj)
#pragma unroll
                    for (int n = 0; n < 2; ++n) { const f32x4 xv = *(const f32x4*)(x + off + bj * 128 + n * 16); *(f32x4*)(out + off + bj * 128 + n * 16) = xv + gt[bj][n] * acc[ai][bj][m][n]; } }
    }
};
struct EpiSwiglu {
    static constexpr bool PERM = true;
    bf16_t* act; const float* b1p; const LAS unsigned char* tile_e;
    __device__ __forceinline__ void operator()(AccRef acc, const pg8::Unit& u, int wr, int wc, int fr, int fq) const {
        const int e = tile_e[u.pm]; const int row0 = u.pm * 256 + wr * 64 + fr, pc = 32 * wc + 8 * fq;
        const float* bp = b1p + e * 2048 + u.pn * 256 + pc;
        f32x4 bg[2], bl[2];
#pragma unroll
        for (int n = 0; n < 2; ++n) { bg[n] = *(const f32x4*)(bp + 4 * n); bl[n] = *(const f32x4*)(bp + 128 + 4 * n); }
#pragma unroll
        for (int ai = 0; ai < 2; ++ai)
#pragma unroll
            for (int m = 0; m < 4; ++m) { f32x4 o[2];
#pragma unroll
                for (int n = 0; n < 2; ++n) { const f32x4 g = acc[ai][0][m][n] + bg[n], l = acc[ai][1][m][n] + bl[n];
#pragma unroll
                    for (int i = 0; i < 4; ++i) { const float gg = fminf(g[i], 7.0f), ll = fminf(fmaxf(l[i], -7.0f), 7.0f);
                        const float sg = __builtin_amdgcn_rcpf(1.0f + __builtin_amdgcn_exp2f(-1.702f * LOG2E * gg)); o[n][i] = gg * sg * (ll + 1.0f); } }
                *(u32x4*)(act + (size_t)(row0 + ai * 128 + m * 16) * 1024 + u.pn * 128 + pc) = pack8(o[0], o[1]); }
    }
};
struct EpiDown {
    static constexpr bool PERM = true;
    bf16_t* slab; const float* b2; const float* slot_gate; const LAS unsigned char* tile_e; const LAS int* tstart;
    __device__ __forceinline__ void operator()(AccRef acc, const pg8::Unit& u, int wr, int wc, int fr, int fq) const {
        const int e = tile_e[u.pm]; const int rl = wr * 64 + fr, col0 = u.pn * 256 + 32 * wc + 8 * fq;
        const float* gp = slot_gate + (size_t)e * CAP + (u.pm - tstart[e]) * 256 + rl;
        f32x4 bv[2][2];
#pragma unroll
        for (int bj = 0; bj < 2; ++bj)
#pragma unroll
            for (int n = 0; n < 2; ++n) bv[bj][n] = *(const f32x4*)(b2 + e * 1024 + col0 + 128 * bj + 4 * n);
#pragma unroll
        for (int ai = 0; ai < 2; ++ai)
#pragma unroll
            for (int m = 0; m < 4; ++m) { const float gate = gp[ai * 128 + m * 16];
                bf16_t* rowp = slab + (size_t)(u.pm * 256 + rl + ai * 128 + m * 16) * 1024 + col0;
#pragma unroll
                for (int bj = 0; bj < 2; ++bj) *(u32x4*)(rowp + 128 * bj) = pack8((acc[ai][bj][m][0] + bv[bj][0]) * gate, (acc[ai][bj][m][1] + bv[bj][1]) * gate); }
    }
};

namespace att {
constexpr int QB = 256, KVB = 64, NT = SEQ / KVB;
constexpr int L_K = 0, L_V = 32768, L_Q = 65536;
#define SBAR() __builtin_amdgcn_sched_barrier(0)
__device__ __forceinline__ int crow(int r, int hi) { return (r & 3) + 8 * (r >> 2) + 4 * hi; }
__device__ __forceinline__ int swap23(int k) { return (k & ~0xC) | ((k & 4) << 1) | ((k & 8) >> 1); }
__device__ __forceinline__ int v_rd_base(int lane) { return ((lane & 3) << 3) | (((lane >> 2) & 3) << 6) | (((lane >> 4) & 1) << 5) | (((lane >> 5) & 1) << 8); }
constexpr int v_rd_off(int d0, int ks, int half) { return d0 * 512 + ks * 4096 + half * 2048; }
template <int OFF> __device__ __forceinline__ s16x4 tr_read(int vb) { s16x4 r; asm volatile("ds_read_b64_tr_b16 %0, %1 offset:%2" : "=&v"(r) : "v"(vb), "i"(OFF) : "memory"); return r; }
#define PKV(L, H) (bf16x8){L[0], L[1], L[2], L[3], H[0], H[1], H[2], H[3]}
template <int D0, int KB> __device__ __forceinline__ void pv_half(f32x16& oa, f32x16& ob, int vb, const bf16x8 (&pa)[2], const bf16x8 (&pb)[2]) {
    const s16x4 l0 = tr_read<v_rd_off(D0, 2 * KB, 0)>(vb), h0 = tr_read<v_rd_off(D0, 2 * KB, 1)>(vb), l1 = tr_read<v_rd_off(D0, 2 * KB + 1, 0)>(vb), h1 = tr_read<v_rd_off(D0, 2 * KB + 1, 1)>(vb);
    asm volatile("s_waitcnt lgkmcnt(0)" ::: "memory"); SBAR();
    oa = __builtin_amdgcn_mfma_f32_32x32x16_bf16(pa[0], PKV(l0, h0), oa, 0, 0, 0);
    ob = __builtin_amdgcn_mfma_f32_32x32x16_bf16(pb[0], PKV(l0, h0), ob, 0, 0, 0);
    oa = __builtin_amdgcn_mfma_f32_32x32x16_bf16(pa[1], PKV(l1, h1), oa, 0, 0, 0);
    ob = __builtin_amdgcn_mfma_f32_32x32x16_bf16(pb[1], PKV(l1, h1), ob, 0, 0, 0);
}
__device__ __forceinline__ void qkt(f32x16& p, const LAS unsigned char* kb, const LAS unsigned char* qb, const int (&co)[4], int off) {
    p = f32x16{};
#pragma unroll
    for (int d0 = 0; d0 < 4; ++d0) {
        const bf16x8 k0 = *(const LAS bf16x8*)(kb + co[d0] + off), qf = *(const LAS bf16x8*)(qb + co[d0] + (off & 255));
        p = __builtin_amdgcn_mfma_f32_32x32x16_bf16(k0, qf, p, 0, 0, 0);
    }
}
__device__ __forceinline__ void add_bias(f32x16& p, const LAS float* bt, int relb, int hi) {
#pragma unroll
    for (int r = 0; r < 16; ++r) { const int i0 = relb + crow(r, hi); p[r] += bt[i0 < 0 ? 0 : (i0 > 254 ? 254 : i0)]; }
}
__device__ __forceinline__ float softmax_pack(f32x16& p, bf16x8 (&pa)[2]) {
#pragma unroll
    for (int r = 0; r < 16; ++r) p[r] = __builtin_amdgcn_exp2f(p[r]);
    float ps = 0.f;
#pragma unroll
    for (int r = 0; r < 16; ++r) ps += p[r];
#define PK4(P, BASE, OUT) do { unsigned a0 = cvt_pk_bf16(P[BASE + 0], P[BASE + 1]), a1 = cvt_pk_bf16(P[BASE + 2], P[BASE + 3]); \
    unsigned b0 = cvt_pk_bf16(P[BASE + 4], P[BASE + 5]), b1 = cvt_pk_bf16(P[BASE + 6], P[BASE + 7]); \
    auto r0 = __builtin_amdgcn_permlane32_swap(a0, b0, false, false); auto r1 = __builtin_amdgcn_permlane32_swap(a1, b1, false, false); \
    u32x4 w = {r0[0], r1[0], r0[1], r1[1]}; OUT = __builtin_bit_cast(bf16x8, w); } while (0)
    PK4(p, 0, pa[0]); PK4(p, 8, pa[1]);
#undef PK4
    return ps;
}

struct Tensors { const bf16_t *Q, *K, *V; bf16_t* Amix; const float* btab; const float* gsub; float lam; };

__device__ __forceinline__ void attn_unit(LAS unsigned char* lds, const Tensors& T, int b, int h, int qb) {
    int tid_ = threadIdx.x; asm volatile("" : "+v"(tid_));
    const int tid = tid_, lane = tid & 63, r32 = lane & 31, hi = lane >> 5; const int wid = __builtin_amdgcn_readfirstlane(tid >> 6);
    const size_t rowbase = (size_t)b * SEQ; const int q0 = qb * QB;
    const bf16_t* Kh = T.K + rowbase * 512 + h * 128; const bf16_t* Vh = T.V + rowbase * 512 + h * 128; const bf16_t* Qh = T.Q + (rowbase + q0) * 512 + h * 128;
    LAS float* bt = (LAS float*)(lds + SP_BT); LAS float* wsf = (LAS float*)(lds + SP_WS) + wid * 64;
    unsigned ksrc[2], vsrc[2];
#pragma unroll
    for (int i = 0; i < 2; ++i) { const int p = wid * 2 + i; const int row = 4 * p + (lane >> 4), ch = (lane & 15) ^ (row & 7); ksrc[i] = (unsigned)(row * 512 + ch * 8) * 2u;
        const int st = 2 * p + (lane >> 5), kk = (st >> 2) * 8 + ((lane & 31) >> 2), cc = (st & 3) * 32 + (lane & 3) * 8; vsrc[i] = (unsigned)(swap23(kk) * 512 + cc) * 2u; }
    const unsigned ldsw = (unsigned)wid * 2048u;
#define DMA_TILE(t, buf) do { const char* kg = (const char*)(Kh + (size_t)(t) * KVB * 512); const char* vg = (const char*)(Vh + (size_t)(t) * KVB * 512); \
    _Pragma("unroll") for (int _i = 0; _i < 2; ++_i) { \
        __builtin_amdgcn_global_load_lds((const unsigned*)(kg + ksrc[_i]), (LAS unsigned*)(lds + L_K + (buf) * 16384 + ldsw + _i * 1024), 16, 0, 0); \
        __builtin_amdgcn_global_load_lds((const unsigned*)(vg + vsrc[_i]), (LAS unsigned*)(lds + L_V + (buf) * 16384 + ldsw + _i * 1024), 16, 0, 0); } } while (0)
    { int lq = lane; asm volatile("" : "+v"(lq));
      const int rq = lq >> 4; const unsigned qo0 = (unsigned)((32 * wid + rq) * 512 + (((lq & 15) ^ (rq & 7)) << 3)) * 2u, qo1 = (unsigned)((32 * wid + 4 + rq) * 512 + (((lq & 15) ^ ((4 + rq) & 7)) << 3)) * 2u;
#pragma unroll
      for (int i = 0; i < 8; ++i) { const int p = wid * 8 + i;
        __builtin_amdgcn_global_load_lds((const unsigned*)((const char*)Qh + ((i & 1) ? qo1 : qo0) + (size_t)(i >> 1) * 8192), (LAS unsigned*)(lds + L_Q + p * 1024), 16, 0, 0); } }
    DMA_TILE(0, 0);
    if (tid < 255) bt[tid] = T.btab[h * 256 + tid];
    int co[4];
#pragma unroll
    for (int d0 = 0; d0 < 4; ++d0) co[d0] = r32 * 256 + (((2 * d0 + hi) ^ (r32 & 7)) << 4);
    const LAS unsigned char* qbase = lds + L_Q + wid * 8192;
    const int vb0 = (int)(uintptr_t)(lds + L_V) + v_rd_base(lane);
    f32x16 o1[4], o2[4];
#pragma unroll
    for (int d = 0; d < 4; ++d) { o1[d] = f32x16{}; o2[d] = f32x16{}; }
    float l1 = 0.f, l2 = 0.f;
    const int qw = q0 + wid * 32;
    int state = (qw >= 154) ? 0 : 1;
    __syncthreads();
    for (int t = 0; t < NT; ++t) {
        const int buf = t & 1;
        if (t + 1 < NT) DMA_TILE(t + 1, buf ^ 1);
        const int k0 = t * KVB;
        const bool isneg = (k0 <= qw - 154), ispos = (k0 >= qw + 122);
        if (state == 0 && !isneg) { const float f = __builtin_amdgcn_exp2f(bt[0]); state = 1;
#pragma unroll
            for (int d = 0; d < 4; ++d) { o1[d] *= f; o2[d] *= f; }
            l1 *= f; l2 *= f; }
        if (state == 1 && ispos) { const float f = __builtin_amdgcn_exp2f(-bt[254]); state = 2;
#pragma unroll
            for (int d = 0; d < 4; ++d) { o1[d] *= f; o2[d] *= f; }
            l1 *= f; l2 *= f; }
        const LAS unsigned char* kbuf = lds + L_K + buf * 16384;
        const int vb = vb0 + buf * 16384; const int relb = k0 - (qw + r32) + 127;
        f32x16 p; bf16x8 pa[2], pb[2];
        qkt(p, kbuf, qbase, co, 0); if (state == 1) add_bias(p, bt, relb, hi); l1 += softmax_pack(p, pa);
        qkt(p, kbuf, qbase, co, 128); if (state == 1) add_bias(p, bt, relb, hi); l2 += softmax_pack(p, pb);
        pv_half<0, 0>(o1[0], o2[0], vb, pa, pb); pv_half<1, 0>(o1[1], o2[1], vb, pa, pb); pv_half<2, 0>(o1[2], o2[2], vb, pa, pb); pv_half<3, 0>(o1[3], o2[3], vb, pa, pb);
        qkt(p, kbuf, qbase, co, 8192); if (state == 1) add_bias(p, bt, relb + 32, hi); l1 += softmax_pack(p, pa);
        qkt(p, kbuf, qbase, co, 8192 + 128); if (state == 1) add_bias(p, bt, relb + 32, hi); l2 += softmax_pack(p, pb);
        pv_half<0, 1>(o1[0], o2[0], vb, pa, pb); pv_half<1, 1>(o1[1], o2[1], vb, pa, pb); pv_half<2, 1>(o1[2], o2[2], vb, pa, pb); pv_half<3, 1>(o1[3], o2[3], vb, pa, pb);
        __syncthreads();
    }
#undef DMA_TILE
    l1 += __shfl_xor(l1, 32); l2 += __shfl_xor(l2, 32);
    if (hi == 0) { wsf[r32] = 1.0f / l1; wsf[32 + r32] = T.lam / l2; }
    LDS_WAIT();
    float gs[4];
#pragma unroll
    for (int d = 0; d < 4; ++d) gs[d] = T.gsub[32 * d + r32] * (1.0f - LAM_INIT);
    bf16_t* Ow = T.Amix + (rowbase + q0 + wid * 32 + 4 * hi) * 1024 + 512 + h * 128 + r32; asm volatile("" : "+v"(Ow));
#pragma unroll
    for (int r = 0; r < 16; ++r) { const int row = crow(r, hi); const float c1 = wsf[row], c2 = wsf[32 + row];
        float y[4], ss = 0.f;
#pragma unroll
        for (int d = 0; d < 4; ++d) { y[d] = o1[d][r] * c1 - o2[d][r] * c2; ss += y[d] * y[d]; }
        ss += __shfl_xor(ss, 1); ss += __shfl_xor(ss, 2); ss += __shfl_xor(ss, 4); ss += __shfl_xor(ss, 8); ss += __shfl_xor(ss, 16);
        const float rr = rsqrtf(ss * (1.0f / 128.0f) + EPS);
#pragma unroll
        for (int d = 0; d < 4; ++d) Ow[(size_t)((r & 3) + 8 * (r >> 2)) * 1024 + 32 * d] = (bf16_t)(cvt_pk_bf16(y[d] * rr * gs[d], 0.f) & 0xffffu); }
    __syncthreads();
}
#undef SBAR
#undef PKV
}

__device__ __forceinline__ void tr_item(const float* W, int ldw, bf16_t* WT, int ldt, LAS float* scr, int lane) {
    float tv[32]; const float* wb = W + (size_t)(lane >> 5) * ldw + (lane & 31);
#pragma unroll
    for (int i = 0; i < 32; ++i) tv[i] = wb[(size_t)(2 * i) * ldw];
#pragma unroll
    for (int i = 0; i < 32; ++i) scr[(2 * i + (lane >> 5)) * 33 + (lane & 31)] = tv[i];
    LDS_WAIT(); asm volatile("" ::: "memory");
    const int c = lane & 7;
#pragma unroll
    for (int j = 0; j < 4; ++j) { const int n = (lane >> 3) + 8 * j; const LAS float* s = scr + (8 * c) * 33 + n;
        u32x4 o; o.x = cvt_pk_bf16(s[0 * 33], s[1 * 33]); o.y = cvt_pk_bf16(s[2 * 33], s[3 * 33]); o.z = cvt_pk_bf16(s[4 * 33], s[5 * 33]); o.w = cvt_pk_bf16(s[6 * 33], s[7 * 33]);
        *(u32x4*)(WT + (size_t)n * ldt + 8 * c) = o; }
    LDS_WAIT(); asm volatile("" ::: "memory");
}
__device__ __forceinline__ int qk_logical(int p) { return 64 * ((p >> 5) & 3) + 32 * (p >> 7) + (p & 31); }

__device__ __forceinline__ int t5_bucket_idx(int rel) {
    const int ret = rel > 0 ? 16 : 0; const int n = rel < 0 ? -rel : rel;
    const float nf = (float)(n < 1 ? 1 : n);
    int large = 8 + (int)(logf(nf / 8.0f) / logf(16.0f) * 8.0f); large = large < 15 ? large : 15;
    if (n == 16) large = 10; if (n == 32) large = 12; if (n == 64) large = 14;
    return ret + (n < 8 ? n : large);
}

constexpr int P0_SCR = 16640;
constexpr int P0_CTAB = 8 * P0_SCR;
__device__ __forceinline__ float cos4096(const LAS float* tab, int m) { m &= 4095; if (m > 2048) m = 4096 - m; return (m <= 1024) ? tab[m] : -tab[2048 - m]; }
#define P0_WLOAD(v, r) do { const float* src_; int ld_; { int rr_ = (r); if (rr_ < I_W2) { const int e = rr_ >> 8, kc = (rr_ >> 4) & 15, nc = rr_ & 15; src_ = F.w2 + (size_t)e * 1048576 + (size_t)(kc * 64) * 1024 + nc * 64 + lane; ld_ = 1024; } \
        else { rr_ -= I_W2; const int e = rr_ >> 9, kc = (rr_ >> 5) & 15, nc = rr_ & 31; src_ = F.w1 + (size_t)e * 2097152 + (size_t)(kc * 64) * 2048 + nc * 64 + lane; ld_ = 2048; } } \
        _Pragma("unroll") for (int kk = 0; kk < 64; ++kk) v[kk] = __builtin_nontemporal_load(src_ + (size_t)kk * ld_); } while (0)
#define P0_WPROC(v, r) do { bf16_t* dst_; int nl_; { int rr_ = (r); if (rr_ < I_W2) { const int e = rr_ >> 8, kc = (rr_ >> 4) & 15, nc = rr_ & 15; nl_ = lane; dst_ = wsp<bf16_t>(F, WS_W2) + (size_t)e * 1048576 + (size_t)(nc * 64 + lane) * 1024 + kc * 64; } \
        else { rr_ -= I_W2; const int e = rr_ >> 9, kc = (rr_ >> 5) & 15, nc = rr_ & 31, pn = nc >> 2, p0 = 32 * (nc & 3); nl_ = (lane < 32) ? 2 * lane : 2 * (lane - 32) + 1; \
               dst_ = wsp<bf16_t>(F, WS_W1) + (size_t)e * 2097152 + (size_t)(pn * 256 + ((lane < 32) ? (p0 + lane) : (128 + p0 + lane - 32))) * 1024 + kc * 64; } } \
        _Pragma("unroll") for (int kk = 0; kk < 64; ++kk) scr[kk * 65 + lane] = v[kk]; \
        LDS_WAIT(); asm volatile("" ::: "memory"); \
        _Pragma("unroll") for (int q = 0; q < 8; ++q) { const LAS float* s_ = scr + (8 * q) * 65 + nl_; u32x4 o_; o_.x = cvt_pk_bf16(s_[0], s_[65]); o_.y = cvt_pk_bf16(s_[130], s_[195]); o_.z = cvt_pk_bf16(s_[260], s_[325]); o_.w = cvt_pk_bf16(s_[390], s_[455]); \
            *(u32x4*)(dst_ + 8 * q) = o_; } \
        LDS_WAIT(); asm volatile("" ::: "memory"); } while (0)
__device__ __forceinline__ void p0_prologue(Frame& F) {
    LAS float* scr = (LAS float*)(F.lds + F.wave * P0_SCR);
    LAS float* ctab = (LAS float*)(F.lds + P0_CTAB);
    for (int m = F.tid; m < 1025; m += 512) ctab[m] = cospif((float)m * (1.0f / 2048.0f));
    __syncthreads();
    const int gw = F.vcu * NWAVES + F.wave, NGW = F.G * NWAVES, lane = F.lane;
    constexpr int I_MOD = 96, I_QKV = 16 * 48, I_WOUT = 8 * 32, I_FCS = 256, I_FOUT = 512, I_ADFT = 4096, I_MISC = 65;
    constexpr int NITEMS = I_MOD + I_QKV + I_WOUT + I_FCS + I_FOUT + I_MISC + I_ADFT;
    constexpr int I_W2 = 32 * 16 * 16, I_W1 = 32 * 16 * 32, NW12 = I_W2 + I_W1;
    float* mod = wsp<float>(F, WS_MOD);
    const int lane0 = lane;
    for (int it = gw; it < NITEMS; it += NGW) {
        int r = it;
        int lane = lane0; asm volatile("" : "+v"(lane));
        if (r < I_MOD) {
            const int col = r * 64 + lane; float acc[8];
#pragma unroll
            for (int b = 0; b < 8; ++b) acc[b] = 0.f;
            for (int kc = 0; kc < 16; ++kc) {
                float wv[64];
#pragma unroll
                for (int kk = 0; kk < 64; ++kk) wv[kk] = __builtin_nontemporal_load(F.w_ada + (size_t)(kc * 64 + kk) * 6144 + col);
#pragma unroll
                for (int b = 0; b < 8; ++b) { const float cv = F.c[b * 1024 + kc * 64 + lane]; scr[lane * 8 + b] = cv / (1.0f + __expf(-cv)); }
                LDS_WAIT(); asm volatile("" ::: "memory");
#pragma unroll
                for (int kk = 0; kk < 64; ++kk) { const float w = wv[kk];
                    const f32x4 s0 = *(const LAS f32x4*)(scr + kk * 8), s1 = *(const LAS f32x4*)(scr + kk * 8 + 4);
                    acc[0] += s0[0] * w; acc[1] += s0[1] * w; acc[2] += s0[2] * w; acc[3] += s0[3] * w; acc[4] += s1[0] * w; acc[5] += s1[1] * w; acc[6] += s1[2] * w; acc[7] += s1[3] * w; }
                LDS_WAIT(); asm volatile("" ::: "memory");
            }
            const float bb = F.b_ada[col];
#pragma unroll
            for (int b = 0; b < 8; ++b) mod[b * 6144 + col] = acc[b] + bb;
            continue; }
        r -= I_MOD;
        if (r < I_QKV) {
            const int kb = r / 48, nb = r % 48, prow = nb * 32, tile = prow >> 8, p = prow & 255;
            const int lcol = 512 + tile * 256 + (tile < 4 ? qk_logical(p) : p);
            tr_item(F.w_in + (size_t)(kb * 64) * 2048 + lcol, 2048, wsp<bf16_t>(F, WS_WQKV) + (size_t)prow * 1024 + kb * 64, 1024, scr, lane);
            continue; }
        r -= I_QKV;
        if (r < I_WOUT) {
            const int kb = r / 32, nb = r % 32;
            tr_item(F.w_out + (size_t)(512 + kb * 64) * 1024 + nb * 32, 1024, wsp<bf16_t>(F, WS_WOUT) + (size_t)(nb * 32) * 1024 + 512 + kb * 64, 1024, scr, lane);
            continue; }
        r -= I_WOUT;
        if (r < I_FCS) {
            const int g = r >> 6, d0 = (r & 63) * 16;
#pragma unroll
            for (int dd = 0; dd < 16; ++dd) { scr[dd * 129 + lane] = F.w_in[(size_t)(d0 + dd) * 2048 + g * 128 + lane]; scr[dd * 129 + 64 + lane] = F.w_in[(size_t)(d0 + dd) * 2048 + g * 128 + 64 + lane]; }
            LAS float* t128 = scr + 16 * 129;
            t128[lane] = cos4096(ctab, lane * 32); t128[64 + lane] = cos4096(ctab, (64 + lane) * 32);
            LDS_WAIT(); asm volatile("" ::: "memory");
            const int d = lane & 15, kq = lane >> 4; float ac[32], as[32];
#pragma unroll
            for (int i = 0; i < 32; ++i) { ac[i] = 0.f; as[i] = 0.f; }
            for (int c = 0; c < 128; ++c) { const float a = scr[d * 129 + c];
#pragma unroll
                for (int i = 0; i < 32; ++i) { const int idx = (c * (kq * 32 + i)) & 127; ac[i] += a * t128[idx]; as[i] += a * t128[(idx - 32) & 127]; } }
            const float sc = 0.08838834764831845f;
            bf16_t* wc = wsp<bf16_t>(F, WS_WCS);
#pragma unroll
            for (int i = 0; i < 32; ++i) { const int n = g * 128 + kq * 32 + i;
                wc[(size_t)n * 1024 + d0 + d] = (bf16_t)(cvt_pk_bf16(ac[i] * sc, 0.f) & 0xffffu); wc[(size_t)(512 + n) * 1024 + d0 + d] = (bf16_t)(cvt_pk_bf16(-as[i] * sc, 0.f) & 0xffffu); }
            LDS_WAIT(); asm volatile("" ::: "memory");
            continue; }
        r -= I_FCS;
        if (r < I_FOUT) {
            const int g = r >> 7, dc = (r >> 3) & 15, kc0 = (r & 7) * 16;
#pragma unroll
            for (int i = 0; i < 16; ++i) { scr[i * 128 + lane] = F.w_fourier[(size_t)(g * 128 + kc0 + i) * 128 + lane]; scr[i * 128 + 64 + lane] = F.w_fourier[(size_t)(g * 128 + kc0 + i) * 128 + 64 + lane]; }
            LDS_WAIT(); asm volatile("" ::: "memory");
            float acc[16];
#pragma unroll
            for (int i = 0; i < 16; ++i) acc[i] = 0.f;
            const int dout = dc * 64 + lane;
#pragma unroll 16
            for (int d = 0; d < 128; ++d) { const float a = F.w_out[(size_t)(g * 128 + d) * 1024 + dout];
#pragma unroll
                for (int i = 0; i < 16; ++i) acc[i] += scr[i * 128 + d] * a; }
            u32x4 o0, o1; o0.x = cvt_pk_bf16(acc[0], acc[1]); o0.y = cvt_pk_bf16(acc[2], acc[3]); o0.z = cvt_pk_bf16(acc[4], acc[5]); o0.w = cvt_pk_bf16(acc[6], acc[7]);
            o1.x = cvt_pk_bf16(acc[8], acc[9]); o1.y = cvt_pk_bf16(acc[10], acc[11]); o1.z = cvt_pk_bf16(acc[12], acc[13]); o1.w = cvt_pk_bf16(acc[14], acc[15]);
            bf16_t* dst = wsp<bf16_t>(F, WS_WOUT) + (size_t)dout * 1024 + g * 128 + kc0;
            *(u32x4*)dst = o0; *(u32x4*)(dst + 8) = o1;
            LDS_WAIT(); asm volatile("" ::: "memory");
            continue; }
        r -= I_FOUT;
        if (r < I_MISC) {
            if (r == 0) { float* bt = wsp<float>(F, WS_BTAB);
                for (int i = lane; i < 4 * 256; i += 64) { const int h = i >> 8, ri = i & 255; const int rel = (ri > 254 ? 254 : ri) - 127; bt[i] = F.rel_bias[t5_bucket_idx(rel) * 4 + h] * LOG2E; } }
            else { float* bp = wsp<float>(F, WS_B1P); const int base = (r - 1) * 1024;
                for (int i = lane; i < 1024; i += 64) { const int idx = base + i, e = idx >> 11, pc = idx & 2047, pn = pc >> 8, p = pc & 255;
                    bp[idx] = F.b1[e * 2048 + pn * 256 + (p < 128 ? 2 * p : 2 * (p - 128) + 1)]; } }
            continue; }
        r -= I_MISC;
        {
            const int k = r; bf16_t* row = wsp<bf16_t>(F, WS_ADFT) + (size_t)k * 4096;
#pragma unroll
            for (int ch = 0; ch < 8; ++ch) { const int j0 = ch * 512 + lane * 8; float v[8];
#pragma unroll
                for (int e = 0; e < 8; ++e) { const int j = j0 + e;
                    if (j < 2048) v[e] = cos4096(ctab, k * j);
                    else if (j == 2048) v[e] = (k & 1) ? -1.0f : 1.0f;
                    else v[e] = cos4096(ctab, k * (j - 2048) - 1024);
                    v[e] *= (1.0f / 64.0f); }
                u32x4 o; o.x = cvt_pk_bf16(v[0], v[1]); o.y = cvt_pk_bf16(v[2], v[3]); o.z = cvt_pk_bf16(v[4], v[5]); o.w = cvt_pk_bf16(v[6], v[7]);
                *(u32x4*)(row + j0) = o; }
        }
    }
    {
        float va[64], vb[64];
        int r = gw;
        if (r < NW12) P0_WLOAD(va, r);
        for (; r < NW12; r += 2 * NGW) {
            const int r1 = r + NGW, r2 = r1 + NGW;
            if (r1 < NW12) P0_WLOAD(vb, r1);
            P0_WPROC(va, r);
            if (r2 < NW12) P0_WLOAD(va, r2);
            if (r1 < NW12) P0_WPROC(vb, r1);
        }
    }
}
#undef P0_WLOAD
#undef P0_WPROC

__device__ __forceinline__ void load_row(const float* xrow, int lane, f32x4 (&h)[4]) {
#pragma unroll
    for (int j = 0; j < 4; ++j) h[j] = *((const f32x4*)xrow + lane + 64 * j);
}
__device__ __forceinline__ void norm_row(const float* g, const float* sh, const float* sc, int lane, f32x4 (&h)[4]) {
    float s = 0.f;
#pragma unroll
    for (int j = 0; j < 4; ++j) s += (h[j][0] * h[j][0] + h[j][1] * h[j][1]) + (h[j][2] * h[j][2] + h[j][3] * h[j][3]);
    const float rr = rsqrtf(wave_sum(s) * (1.0f / 1024.0f) + EPS);
#pragma unroll
    for (int j = 0; j < 4; ++j) { const f32x4 gv = *((const f32x4*)g + lane + 64 * j), sv = *((const f32x4*)sc + lane + 64 * j), hv = *((const f32x4*)sh + lane + 64 * j);
        h[j] = h[j] * rr * gv * (sv + 1.0f) + hv; }
}
__device__ __forceinline__ void store_row_bf16(bf16_t* row, int lane, const f32x4 (&h)[4]) {
#pragma unroll
    for (int j = 0; j < 4; ++j) { u32x2 w; w.x = cvt_pk_bf16(h[j][0], h[j][1]); w.y = cvt_pk_bf16(h[j][2], h[j][3]); *((u32x2*)row + lane + 64 * j) = w; }
}
constexpr int P1_GEMV = 512, P1_NITEMS = P1_GEMV + NB * (HSEQ + 1);
__device__ __forceinline__ void p1_decode(int w, int& b, int& j) { if (w < P1_GEMV) { b = w >> 6; j = HSEQ; } else { w -= P1_GEMV; b = w / (HSEQ + 1); j = w % (HSEQ + 1); } }
__device__ __forceinline__ void p1_rows(Frame& F) {
    const int gw = F.vcu * NWAVES + F.wave, NGW = F.G * NWAVES, lane = F.lane;
    const float* mod = wsp<float>(F, WS_MOD);
    bf16_t* XN = wsp<bf16_t>(F, WS_XN); bf16_t* XS = wsp<bf16_t>(F, WS_XNSA); bf16_t* XA = XS + (size_t)NB * HSEQ * 1024;
    f32x4 h0[4], h1[4], n0[4], n1[4];
    int w = gw;
    if (w < P1_NITEMS) { int b, j; p1_decode(w, b, j); load_row(F.x + ((size_t)b * SEQ + j) * 1024, lane, h0); load_row(F.x + ((size_t)b * SEQ + ((SEQ - j) & (SEQ - 1))) * 1024, lane, h1); }
    for (; w < P1_NITEMS; w += NGW) {
        const int wn = w + NGW;
        if (wn < P1_NITEMS) { int b, j; p1_decode(wn, b, j); load_row(F.x + ((size_t)b * SEQ + j) * 1024, lane, n0); load_row(F.x + ((size_t)b * SEQ + ((SEQ - j) & (SEQ - 1))) * 1024, lane, n1); }
        int b, j; p1_decode(w, b, j);
        const float* sh = mod + b * 6144; const float* sc = sh + 1024;
        norm_row(F.g_mix, sh, sc, lane, h0);
        if (w < P1_GEMV) {
            const int nb = (w & 63) * 8; const bf16_t* wc = wsp<bf16_t>(F, WS_WCS) + (size_t)nb * 1024; float* vr = wsp<float>(F, WS_VR);
            float sacc[8];
#pragma unroll
            for (int n = 0; n < 8; ++n) { float sv = 0.f;
#pragma unroll
                for (int q = 0; q < 4; ++q) { const u32x2 wv = *((const u32x2*)(wc + (size_t)n * 1024) + lane + 64 * q);
                    sv += h0[q][0] * __uint_as_float(wv.x << 16) + h0[q][1] * __uint_as_float(wv.x & 0xffff0000u) + h0[q][2] * __uint_as_float(wv.y << 16) + h0[q][3] * __uint_as_float(wv.y & 0xffff0000u); }
                sacc[n] = sv; }
#pragma unroll
            for (int n = 0; n < 8; ++n) { const float t = wave_sum(sacc[n]); if (lane == 0) vr[b * 512 + nb + n] = t; }
        } else {
            store_row_bf16(XN + ((size_t)b * SEQ + j) * 1024, lane, h0);
            if (j == 0) {
                store_row_bf16(XS + ((size_t)b * HSEQ) * 1024, lane, h0);
                f32x4 z[4];
#pragma unroll
                for (int q = 0; q < 4; ++q) z[q] = (f32x4){0.f, 0.f, 0.f, 0.f};
                store_row_bf16(XA + ((size_t)b * HSEQ) * 1024, lane, z);
            } else if (j != HSEQ) {
                f32x4 t[4];
                norm_row(F.g_mix, sh, sc, lane, h1);
                store_row_bf16(XN + ((size_t)b * SEQ + (SEQ - j)) * 1024, lane, h1);
#pragma unroll
                for (int q = 0; q < 4; ++q) t[q] = h0[q] + h1[q];
                store_row_bf16(XS + ((size_t)b * HSEQ + j) * 1024, lane, t);
#pragma unroll
                for (int q = 0; q < 4; ++q) t[q] = h0[q] - h1[q];
                store_row_bf16(XA + ((size_t)b * HSEQ + j) * 1024, lane, t);
            }
        }
#pragma unroll
        for (int q = 0; q < 4; ++q) { h0[q] = n0[q]; h1[q] = n1[q]; }
    }
}

__device__ __forceinline__ void moe_tables(Frame& F) {
    LAS int* cnt = (LAS int*)(F.lds + SP_CNT); LAS int* tstart = (LAS int*)(F.lds + SP_TSTART); LAS unsigned char* tile_e = F.lds + SP_TILEE;
    __syncthreads();
    if (F.tid < 32) cnt[F.tid] = (int)__hip_atomic_load(F.ctl + CW_GCNT + 64 * F.tid, RLX_AGENT);
    __syncthreads();
    if (F.tid == 0) { int s = 0; for (int e = 0; e < 32; ++e) { tstart[e] = s; s += (cnt[e] + 255) >> 8; } tstart[32] = s; tstart[33] = s; }
    __syncthreads();
    const int total = tstart[32];
    for (int pm = F.tid; pm < total; pm += 512) { int e = 0;
        for (int q = 1; q < 32; ++q) e += (pm >= tstart[q]) ? 1 : 0;
        tile_e[pm] = (unsigned char)e; }
    __syncthreads();
}

constexpr int SP_LCNT = SP_OFF + 5120, SP_LBASE = SP_OFF + 5376, SP_STASH = SP_OFF + 6144;
__device__ __forceinline__ void p5_router(Frame& F) {
    const int lane = F.lane, tid = F.tid;
    LAS f32x4* W4 = (LAS f32x4*)F.lds;
    for (int idx = tid; idx < 1024 * 8; idx += 512) { const int d = idx >> 3, e4 = idx & 7; const f32x4 v = *((const f32x4*)(F.w_router + (size_t)d * 32) + e4);
        const int jj = d >> 8, ln = (d & 255) >> 2, i = d & 3; W4[((jj * 4 + i) * 8 + e4) * 64 + ln] = v; }
    LAS int* lcnt = (LAS int*)(F.lds + SP_LCNT); LAS int* lbase = (LAS int*)(F.lds + SP_LBASE); LAS int* stash = (LAS int*)(F.lds + SP_STASH);
    if (tid < 32) lcnt[tid] = 0;
    __syncthreads();
    const float* mod = wsp<float>(F, WS_MOD); bf16_t* XN2 = wsp<bf16_t>(F, WS_XN2);
    const int e_lane = ((lane >> 5) & 1) * 16 + ((lane >> 4) & 1) * 8 + ((lane >> 3) & 1) * 4 + ((lane >> 2) & 1) * 2 + ((lane >> 1) & 1);
    const float brt = F.b_router[e_lane];
    f32x4 h[4], hn[4];
    load_row(F.out + (size_t)(F.vcu * 128 + F.wave * 16) * 1024, lane, h);
    for (int rl = 0; rl < 16; ++rl) {
        const int trow = F.vcu * 128 + F.wave * 16 + rl, b = trow >> 12;
        if (rl + 1 < 16) load_row(F.out + (size_t)(trow + 1) * 1024, lane, hn);
        norm_row(F.g_ffn, mod + b * 6144 + 3072, mod + b * 6144 + 4096, lane, h);
        store_row_bf16(XN2 + (size_t)trow * 1024, lane, h);
        float acc[32];
#pragma unroll
        for (int e = 0; e < 32; ++e) acc[e] = 0.f;
#pragma unroll
        for (int jj = 0; jj < 4; ++jj)
#pragma unroll
            for (int i = 0; i < 4; ++i) { const float hv = h[jj][i];
#pragma unroll
                for (int e4 = 0; e4 < 8; ++e4) { const f32x4 w = W4[((jj * 4 + i) * 8 + e4) * 64 + lane];
                    acc[4 * e4 + 0] += hv * w[0]; acc[4 * e4 + 1] += hv * w[1]; acc[4 * e4 + 2] += hv * w[2]; acc[4 * e4 + 3] += hv * w[3]; } }
        float s16[16];
#pragma unroll
        for (int i = 0; i < 16; ++i) { const float send = (lane & 32) ? acc[i] : acc[16 + i], keep = (lane & 32) ? acc[16 + i] : acc[i]; s16[i] = keep + __shfl_xor(send, 32); }
        float s8[8];
#pragma unroll
        for (int i = 0; i < 8; ++i) { const float send = (lane & 16) ? s16[i] : s16[8 + i], keep = (lane & 16) ? s16[8 + i] : s16[i]; s8[i] = keep + __shfl_xor(send, 16); }
        float s4[4];
#pragma unroll
        for (int i = 0; i < 4; ++i) { const float send = (lane & 8) ? s8[i] : s8[4 + i], keep = (lane & 8) ? s8[4 + i] : s8[i]; s4[i] = keep + __shfl_xor(send, 8); }
        float s2[2];
#pragma unroll
        for (int i = 0; i < 2; ++i) { const float send = (lane & 4) ? s4[i] : s4[2 + i], keep = (lane & 4) ? s4[2 + i] : s4[i]; s2[i] = keep + __shfl_xor(send, 4); }
        float lg; { const float send = (lane & 2) ? s2[0] : s2[1], keep = (lane & 2) ? s2[1] : s2[0]; lg = keep + __shfl_xor(send, 2); }
        lg += __shfl_xor(lg, 1); lg += brt;
        float tv[4]; int te[4]; float cur = lg;
#pragma unroll
        for (int k = 0; k < 4; ++k) { float bv = cur; int be = e_lane;
#pragma unroll
            for (int o = 2; o < 64; o <<= 1) { const float ov = __shfl_xor(bv, o); const int oe = __shfl_xor(be, o); const bool take = (ov > bv) || (ov == bv && oe < be); bv = take ? ov : bv; be = take ? oe : be; }
            tv[k] = bv; te[k] = be; if (e_lane == be) cur = -INFINITY; }
        const float e1 = __expf(tv[1] - tv[0]), e2 = __expf(tv[2] - tv[0]), e3 = __expf(tv[3] - tv[0]); const float inv = 1.0f / (1.0f + e1 + e2 + e3);
        if (lane < 4) { const int k = lane; const int e = (k == 0) ? te[0] : (k == 1) ? te[1] : (k == 2) ? te[2] : te[3];
            const float gk = ((k == 0) ? 1.0f : (k == 1) ? e1 : (k == 2) ? e2 : e3) * inv;
            const int lr = atomicAdd((int*)(lcnt + e), 1);
            const int si = ((F.wave * 16 + rl) * 4 + k) * 4; stash[si] = trow * 4 + k; stash[si + 1] = e; stash[si + 2] = lr; stash[si + 3] = __float_as_int(gk); }
#pragma unroll
        for (int q = 0; q < 4; ++q) h[q] = hn[q];
    }
    __syncthreads();
    if (tid < 32) lbase[tid] = (int)__hip_atomic_fetch_add(F.ctl + CW_GCNT + 64 * tid, (unsigned)lcnt[tid], RLX_AGENT);
    __syncthreads();
    { const int si = tid * 4; const int tk = stash[si], e = stash[si + 1], slot = lbase[e] + stash[si + 2];
      wsp<unsigned>(F, WS_SLOTTOK)[(size_t)e * CAP + slot] = (unsigned)(tk >> 2);
      wsp<int>(F, WS_SLOTGATE)[(size_t)e * CAP + slot] = stash[si + 3];
      wsp<unsigned>(F, WS_TOKSLOT)[tk] = (unsigned)(e * CAP + slot); }
}

__device__ __forceinline__ void p8_combine(Frame& F) {
    const int lane = F.lane; const LAS int* tstart = (const LAS int*)(F.lds + SP_TSTART);
    const float* mod = wsp<float>(F, WS_MOD); const bf16_t* slab = wsp<bf16_t>(F, WS_SLAB); const unsigned* ts = wsp<unsigned>(F, WS_TOKSLOT);
    const int trow0 = F.vcu * 128 + F.wave * 16, b = trow0 >> 12;
    int myrow[4];
    { const u32x4 sl = *(const u32x4*)(ts + (size_t)(trow0 + (lane & 15)) * 4);
#pragma unroll
      for (int k = 0; k < 4; ++k) { const unsigned v = sl[k]; myrow[k] = tstart[v >> 15] * 256 + (int)(v & 32767u); } }
    f32x4 gt[4];
#pragma unroll
    for (int j = 0; j < 4; ++j) gt[j] = *((const f32x4*)(mod + b * 6144 + 5120) + lane + 64 * j);
#define P8_LOAD(rl, SV, XV) do { _Pragma("unroll") for (int k = 0; k < 4; ++k) { const size_t ar = (size_t)__shfl(myrow[k], (rl)) * 1024; \
        _Pragma("unroll") for (int j = 0; j < 4; ++j) SV[k][j] = *((const u32x2*)(slab + ar) + lane + 64 * j); } \
        _Pragma("unroll") for (int j = 0; j < 4; ++j) XV[j] = *((const f32x4*)(F.out + (size_t)(trow0 + (rl)) * 1024) + lane + 64 * j); } while (0)
#define P8_PROC(rl, SV, XV) do { _Pragma("unroll") for (int j = 0; j < 4; ++j) { f32x4 s = (f32x4){0.f, 0.f, 0.f, 0.f}; \
        _Pragma("unroll") for (int k = 0; k < 4; ++k) { const u32x2 wv = SV[k][j]; s[0] += __uint_as_float(wv.x << 16); s[1] += __uint_as_float(wv.x & 0xffff0000u); s[2] += __uint_as_float(wv.y << 16); s[3] += __uint_as_float(wv.y & 0xffff0000u); } \
        *((f32x4*)(F.out + (size_t)(trow0 + (rl)) * 1024) + lane + 64 * j) = XV[j] + gt[j] * s; } } while (0)
    u32x2 sa[4][4], sb[4][4]; f32x4 xa[4], xb[4];
    P8_LOAD(0, sa, xa);
    for (int rl = 0; rl < 16; rl += 2) {
        P8_LOAD(rl + 1, sb, xb);
        P8_PROC(rl, sa, xa);
        if (rl + 2 < 16) P8_LOAD(rl + 2, sa, xa);
        P8_PROC(rl + 1, sb, xb);
    }
#undef P8_LOAD
#undef P8_PROC
}

constexpr int NPHASE = 9;
struct Args { const float* in[23]; float* out; unsigned char* ws; int ph_lo, ph_hi, skip, pad; };
__global__ void __launch_bounds__(NWAVES * 64, 2) mk_fwd(Args args) {
    extern __shared__ __attribute__((aligned(16))) unsigned char lds_[];
    Frame F;
    F.lds = (LAS unsigned char*)lds_;
    F.MISC = (volatile LAS unsigned*)(F.lds + SP_MISC);
    F.tid = threadIdx.x; F.lane = F.tid & 63; F.wave = __builtin_amdgcn_readfirstlane(F.tid >> 6);
    F.G = gridDim.x; { const int bx = blockIdx.x; F.vcu = (F.G % 8 == 0) ? (bx % 8) * (F.G / 8) + bx / 8 : bx; }
    F.ws = args.ws; F.ctl = (unsigned*)(args.ws + WS_CTL); F.out = args.out;
    F.x = args.in[0]; F.c = args.in[1]; F.w_ada = args.in[2]; F.b_ada = args.in[3]; F.g_mix = args.in[4]; F.w_in = args.in[5]; F.w_fourier = args.in[6];
    F.q_norm_g = args.in[7]; F.k_norm_g = args.in[8]; F.lq1 = args.in[9]; F.lk1 = args.in[10]; F.lq2 = args.in[11]; F.lk2 = args.in[12]; F.g_subln = args.in[13];
    F.w_out = args.in[14]; F.rel_bias = args.in[15]; F.g_ffn = args.in[16]; F.w_router = args.in[17]; F.b_router = args.in[18]; F.w1 = args.in[19]; F.b1 = args.in[20];
    F.w2 = args.in[21]; F.b2 = args.in[22];
    if (F.tid < 64) ((LAS unsigned*)(F.lds + SP_MISC))[F.tid] = 0u;
    __syncthreads();
    const int lo = args.ph_lo, hi = args.ph_hi;
    XcdBarrier bar; bar.bar = F.ctl + CW_BAR; bar.x = 0; bar.st = nullptr;
    if (hi - lo > 1) bar = xcd_barrier_post(F.ctl + CW_BAR, F.MISC + 8);
#ifndef PH_MASK
#define PH_MASK 0x1ff
#endif
#define IN(k) (((PH_MASK >> (k)) & 1) && lo <= (k) && (k) < hi)
#define SEAM(k) do { if (IN(k) && IN((k) + 1)) xcd_barrier(bar); } while (0)
    const int cblk = (int)blockIdx.x;

    if (IN(0)) { p0_prologue(F); }
    SEAM(0);
    if (IN(1)) { p1_rows(F); }
    SEAM(1);
    if (IN(2)) {
        { SchedPlain S{(const char*)wsp<bf16_t>(F, WS_XN), (const char*)wsp<bf16_t>(F, WS_WQKV), NTOK / 256, NQKV / 256, F.G, cblk, (size_t)256 * 1024 * 2};
          EpiQKV E{wsp<bf16_t>(F, WS_Q), wsp<bf16_t>(F, WS_K), wsp<bf16_t>(F, WS_V), F.q_norm_g, F.k_norm_g};
          pg8::gemm_phase<EpiQKV, SchedPlain>(F.lds, 1024, S, E); }
        { SchedFourier S{(const char*)wsp<bf16_t>(F, WS_WCS), (const char*)wsp<bf16_t>(F, WS_XNSA), F.G, cblk, (size_t)256 * 1024 * 2};
          EpiFourier E{wsp<bf16_t>(F, WS_BDFT), wsp<float>(F, WS_VR)};
          pg8::gemm_phase<EpiFourier, SchedFourier>(F.lds, 1024, S, E); }
    }
    SEAM(2);
    if (IN(3)) {
        float lam;
        { const float a = F.lq1[F.lane] * F.lk1[F.lane], b = F.lq2[F.lane] * F.lk2[F.lane]; lam = __expf(wave_sum(a)) - __expf(wave_sum(b)) + LAM_INIT; }
        att::Tensors T{wsp<bf16_t>(F, WS_Q), wsp<bf16_t>(F, WS_K), wsp<bf16_t>(F, WS_V), wsp<bf16_t>(F, WS_AMIX), wsp<float>(F, WS_BTAB), F.g_subln, lam};
        if (!(args.skip & 1)) for (int L = F.vcu; L < NB * 4 * (SEQ / att::QB); L += F.G) { const int bh = L >> 4, qb = L & 15; att::attn_unit(F.lds, T, bh >> 2, bh & 3, qb); }
        if (!(args.skip & 2)) { SchedPlain S{(const char*)wsp<bf16_t>(F, WS_ADFT), (const char*)wsp<bf16_t>(F, WS_BDFT), 16, 16, F.G, cblk, (size_t)256 * 4096 * 2};
          EpiDft E{wsp<bf16_t>(F, WS_AMIX)};
          pg8::gemm_phase<EpiDft, SchedPlain>(F.lds, 4096, S, E); }
    }
    SEAM(3);
    if (IN(4)) {
        SchedPlain S{(const char*)wsp<bf16_t>(F, WS_AMIX), (const char*)wsp<bf16_t>(F, WS_WOUT), NTOK / 256, 4, F.G, cblk, (size_t)256 * 1024 * 2};
        EpiOut E{F.x, wsp<float>(F, WS_MOD), F.out};
        pg8::gemm_phase<EpiOut, SchedPlain>(F.lds, 1024, S, E);
    }
    SEAM(4);
    if (IN(5)) { p5_router(F); }
    SEAM(5);
    if (IN(6)) {
        moe_tables(F);
        const LAS int* tstart = (const LAS int*)(F.lds + SP_TSTART);
        SchedMoe<true> S{(const char*)wsp<bf16_t>(F, WS_XN2), (const char*)wsp<bf16_t>(F, WS_W1), tstart[32], 8, F.G, cblk, 0, (size_t)256 * 1024 * 2, (size_t)2048 * 1024 * 2,
                         F.lds + SP_TILEE, tstart, (const LAS int*)(F.lds + SP_CNT), wsp<unsigned>(F, WS_SLOTTOK)};
        EpiSwiglu E{wsp<bf16_t>(F, WS_ACT), wsp<float>(F, WS_B1P), F.lds + SP_TILEE};
        pg8::gemm_phase<EpiSwiglu, SchedMoe<true>>(F.lds, 1024, S, E);
    }
    SEAM(6);
    if (IN(7)) {
        moe_tables(F);
        const LAS int* tstart = (const LAS int*)(F.lds + SP_TSTART);
        SchedMoe<false> S{(const char*)wsp<bf16_t>(F, WS_ACT), (const char*)wsp<bf16_t>(F, WS_W2), tstart[32], 4, F.G, cblk, (size_t)256 * 1024 * 2, (size_t)256 * 1024 * 2, (size_t)1024 * 1024 * 2,
                          F.lds + SP_TILEE, tstart, (const LAS int*)(F.lds + SP_CNT), wsp<unsigned>(F, WS_SLOTTOK)};
        EpiDown E{wsp<bf16_t>(F, WS_SLAB), F.b2, wsp<float>(F, WS_SLOTGATE), F.lds + SP_TILEE, tstart};
        pg8::gemm_phase<EpiDown, SchedMoe<false>>(F.lds, 1024, S, E);
    }
    SEAM(7);
    if (IN(8)) { moe_tables(F); p8_combine(F); }
#undef IN
#undef SEAM
}

extern "C" void kernel_launch(void* const* d_in, const int* in_sizes, int n_in, void* d_out, int out_size, void* d_ws, size_t ws_size, hipStream_t stream) {
    static int grid = 0;
    if (grid == 0) {
        if (n_in != 23 || in_sizes[0] != NTOK * DM || out_size != NTOK * DM || ws_size < WS_END) {
            fprintf(stderr, "kernel_launch: unexpected shapes: n_in %d in0 %d out %d ws %zu (need >= %zu)\n", n_in, n_in > 0 ? in_sizes[0] : -1, out_size, ws_size, (size_t)WS_END); grid = -1; return; }
        int dev = 0, cus = 0, per_cu = 0;
        if (hipGetDevice(&dev) != hipSuccess || hipDeviceGetAttribute(&cus, hipDeviceAttributeMultiprocessorCount, dev) != hipSuccess) { fprintf(stderr, "kernel_launch: device query failed\n"); grid = -1; return; }
        if (hipFuncSetAttribute((const void*)mk_fwd, hipFuncAttributeMaxDynamicSharedMemorySize, LDS_BYTES) != hipSuccess) { fprintf(stderr, "kernel_launch: hipFuncSetAttribute failed\n"); grid = -1; return; }
        if (hipOccupancyMaxActiveBlocksPerMultiprocessor(&per_cu, (const void*)mk_fwd, NWAVES * 64, LDS_BYTES) != hipSuccess || per_cu < 1) { fprintf(stderr, "kernel_launch: occupancy query says %d blocks per CU\n", per_cu); grid = -1; (void)hipGetLastError(); return; }
        grid = cus;
        if (grid % 8 != 0 || grid < 8) fprintf(stderr, "kernel_launch: note: %d CUs\n", grid);
    }
    if (grid < 0) return;
    if (hipMemsetAsync((char*)d_ws + WS_CTL, 0, CTL_ZERO_BYTES, stream) != hipSuccess) { fprintf(stderr, "kernel_launch: memset failed\n"); return; }
    Args a{};
    for (int i = 0; i < 23; ++i) a.in[i] = (const float*)d_in[i];
    a.out = (float*)d_out; a.ws = (unsigned char*)d_ws;
#if MK_SPLIT
    for (int p = 0; p < NPHASE; ++p) { a.ph_lo = p; a.ph_hi = p + 1; a.skip = 0; hipLaunchKernelGGL(mk_fwd, dim3(grid), dim3(NWAVES * 64), LDS_BYTES, stream, a);
        if (p == MK_PROBE) { a.skip = MK_PROBE_SKIP; hipLaunchKernelGGL(mk_fwd, dim3(grid), dim3(NWAVES * 64), LDS_BYTES, stream, a); } }
#else
    a.ph_lo = 0; a.ph_hi = NPHASE;
    void* kargs[] = {(void*)&a};
    const hipError_t le = hipLaunchCooperativeKernel((const void*)mk_fwd, dim3(grid), dim3(NWAVES * 64), kargs, LDS_BYTES, stream);
    if (le != hipSuccess) fprintf(stderr, "kernel_launch: cooperative launch failed: %s (grid %d)\n", hipGetErrorName(le), grid);
#endif
}
```

```cpp
#include <hip/hip_runtime.h>
#include <cstdio>
#include <cstdint>
#include <cmath>

#define LAS __attribute__((address_space(3)))
#define GAS __attribute__((address_space(1)))
typedef unsigned short bf16_t;
typedef short bf16x8 __attribute__((ext_vector_type(8)));
typedef short s16x4 __attribute__((ext_vector_type(4)));
typedef float f32x4 __attribute__((ext_vector_type(4)));
typedef float f32x2 __attribute__((ext_vector_type(2)));
typedef float f32x16 __attribute__((ext_vector_type(16)));
typedef unsigned u32x4 __attribute__((ext_vector_type(4)));
typedef unsigned u32x2 __attribute__((ext_vector_type(2)));
typedef GAS unsigned gu32;

#ifndef MK_TIMER
#define MK_TIMER -1
#endif
#ifndef MK_PROBE
#define MK_PROBE -1
#endif
#ifndef MK_PROBE_SKIP
#define MK_PROBE_SKIP 0
#endif
#ifndef MK_SPLIT
#define MK_SPLIT 0
#endif

constexpr int NB = 8, SEQ = 4096, DM = 1024, NTOK = NB * SEQ;
constexpr int NEXP = 32, TOPK = 4, DFF = 1024, CAP = NTOK;
constexpr int NQKV = 1536;
constexpr int HSEQ = SEQ / 2;
constexpr float EPS = 1e-6f;
constexpr float LOG2E = 1.4426950408889634f;
constexpr float SWG_C = -1.702f * LOG2E;
constexpr float QSCALE = 0.125f * LOG2E;
constexpr float LAM_INIT = 0.2f;
constexpr int MAXTILES = (NTOK * TOPK) / 256 + NEXP;

constexpr size_t MiB = 1u << 20;
constexpr size_t WS_CTL = 0, CTL_ZERO_BYTES = 1 * MiB;
constexpr size_t WS_MOD = 1 * MiB;
constexpr size_t WS_VR = WS_MOD + 256 * 1024;
constexpr size_t WS_BTAB = WS_MOD + 320 * 1024;
constexpr size_t WS_B1P = WS_MOD + 512 * 1024;
constexpr size_t WS_TOKSLOT = 2 * MiB;
constexpr size_t WS_SLOTTOK = 4 * MiB;
constexpr size_t WS_SLOTGATE = 8 * MiB;
constexpr size_t WS_WQKV = 12 * MiB;
constexpr size_t WS_WCS = 15 * MiB;
constexpr size_t WS_WOUT = 17 * MiB;
constexpr size_t WS_ADFT = 20 * MiB;
constexpr size_t WS_W1 = 52 * MiB;
constexpr size_t WS_W2 = 180 * MiB;
constexpr size_t WS_XN = 256 * MiB;
constexpr size_t WS_XNSA = 320 * MiB;
constexpr size_t WS_Q = 384 * MiB, WS_K = 416 * MiB, WS_V = 448 * MiB;
constexpr size_t WS_BDFT = 480 * MiB;
constexpr size_t WS_AMIX = 512 * MiB;
constexpr size_t WS_ACT = 256 * MiB;
constexpr size_t WS_XN2 = 576 * MiB;
constexpr size_t WS_SLAB = 640 * MiB;
constexpr size_t WS_X1 = 784 * MiB;
constexpr size_t WS_END = 912 * MiB;
static_assert(WS_ACT + (size_t)MAXTILES * 256 * 1024 * 2 <= WS_XN2 && WS_SLAB + (size_t)MAXTILES * 256 * 1024 * 2 <= WS_END, "d_ws map");
constexpr int CW_BAR = 4096;
constexpr int CW_GCNT = 8192;

constexpr int RING_BYTES = 131072;
constexpr int SP_OFF = 147456;
constexpr int SP_MISC = SP_OFF;
constexpr int SP_TSTART = SP_OFF + 256;
constexpr int SP_CNT = SP_OFF + 512;
constexpr int SP_TILEE = SP_OFF + 768;
constexpr int SP_BT = SP_OFF + 2048;
constexpr int SP_WS = SP_OFF + 3072;
constexpr int GROW_OFF = SP_OFF + 6144;
constexpr int LDS_BYTES = 163840;
constexpr int NWAVES = 8;

__device__ __forceinline__ unsigned cvt_pk_bf16(float lo, float hi) { unsigned r; asm volatile("v_cvt_pk_bf16_f32 %0, %1, %2" : "=v"(r) : "v"(lo), "v"(hi)); return r; }
__device__ __forceinline__ unsigned cvt_pk4_fp8(float a, float b, float c, float d) { unsigned w = 0; w = __builtin_amdgcn_cvt_pk_fp8_f32(a, b, w, false); w = __builtin_amdgcn_cvt_pk_fp8_f32(c, d, w, true); return w; }
__device__ __forceinline__ float bf2f(unsigned short h) { return __uint_as_float((unsigned)h << 16); }
__device__ __forceinline__ float wave_sum(float v) {
#pragma unroll
    for (int o = 1; o < 64; o <<= 1) v += __shfl_xor(v, o);
    return v;
}
__device__ __forceinline__ int lane_now() { int l; asm volatile("v_mbcnt_lo_u32_b32 %0, -1, 0\n\tv_mbcnt_hi_u32_b32 %0, -1, %0" : "=v"(l)); return l; }
#define LDS_WAIT() asm volatile("s_waitcnt lgkmcnt(0)" ::: "memory")
#define VM_WAIT() asm volatile("s_waitcnt vmcnt(0)" ::: "memory")
#define RLX_AGENT __ATOMIC_RELAXED, __HIP_MEMORY_SCOPE_AGENT

namespace pg8 {
constexpr int BM = 256, BK = 64, HALF = 128, HTB = HALF * BK * 2, STAGE_BYTES = 8 * HTB, NXCD = 8, WGM = 8;
__host__ __device__ __forceinline__ int lds_byte(int r, int c) { const int st = (r >> 4) * 2 + (c >> 5), rr = r & 15, cc = c & 31, ob = rr * 64 + cc * 2; return st * 1024 + (ob ^ (((ob >> 9) & 1) << 5)); }
__host__ __device__ __forceinline__ void stage_rc(int b, int& R, int& C) { const int st = b / 1024, sb = b % 1024, swz = sb ^ (((sb >> 9) & 1) << 5); R = (st >> 1) * 16 + swz / 64; C = (st & 1) * 32 + (swz % 64) / 2; }
__host__ __device__ __forceinline__ int perm32(int rho) { const int n = rho >> 4, i = rho & 15; return 8 * (i >> 2) + 4 * n + (i & 3); }
struct Unit { int pm, pn; };

__device__ __forceinline__ bool static_unit(int i, int G, int c, int nM, int nN, Unit& u) {
    const int nwg = nM * nN; const long L = (long)i * G + c; if (L >= nwg) return false;
    int wgid = (int)L; { const int q = nwg / NXCD, r = nwg % NXCD, xcd = wgid % NXCD, off = wgid / NXCD; wgid = (xcd < r ? xcd * (q + 1) : r * (q + 1) + (xcd - r) * q) + off; }
    const int nig = WGM * nN, gid = wgid / nig, fm = gid * WGM, gsz = (nM - fm) < WGM ? (nM - fm) : WGM;
    u.pm = fm + ((wgid % nig) % gsz); u.pn = (wgid % nig) / gsz; return true;
}

typedef int i32x8 __attribute__((ext_vector_type(8)));
typedef int i32x4v __attribute__((ext_vector_type(4)));
template <class Epi, class Sched, bool FP8 = false, int SCB = 127>
__device__ __forceinline__ void gemm_phase(LAS unsigned char* lds, const int KB, const Sched& S, const Epi& E, const int wid_in) {
    const int lane = lane_now(), wid = __builtin_amdgcn_readfirstlane(wid_in), tid = wid * 64 + lane, wr = wid >> 2, wc = wid & 3, fr = lane & 15, fq = lane >> 4;
    int nt = KB / 128; asm volatile("" : "+s"(nt));
    unsigned voffA, voffB; int RA0, CA0;
    { int R, C; stage_rc(tid * 16, R, C); const int Rb = Epi::WIDE ? (64 * (R >> 5) + 16 * ((R >> 2) & 3) + 4 * ((R >> 4) & 1) + (R & 3)) : Epi::PERM ? ((R & ~31) + perm32(R & 31)) : R;
      voffA = (unsigned)(R * KB + C * 2); voffB = (unsigned)(Rb * KB + C * 2); RA0 = R; CA0 = C; }
    const unsigned p1off = 64u * (unsigned)KB, p1offB = (Epi::WIDE ? 128u : 64u) * (unsigned)KB;
    const size_t kstep = (size_t)(BK * 2);
    const size_t hstep = (size_t)HALF * KB, hstepB = (size_t)(Epi::WIDE ? 8 : HALF) * KB;
    const unsigned ldsw = (unsigned)wid * 1024u, ldsb = (unsigned)(uintptr_t)lds;
    const int aoff = FP8 ? lds_byte(wr * 64 + fr, 32 * (fq >> 1) + 8 * (fq & 1)) : lds_byte(wr * 64 + fr, fq * 8), boff = FP8 ? lds_byte(wc * 32 + fr, 32 * (fq >> 1) + 8 * (fq & 1)) : lds_byte(wc * 32 + fr, fq * 8);
    const int aoff2 = lds_byte(wr * 64 + fr, 32 * (fq >> 1) + 8 * (fq & 1) + 16), boff2 = lds_byte(wc * 32 + fr, 32 * (fq >> 1) + 8 * (fq & 1) + 16);
    LAS unsigned short* grow = (LAS unsigned short*)(lds + GROW_OFF) + tid * 4;
#define PG8_SA(b, h) (((b) * 2 + (h)) * HTB)
#define PG8_SB(b, h) ((4 + (b) * 2 + (h)) * HTB)
#define PG8_GLDS(sbase, vo, ldsdst) do { unsigned keep_; asm volatile("s_mov_b32 %0, m0\n\ts_mov_b32 m0, %3\n\ts_nop 0\n\tglobal_load_lds_dwordx4 %1, %2\n\ts_mov_b32 m0, %0" \
        : "=&s"(keep_) : "v"(vo), "s"(sbase), "s"(ldsdst) : "memory"); } while (0)
#define PG8_UPTR(p) ((const char*)(((unsigned long long)(unsigned)__builtin_amdgcn_readfirstlane((int)((unsigned long long)(p) >> 32)) << 32) | (unsigned)__builtin_amdgcn_readfirstlane((int)(unsigned long long)(p))))
#define PG8_STAGE_P(bufoff, gbase, voff, p1) do { const char* sb_ = PG8_UPTR(gbase); \
        PG8_GLDS(sb_, (voff), (unsigned)__builtin_amdgcn_readfirstlane((int)(ldsb + (unsigned)(bufoff) + ldsw))); \
        PG8_GLDS(sb_ + (p1), (voff), (unsigned)__builtin_amdgcn_readfirstlane((int)(ldsb + (unsigned)(bufoff) + ldsw + 8192))); } while (0)
#define PG8_STAGE(bufoff, gbase, voff) PG8_STAGE_P(bufoff, gbase, voff, p1offB)
#define PG8_STAGE_A(bufoff, ab, kb, h, set) do { if constexpr (Sched::GATHER) { const char* sb_ = PG8_UPTR((ab) + (kb)); const unsigned rr_ = *(const LAS unsigned*)(grow + (set) * 2048 + 2 * (h)); \
        PG8_GLDS(sb_, (rr_ & 0xffffu) * (unsigned)KB + (unsigned)(CA0 * 2), (unsigned)__builtin_amdgcn_readfirstlane((int)(ldsb + (unsigned)(bufoff) + ldsw))); \
        PG8_GLDS(sb_, (rr_ >> 16) * (unsigned)KB + (unsigned)(CA0 * 2), (unsigned)__builtin_amdgcn_readfirstlane((int)(ldsb + (unsigned)(bufoff) + ldsw + 8192))); } \
        else { PG8_STAGE_P(bufoff, (ab) + (kb) + (h) * hstep, voffA, p1off); } } while (0)
#define PG8_LD8(base, o0, o1) __builtin_shufflevector(*(const LAS i32x4v*)(lds + (base) + (o0)), *(const LAS i32x4v*)(lds + (base) + (o1)), 0, 1, 2, 3, 4, 5, 6, 7)
#define PG8_LDA(dst, b, h) do { if constexpr (FP8) { _Pragma("unroll") for (int m = 0; m < 4; ++m) dst##8[m] = PG8_LD8(PG8_SA(b, h) + m * 2048, aoff, aoff2); } \
        else { _Pragma("unroll") for (int m = 0; m < 4; ++m) _Pragma("unroll") for (int k = 0; k < 2; ++k) dst[m][k] = *(const LAS bf16x8*)(lds + PG8_SA(b, h) + aoff + m * 2048 + k * 1024); } } while (0)
#define PG8_LDB(dst, b, h) do { if constexpr (FP8) { _Pragma("unroll") for (int n = 0; n < 2; ++n) dst##8[n] = PG8_LD8(PG8_SB(b, h) + n * 2048, boff, boff2); } \
        else { _Pragma("unroll") for (int n = 0; n < 2; ++n) _Pragma("unroll") for (int k = 0; k < 2; ++k) dst[n][k] = *(const LAS bf16x8*)(lds + PG8_SB(b, h) + boff + n * 2048 + k * 1024); } } while (0)
#define PG8_MMA(ai, bj, At, Bt) do { __builtin_amdgcn_s_setprio(1); _Pragma("unroll") for (int m = 0; m < 4; ++m) _Pragma("unroll") for (int n = 0; n < 2; ++n) { \
        if constexpr (FP8) asm volatile("v_mfma_scale_f32_16x16x128_f8f6f4 %0, %1, %2, %0, %3, %3 op_sel_hi:[0,0,0]" : "+v"(acc[ai][bj][m][n]) : "v"(Bt##8[n]), "v"(At##8[m]), "v"(scv)); \
        else { _Pragma("unroll") for (int k = 0; k < 2; ++k) acc[ai][bj][m][n] = __builtin_amdgcn_mfma_f32_16x16x32_bf16(Bt[n][k], At[m][k], acc[ai][bj][m][n], 0, 0, 0); } } __builtin_amdgcn_s_setprio(0); } while (0)
#define PG8_WAIT_V(n) asm volatile("s_waitcnt vmcnt(" #n ")" ::: "memory")
#define PG8_WAIT_L(n) asm volatile("s_waitcnt lgkmcnt(" #n ")" ::: "memory")
#define PG8_BAR __builtin_amdgcn_s_barrier()
#define PG8_SCHED __builtin_amdgcn_sched_barrier(0)
    Unit cur, nxt; int ui = 0;
    if (!S.next(0, cur)) return;
    f32x4 acc[2][2][4][2];
    typename Epi::Pre pre, pren; E.prefetch(pre, cur, wr, wc, fr, fq); E.init(acc, pre);
    bf16x8 At[4][2], B0[2][2], B1[2][2]; i32x8 At8[4], B08[2], B18[2];
    const int scv = SCB;
    const char* cA = S.a_ptr(cur); const char* cB = S.b_ptr(cur);
    if constexpr (Sched::GATHER) { int r[4]; S.a_rows(cur, RA0, RA0 + 64, r);
        *(LAS u32x2*)grow = (u32x2){(unsigned)r[0] | ((unsigned)r[1] << 16), (unsigned)r[2] | ((unsigned)r[3] << 16)}; }
    PG8_STAGE(PG8_SB(0, 0), cB, voffB); PG8_STAGE(PG8_SB(0, 1), cB + hstepB, voffB); PG8_STAGE_A(PG8_SA(0, 0), cA, 0, 0, 0); PG8_STAGE_A(PG8_SA(0, 1), cA, 0, 1, 0);
    if (wr == 1) PG8_BAR;
    PG8_WAIT_V(2); PG8_BAR;
    PG8_STAGE(PG8_SB(1, 0), cB + kstep, voffB); PG8_STAGE_A(PG8_SA(1, 0), cA, kstep, 0, 0); PG8_STAGE(PG8_SB(1, 1), cB + hstepB + kstep, voffB);
    PG8_WAIT_V(6); PG8_BAR;
    for (;;) {
        const bool has_next = S.next(ui + 1, nxt);
        const char* nA = has_next ? S.a_ptr(nxt) : cA; const char* nB = has_next ? S.b_ptr(nxt) : cB;
        const int cset = ui & 1, nset = has_next ? (cset ^ 1) : cset;
        if constexpr (Sched::GATHER) { if (has_next) { int r[4]; S.a_rows(nxt, RA0, RA0 + 64, r);
            *(LAS u32x2*)(grow + nset * 2048) = (u32x2){(unsigned)r[0] | ((unsigned)r[1] << 16), (unsigned)r[2] | ((unsigned)r[3] << 16)}; } }
#pragma unroll 1
        for (int t = 0; t < nt; t += 2) {
            const bool last = (t == nt - 2);
            const size_t k1 = (size_t)(t + 1) * kstep;
            const char* a2 = last ? nA : cA; const size_t k2 = last ? 0 : (size_t)(t + 2) * kstep; const char* b2 = last ? nB : cB + (size_t)(t + 2) * kstep;
            const size_t k3 = k2 + kstep; const char* b3 = b2 + kstep;
            PG8_LDB(B0, 0, 0); PG8_LDB(B1, 0, 1); PG8_SCHED; PG8_LDA(At, 0, 0); PG8_STAGE_A(PG8_SA(1, 1), cA, k1, 1, cset);
            PG8_WAIT_V(8); PG8_WAIT_L(0); PG8_BAR; PG8_MMA(0, 0, At, B0); PG8_MMA(0, 1, At, B1); PG8_BAR; PG8_SCHED;
            PG8_LDA(At, 0, 1); PG8_STAGE(PG8_SB(0, 0), b2, voffB); PG8_STAGE(PG8_SB(0, 1), b2 + hstepB, voffB); PG8_STAGE_A(PG8_SA(0, 0), a2, k2, 0, (last ? nset : cset));
            PG8_WAIT_V(8); PG8_WAIT_L(0); PG8_BAR; PG8_MMA(1, 0, At, B0); PG8_MMA(1, 1, At, B1); PG8_BAR; PG8_SCHED;
            PG8_LDB(B0, 1, 0); PG8_LDB(B1, 1, 1); PG8_SCHED; PG8_LDA(At, 1, 0); PG8_STAGE_A(PG8_SA(0, 1), a2, k2, 1, (last ? nset : cset));
            PG8_WAIT_V(8); PG8_WAIT_L(0); PG8_BAR; PG8_MMA(0, 0, At, B0); PG8_MMA(0, 1, At, B1); PG8_BAR; PG8_SCHED;
            PG8_LDA(At, 1, 1); PG8_STAGE(PG8_SB(1, 0), b3, voffB); PG8_STAGE(PG8_SB(1, 1), b3 + hstepB, voffB); PG8_STAGE_A(PG8_SA(1, 0), a2, k3, 0, (last ? nset : cset));
            PG8_WAIT_V(8); PG8_WAIT_L(0); PG8_BAR; PG8_MMA(1, 0, At, B0); PG8_MMA(1, 1, At, B1); PG8_BAR; PG8_SCHED;
        }
        if (wr == 0) PG8_BAR;
        if constexpr (FP8) asm volatile("s_nop 15\n\ts_nop 15" ::: "memory");
        { const int t2_ = lane_now();
          Unit ue_; ue_.pm = __builtin_amdgcn_readfirstlane(cur.pm); ue_.pn = __builtin_amdgcn_readfirstlane(cur.pn);
          if (has_next) { Unit un_; un_.pm = __builtin_amdgcn_readfirstlane(nxt.pm); un_.pn = __builtin_amdgcn_readfirstlane(nxt.pn); E.prefetch(pren, un_, wr, wc, t2_ & 15, (t2_ >> 4) & 3); }
          E(acc, ue_, wr, wc, t2_ & 15, (t2_ >> 4) & 3, pre); }
        if (!has_next) break;
        pre = pren; E.init(acc, pre);
        cur = nxt; cA = nA; cB = nB; ++ui;
        if (wr == 1) PG8_BAR;
    }
    PG8_WAIT_V(0);
    PG8_BAR;
#undef PG8_SA
#undef PG8_SB
#undef PG8_STAGE
#undef PG8_STAGE_P
#undef PG8_GLDS
#undef PG8_UPTR
#undef PG8_STAGE_A
#undef PG8_LDA
#undef PG8_LDB
#undef PG8_MMA
#undef PG8_LD8
#undef PG8_WAIT_V
#undef PG8_WAIT_L
#undef PG8_BAR
#undef PG8_SCHED
}
}

#define XB_TMO      128
#define XB_XCNT(j)  (256  + 64 * (j))
#define XB_XSUB(j)  (1280 + 64 * (j))
#define XB_XGEN(j)  (2304 + 64 * (j))
#define XB_TOP      3328
#define XB_TOPGEN   3392
#define XCD_BAR_WORDS 3456
#define XB_SPIN_CAP (1u << 20)
__device__ __forceinline__ unsigned xb_ld(unsigned* p)              { return __hip_atomic_load(p, __ATOMIC_RELAXED, __HIP_MEMORY_SCOPE_AGENT); }
__device__ __forceinline__ unsigned xb_add(unsigned* p, unsigned v) { return __hip_atomic_fetch_add(p, v, __ATOMIC_RELAXED, __HIP_MEMORY_SCOPE_AGENT); }
__device__ __forceinline__ unsigned xb_xcc_id() { return (unsigned)__builtin_amdgcn_s_getreg((3 << 11) | 20) & 0xFu; }
#define XB_SPIN(cond, bar) do { unsigned _sp = 0; while (cond) { __builtin_amdgcn_s_sleep(1); \
    if ((++_sp & 255u) == 0u) { if (xb_ld(&(bar)[XB_TMO])) break; if (_sp > XB_SPIN_CAP) { atomicAdd(&(bar)[XB_TMO], 1u); break; } } } } while (0)
struct XcdBarrier { unsigned* bar; unsigned x; volatile LAS unsigned* st; };
__device__ __forceinline__ XcdBarrier xcd_barrier_post(unsigned* bar, volatile LAS unsigned* st) {
    XcdBarrier b; b.bar = bar; b.x = xb_xcc_id(); b.st = st;
    if (threadIdx.x == 0) (void)xb_add(&bar[XB_XCNT(b.x)], 1u);
    return b;
}
__device__ __forceinline__ void xcd_barrier_complete(unsigned* bar, unsigned x, unsigned& nloc, unsigned& nx) {
    const unsigned G = gridDim.x * gridDim.y * gridDim.z;
    unsigned sum, cnt, mine, sp = 0u;
    for (;;) {
        sum = 0u; cnt = 0u; mine = 0u;
#pragma unroll
        for (unsigned j = 0; j < 16; ++j) { const unsigned c = xb_ld(&bar[XB_XCNT(j)]); sum += c; cnt += (c > 0u) ? 1u : 0u; mine = (j == x) ? c : mine; }
        if (sum == G) break;
        __builtin_amdgcn_s_sleep(1);
        if ((++sp & 255u) == 0u) { if (xb_ld(&bar[XB_TMO])) break; if (sp > XB_SPIN_CAP) { atomicAdd(&bar[XB_TMO], 1u); break; } }
    }
    nloc = mine > 0u ? mine : 1u; nx = cnt > 0u ? cnt : 1u;
}
__device__ __forceinline__ void xcd_barrier(const XcdBarrier& b) {
    asm volatile("s_waitcnt vmcnt(0)" ::: "memory");
    __syncthreads();
    if (threadIdx.x == 0) {
        unsigned* bar = b.bar;
        __builtin_amdgcn_s_waitcnt(0);
        unsigned nloc = b.st[0], nx = b.st[1];
        if (nloc == 0u) { xcd_barrier_complete(bar, b.x, nloc, nx); b.st[0] = nloc; b.st[1] = nx; }
        const unsigned old = xb_add(&bar[XB_XSUB(b.x)], 1u);
        const unsigned gen = old / nloc;
        if (old + 1u == (gen + 1u) * nloc) {
            __builtin_amdgcn_fence(__ATOMIC_RELEASE, "agent");
            asm volatile("s_waitcnt vmcnt(0)" ::: "memory");
            const unsigned og = xb_add(&bar[XB_TOP], 1u);
            const unsigned tg = og / nx;
            if (og + 1u == (tg + 1u) * nx) xb_add(&bar[XB_TOPGEN], 1u);
            else XB_SPIN(xb_ld(&bar[XB_TOPGEN]) == tg, bar);
            __builtin_amdgcn_fence(__ATOMIC_ACQUIRE, "agent");
            xb_add(&bar[XB_XGEN(b.x)], 1u);
            asm volatile("s_waitcnt vmcnt(0)" ::: "memory");
        } else {
            XB_SPIN(xb_ld(&bar[XB_XGEN(b.x)]) == gen, bar);
            __builtin_amdgcn_fence(__ATOMIC_ACQUIRE, "agent");
            asm volatile("s_waitcnt vmcnt(0)" ::: "memory");
        }
    }
    __syncthreads();
}

struct Frame {
    LAS unsigned char* lds;
    volatile LAS unsigned* MISC;
    unsigned* ctl;
    int wave, vcu, G;
    __device__ __forceinline__ int lane() const { return lane_now(); }
    __device__ __forceinline__ int tid() const { return wave * 64 + lane_now(); }
    const float *x, *c, *w_ada, *b_ada, *g_mix, *w_in, *w_fourier, *q_norm_g, *k_norm_g, *lq1, *lk1, *lq2, *lk2, *g_subln, *w_out, *rel_bias,
                *g_ffn, *w_router, *b_router, *w1, *b1, *w2, *b2;
    float* out;
    unsigned char* ws;
};
template <class T> __device__ __forceinline__ T* wsp(const Frame& F, size_t off) { return (T*)(F.ws + off); }

struct SchedPlain {
    static constexpr bool GATHER = false;
    const char* A; const char* Bt; int nM, nN, G, c; size_t tstep;
    __device__ __forceinline__ bool next(int i, pg8::Unit& u) const { return pg8::static_unit(i, G, c, nM, nN, u); }
    __device__ __forceinline__ const char* a_ptr(const pg8::Unit& u) const { return A + (size_t)u.pm * tstep; }
    __device__ __forceinline__ const char* b_ptr(const pg8::Unit& u) const { return Bt + (size_t)u.pn * tstep; }
    __device__ __forceinline__ void a_rows(const pg8::Unit&, int, int, int (&r)[4]) const { r[0] = r[1] = r[2] = r[3] = 0; }
};
struct SchedFourier {
    static constexpr bool GATHER = false;
    const char* A; const char* Bt; int G, c; size_t tstep;
    __device__ __forceinline__ bool next(int i, pg8::Unit& u) const {
        const int L = i * G + c; if (L >= 256) return false;
        const int w = (L % 8) * 32 + L / 8;
        const int half = w >> 7, r = w & 127; u.pm = 2 * half + (r & 1); u.pn = 64 * half + (r >> 1); return true; }
    __device__ __forceinline__ const char* a_ptr(const pg8::Unit& u) const { return A + (size_t)u.pm * tstep; }
    __device__ __forceinline__ const char* b_ptr(const pg8::Unit& u) const { return Bt + (size_t)u.pn * tstep; }
    __device__ __forceinline__ void a_rows(const pg8::Unit&, int, int, int (&r)[4]) const { r[0] = r[1] = r[2] = r[3] = 0; }
};
template <bool GATHER_> struct SchedMoe {
    static constexpr bool GATHER = GATHER_;
    const char* A; const char* Bt; int nM, nN, G, c; size_t a_tstep, b_tstep, e_stride;
    const LAS unsigned char* tile_e; const LAS int* tstart; const LAS int* cnt; const unsigned* slot_tok;
    __device__ __forceinline__ bool next(int i, pg8::Unit& u) const { return pg8::static_unit(i, G, c, nM, nN, u); }
    __device__ __forceinline__ const char* a_ptr(const pg8::Unit& u) const { return GATHER_ ? A : A + (size_t)u.pm * a_tstep; }
    __device__ __forceinline__ const char* b_ptr(const pg8::Unit& u) const { const int e = __builtin_amdgcn_readfirstlane((int)tile_e[u.pm]); return Bt + (size_t)e * e_stride + (size_t)u.pn * b_tstep; }
    __device__ __forceinline__ void a_rows(const pg8::Unit& u, int R0, int R1, int (&r)[4]) const {
        const int e = __builtin_amdgcn_readfirstlane((int)tile_e[u.pm]); const int s0 = __builtin_amdgcn_readfirstlane((u.pm - tstart[e]) * 256), n = __builtin_amdgcn_readfirstlane(cnt[e]);
#pragma unroll
        for (int h = 0; h < 2; ++h)
#pragma unroll
            for (int i = 0; i < 2; ++i) { const int s = s0 + h * 128 + (i ? R1 : R0); r[2 * h + i] = (s < n) ? (int)slot_tok[(size_t)e * CAP + s] : 0; }
    }
};

typedef const f32x4 (&AccRef)[2][2][4][2];
__device__ __forceinline__ u32x4 pack8(f32x4 a, f32x4 b) { u32x4 w; w.x = cvt_pk_bf16(a[0], a[1]); w.y = cvt_pk_bf16(a[2], a[3]); w.z = cvt_pk_bf16(b[0], b[1]); w.w = cvt_pk_bf16(b[2], b[3]); return w; }

struct EpiQKV {
    static constexpr bool PERM = true, WIDE = true;
    bf16_t *Q, *Kb, *V; const float *gq, *gk;
    struct Pre {};
    __device__ __forceinline__ void prefetch(Pre&, const pg8::Unit&, int, int, int, int) const {}
    __device__ __forceinline__ void init(f32x4 (&acc)[2][2][4][2], const Pre&) const {
#pragma unroll
        for (int a = 0; a < 2; ++a)
#pragma unroll
            for (int b = 0; b < 2; ++b)
#pragma unroll
                for (int m = 0; m < 4; ++m)
#pragma unroll
                    for (int n = 0; n < 2; ++n) acc[a][b][m][n] = (f32x4){0.f, 0.f, 0.f, 0.f}; }
    __device__ __forceinline__ void operator()(AccRef acc, const pg8::Unit& u, int wr, int wc, int fr, int fq, const Pre& PR) const {
        const int sec = u.pn >> 1, row0 = u.pm * 256 + wr * 64 + fr;
        if (sec < 2) {
            bf16_t* O = sec == 0 ? Q : Kb; const float* g = sec == 0 ? gq : gk; const float sc = sec == 0 ? 8.0f * QSCALE : 1.0f;
            f32x4 gl[2][2];
#pragma unroll
            for (int bj = 0; bj < 2; ++bj)
#pragma unroll
                for (int n = 0; n < 2; ++n) gl[bj][n] = *(const f32x4*)(g + 16 * fq + 8 * bj + 4 * n);
#pragma unroll
            for (int ai = 0; ai < 2; ++ai)
#pragma unroll
                for (int m = 0; m < 4; ++m) {
                    float ss = 0.f;
#pragma unroll
                    for (int bj = 0; bj < 2; ++bj)
#pragma unroll
                        for (int n = 0; n < 2; ++n) { const f32x4 v = acc[ai][bj][m][n]; ss += (v[0] * v[0] + v[1] * v[1]) + (v[2] * v[2] + v[3] * v[3]); }
                    ss += __shfl_xor(ss, 16); ss += __shfl_xor(ss, 32);
                    const float rr = rsqrtf(ss * (1.0f / 64.0f) + EPS) * sc;
                    u32x4 w;
#pragma unroll
                    for (int bj = 0; bj < 2; ++bj) { const f32x4 v0 = acc[ai][bj][m][0] * rr * gl[bj][0], v1 = acc[ai][bj][m][1] * rr * gl[bj][1]; w[2 * bj] = cvt_pk4_fp8(v0[0], v0[1], v0[2], v0[3]); w[2 * bj + 1] = cvt_pk4_fp8(v1[0], v1[1], v1[2], v1[3]); }
                    *(u32x4*)((unsigned char*)O + (size_t)(row0 + ai * 128 + m * 16) * 512 + (u.pn & 1) * 256 + 64 * wc + 16 * fq) = w;
                }
        } else {
#pragma unroll
            for (int ai = 0; ai < 2; ++ai)
#pragma unroll
                for (int m = 0; m < 4; ++m) { bf16_t* rowp = V + (size_t)(row0 + ai * 128 + m * 16) * 512 + (u.pn & 1) * 256 + 64 * wc + 16 * fq;
#pragma unroll
                    for (int bj = 0; bj < 2; ++bj) *(u32x4*)(rowp + 8 * bj) = pack8(acc[ai][bj][m][0], acc[ai][bj][m][1]); }
        }
    }
};
struct EpiFourier {
    static constexpr bool PERM = true, WIDE = true;
    bf16_t* Bdft; const float* vr;
    struct Pre {};
    __device__ __forceinline__ void prefetch(Pre&, const pg8::Unit&, int, int, int, int) const {}
    __device__ __forceinline__ void init(f32x4 (&acc)[2][2][4][2], const Pre&) const {
#pragma unroll
        for (int a = 0; a < 2; ++a)
#pragma unroll
            for (int b = 0; b < 2; ++b)
#pragma unroll
                for (int m = 0; m < 4; ++m)
#pragma unroll
                    for (int n = 0; n < 2; ++n) acc[a][b][m][n] = (f32x4){0.f, 0.f, 0.f, 0.f}; }
    __device__ __forceinline__ void operator()(AccRef acc, const pg8::Unit& u, int wr, int wc, int fr, int fq, const Pre& PR) const {
        const int half = u.pm >> 1, pnl = u.pn - 64 * half, b = pnl >> 3, j0 = (pnl & 7) * 256;
        const int n0 = (u.pm & 1) * 256 + wr * 64 + fr;
        const bool patch = (half == 1) && (j0 == 0) && (wc == 0) && (fq == 0);
#pragma unroll
        for (int ai = 0; ai < 2; ++ai)
#pragma unroll
            for (int m = 0; m < 4; ++m) { const int n = n0 + ai * 128 + m * 16; u32x4 w;
#pragma unroll
                for (int bj = 0; bj < 2; ++bj) { f32x4 v0 = acc[ai][bj][m][0]; if (patch && bj == 0) v0[0] = vr[b * 512 + n];
                    const f32x4 v1 = acc[ai][bj][m][1]; w[2 * bj] = cvt_pk4_fp8(v0[0], v0[1], v0[2], v0[3]); w[2 * bj + 1] = cvt_pk4_fp8(v1[0], v1[1], v1[2], v1[3]); }
                *(u32x4*)((unsigned char*)Bdft + (size_t)(b * 512 + n) * 4096 + half * 2048 + j0 + 64 * wc + 16 * fq) = w; }
    }
};
struct EpiDft {
    static constexpr bool PERM = true, WIDE = true;
    bf16_t* Amix;
    struct Pre {};
    __device__ __forceinline__ void prefetch(Pre&, const pg8::Unit&, int, int, int, int) const {}
    __device__ __forceinline__ void init(f32x4 (&acc)[2][2][4][2], const Pre&) const {
#pragma unroll
        for (int a = 0; a < 2; ++a)
#pragma unroll
            for (int b = 0; b < 2; ++b)
#pragma unroll
                for (int m = 0; m < 4; ++m)
#pragma unroll
                    for (int n = 0; n < 2; ++n) acc[a][b][m][n] = (f32x4){0.f, 0.f, 0.f, 0.f}; }
    __device__ __forceinline__ void operator()(AccRef acc, const pg8::Unit& u, int wr, int wc, int fr, int fq, const Pre& PR) const {
        const int b = u.pn >> 1, col0 = (u.pn & 1) * 256 + 64 * wc + 16 * fq, k0 = u.pm * 256 + wr * 64 + fr;
#pragma unroll
        for (int ai = 0; ai < 2; ++ai)
#pragma unroll
            for (int m = 0; m < 4; ++m) { bf16_t* rowp = Amix + (size_t)(b * 4096 + k0 + ai * 128 + m * 16) * 1024 + col0;
#pragma unroll
                for (int bj = 0; bj < 2; ++bj) *(u32x4*)(rowp + 8 * bj) = pack8(acc[ai][bj][m][0], acc[ai][bj][m][1]); }
    }
};
struct EpiOut {
    static constexpr bool PERM = true, WIDE = true;
    const float* x; const float* mod; bf16_t* x1;
    struct Pre {};
    __device__ __forceinline__ void prefetch(Pre&, const pg8::Unit&, int, int, int, int) const {}
    __device__ __forceinline__ void init(f32x4 (&acc)[2][2][4][2], const Pre&) const {
#pragma unroll
        for (int a = 0; a < 2; ++a)
#pragma unroll
            for (int b = 0; b < 2; ++b)
#pragma unroll
                for (int m = 0; m < 4; ++m)
#pragma unroll
                    for (int n = 0; n < 2; ++n) acc[a][b][m][n] = (f32x4){0.f, 0.f, 0.f, 0.f}; }
    __device__ __forceinline__ void operator()(AccRef acc, const pg8::Unit& u, int wr, int wc, int fr, int fq, const Pre& PR) const {
        const int row0 = u.pm * 256 + wr * 64 + fr, col0 = u.pn * 256 + wc * 64 + 16 * fq, b = (u.pm * 256) >> 12;
        f32x4 gt[2][2];
#pragma unroll
        for (int bj = 0; bj < 2; ++bj)
#pragma unroll
            for (int n = 0; n < 2; ++n) gt[bj][n] = *(const f32x4*)(mod + b * 6144 + 2048 + col0 + bj * 8 + n * 4);
#pragma unroll
        for (int ai = 0; ai < 2; ++ai) {
            f32x4 xs[4][2][2];
#pragma unroll
            for (int m = 0; m < 4; ++m) { const size_t off = (size_t)(row0 + ai * 128 + m * 16) * 1024 + col0;
#pragma unroll
                for (int bj = 0; bj < 2; ++bj) { xs[m][bj][0] = *(const f32x4*)(x + off + bj * 8); xs[m][bj][1] = *(const f32x4*)(x + off + bj * 8 + 4); } }
#pragma unroll
            for (int m = 0; m < 4; ++m) { const size_t off = (size_t)(row0 + ai * 128 + m * 16) * 1024 + col0;
#pragma unroll
                for (int bj = 0; bj < 2; ++bj) *(u32x4*)(x1 + off + bj * 8) = pack8(xs[m][bj][0] + gt[bj][0] * acc[ai][bj][m][0], xs[m][bj][1] + gt[bj][1] * acc[ai][bj][m][1]); } }
    }
};
struct EpiSwiglu {
    static constexpr bool PERM = true, WIDE = false;
    bf16_t* act; const float* b1p; const LAS unsigned char* tile_e;
    struct Pre { f32x4 bg[2], bl[2]; };
    __device__ __forceinline__ void prefetch(Pre& P, const pg8::Unit& u, int wr, int wc, int fr, int fq) const {
        const int e = __builtin_amdgcn_readfirstlane((int)tile_e[u.pm]); const float* bp = b1p + e * 2048 + u.pn * 256 + 32 * wc + 8 * fq;
#pragma unroll
        for (int n = 0; n < 2; ++n) { P.bg[n] = *(const f32x4*)(bp + 4 * n); P.bl[n] = *(const f32x4*)(bp + 128 + 4 * n); }
    }
    __device__ __forceinline__ void init(f32x4 (&acc)[2][2][4][2], const Pre& P) const {
#pragma unroll
        for (int a = 0; a < 2; ++a)
#pragma unroll
            for (int m = 0; m < 4; ++m)
#pragma unroll
                for (int n = 0; n < 2; ++n) { acc[a][0][m][n] = P.bg[n]; acc[a][1][m][n] = P.bl[n]; } }
    __device__ __forceinline__ void operator()(AccRef acc, const pg8::Unit& u, int wr, int wc, int fr, int fq, const Pre& PR) const {
        const int row0 = u.pm * 256 + wr * 64 + fr, pc = 32 * wc + 8 * fq;
#pragma unroll
        for (int ai = 0; ai < 2; ++ai)
#pragma unroll
            for (int m = 0; m < 4; ++m) { f32x4 o[2];
#pragma unroll
                for (int n = 0; n < 2; ++n) { const f32x4 g = acc[ai][0][m][n], l = acc[ai][1][m][n];
#pragma unroll
                    for (int i = 0; i < 4; ++i) { const float gg = fmaxf(g[i], 7.0f * SWG_C), ll = __builtin_amdgcn_fmed3f(l[i], -6.0f / SWG_C, 8.0f / SWG_C);
                        o[n][i] = gg * ll * __builtin_amdgcn_rcpf(1.0f + __builtin_amdgcn_exp2f(gg)); } }
                u32x2 w8; w8.x = cvt_pk4_fp8(o[0][0], o[0][1], o[0][2], o[0][3]); w8.y = cvt_pk4_fp8(o[1][0], o[1][1], o[1][2], o[1][3]);
                *(u32x2*)((unsigned char*)act + (size_t)(row0 + ai * 128 + m * 16) * 1024 + u.pn * 128 + pc) = w8; }
    }
};
struct EpiDown {
    static constexpr bool PERM = true, WIDE = true;
    bf16_t* slab; const float* b2; const float* slot_gate; const LAS unsigned char* tile_e; const LAS int* tstart;
    struct Pre { f32x4 bv[2][2]; float g[2][4]; };
    __device__ __forceinline__ void prefetch(Pre& P, const pg8::Unit& u, int wr, int wc, int fr, int fq) const {
        const int e = __builtin_amdgcn_readfirstlane((int)tile_e[u.pm]); const int col0 = u.pn * 256 + 64 * wc + 16 * fq;
        { const float* gp = slot_gate + (size_t)e * CAP + __builtin_amdgcn_readfirstlane((u.pm - tstart[e]) * 256) + wr * 64 + fr;
#pragma unroll
          for (int ai = 0; ai < 2; ++ai)
#pragma unroll
              for (int m = 0; m < 4; ++m) P.g[ai][m] = gp[ai * 128 + m * 16]; }
#pragma unroll
        for (int bj = 0; bj < 2; ++bj)
#pragma unroll
            for (int n = 0; n < 2; ++n) P.bv[bj][n] = *(const f32x4*)(b2 + e * 1024 + col0 + 8 * bj + 4 * n);
    }
    __device__ __forceinline__ void init(f32x4 (&acc)[2][2][4][2], const Pre& P) const {
#pragma unroll
        for (int a = 0; a < 2; ++a)
#pragma unroll
            for (int b = 0; b < 2; ++b)
#pragma unroll
                for (int m = 0; m < 4; ++m)
#pragma unroll
                    for (int n = 0; n < 2; ++n) acc[a][b][m][n] = P.bv[b][n]; }
    __device__ __forceinline__ void operator()(AccRef acc, const pg8::Unit& u, int wr, int wc, int fr, int fq, const Pre& PR) const {
        const int e = __builtin_amdgcn_readfirstlane((int)tile_e[u.pm]); const int rl = wr * 64 + fr, col0 = u.pn * 256 + 64 * wc + 16 * fq;
        const float* gp = slot_gate + (size_t)e * CAP + __builtin_amdgcn_readfirstlane((u.pm - tstart[e]) * 256) + rl;
#pragma unroll
        for (int ai = 0; ai < 2; ++ai)
#pragma unroll
            for (int m = 0; m < 4; ++m) { const float gate = PR.g[ai][m] * 16.0f;
                u32x4 w;
#pragma unroll
                for (int bj = 0; bj < 2; ++bj) { const f32x4 v0 = acc[ai][bj][m][0] * gate, v1 = acc[ai][bj][m][1] * gate;
                    w[2 * bj] = cvt_pk4_fp8(v0[0], v0[1], v0[2], v0[3]); w[2 * bj + 1] = cvt_pk4_fp8(v1[0], v1[1], v1[2], v1[3]); }
                *(u32x4*)((unsigned char*)slab + (size_t)(u.pm * 256 + rl + ai * 128 + m * 16) * 1024 + col0) = w; }
    }
};

namespace att {
constexpr int QB = 256, KVB = 64, NT = SEQ / KVB;
constexpr int L_K = 0, L_V = 32768, L_Q = 65536;
#define SBAR() __builtin_amdgcn_sched_barrier(0)
__device__ __forceinline__ int crow(int r, int hi) { return (r & 3) + 8 * (r >> 2) + 4 * hi; }
__device__ __forceinline__ int swap23(int k) { return (k & ~0xC) | ((k & 4) << 1) | ((k & 8) >> 1); }
__device__ __forceinline__ int v_rd_base(int lane) { return ((lane & 3) << 3) | (((lane >> 2) & 3) << 6) | (((lane >> 4) & 1) << 5) | (((lane >> 5) & 1) << 8); }
constexpr int v_rd_off(int d0, int ks, int half) { return d0 * 512 + ks * 4096 + half * 2048; }
typedef short v4i16_t __attribute__((ext_vector_type(4)));
template <int OFF> __device__ __forceinline__ s16x4 tr_read(int vb) { return __builtin_bit_cast(s16x4, __builtin_amdgcn_ds_read_tr16_b64_v4i16((LAS v4i16_t*)(uintptr_t)(unsigned)(vb + OFF))); }
#define PKV(L, H) (bf16x8){L[0], L[1], L[2], L[3], H[0], H[1], H[2], H[3]}
typedef __bf16 bf16x2_t __attribute__((ext_vector_type(2)));
__device__ __forceinline__ unsigned cvt_pk_s(float lo, float hi) { f32x2 v = {lo, hi}; bf16x2_t b = __builtin_convertvector(v, bf16x2_t); return __builtin_bit_cast(unsigned, b); }
#define ATT_MFMA(o, a, b) asm volatile("s_nop 1\n\tv_mfma_f32_32x32x16_bf16 %0, %1, %2, %0" : "+v"(o) : "v"(a), "v"(b))
template <int D0, int KB> __device__ __forceinline__ void pv_blk2(f32x16& oA, f32x16& oB, int vb, const bf16x8 (&pa)[2]) {
    const s16x4 l0 = tr_read<v_rd_off(D0, 2 * KB, 0)>(vb), h0 = tr_read<v_rd_off(D0, 2 * KB, 1)>(vb), l1 = tr_read<v_rd_off(D0, 2 * KB + 1, 0)>(vb), h1 = tr_read<v_rd_off(D0, 2 * KB + 1, 1)>(vb);
    const s16x4 m0 = tr_read<v_rd_off(D0 + 1, 2 * KB, 0)>(vb), n0 = tr_read<v_rd_off(D0 + 1, 2 * KB, 1)>(vb), m1 = tr_read<v_rd_off(D0 + 1, 2 * KB + 1, 0)>(vb), n1 = tr_read<v_rd_off(D0 + 1, 2 * KB + 1, 1)>(vb);
    const bf16x8 va0 = PKV(l0, h0), vb0_ = PKV(m0, n0), va1 = PKV(l1, h1), vb1_ = PKV(m1, n1);
    ATT_MFMA(oA, pa[0], va0); ATT_MFMA(oB, pa[0], vb0_); ATT_MFMA(oA, pa[1], va1); ATT_MFMA(oB, pa[1], vb1_);
}
__device__ __forceinline__ void qkt2(f32x16& p0, f32x16& p1, const LAS unsigned char* kb, const LAS unsigned char* qb, const int (&co)[4], int off) {
    p0 = f32x16{}; p1 = f32x16{};
#pragma unroll
    for (int d0 = 0; d0 < 4; ++d0) { const bf16x8 k0 = *(const LAS bf16x8*)(kb + co[d0] + off), qf = *(const LAS bf16x8*)(qb + co[d0]);
        p0 = __builtin_amdgcn_mfma_f32_32x32x16_bf16(k0, qf, p0, 0, 0, 0); }
#pragma unroll
    for (int d0 = 0; d0 < 4; ++d0) { const bf16x8 k1 = *(const LAS bf16x8*)(kb + co[d0] + off + 128), qf = *(const LAS bf16x8*)(qb + co[d0] + 128);
        p1 = __builtin_amdgcn_mfma_f32_32x32x16_bf16(k1, qf, p1, 0, 0, 0); }
}
__device__ __forceinline__ void add_bias(f32x16& p, const LAS float* bt, int relb, int hi) {
#pragma unroll
    for (int r = 0; r < 16; ++r) { const int i0 = relb + crow(r, hi); p[r] += bt[i0 < 0 ? 0 : (i0 > 254 ? 254 : i0)]; }
}
template <int Q> __device__ __forceinline__ float sm_part(const f32x16& p, bf16x8& out) {
    float e[8];
#pragma unroll
    for (int j = 0; j < 8; ++j) e[j] = __builtin_amdgcn_exp2f(p[8 * Q + j]);
    const float ps = ((e[0] + e[1]) + (e[2] + e[3])) + ((e[4] + e[5]) + (e[6] + e[7]));
    u32x4 w = {cvt_pk_s(e[0], e[1]), cvt_pk_s(e[2], e[3]), cvt_pk_s(e[4], e[5]), cvt_pk_s(e[6], e[7])};
    out = __builtin_bit_cast(bf16x8, w); return ps;
}
template <int KB> __device__ __forceinline__ void half_tile(f32x16 (&o1)[4], f32x16 (&o2)[4], float& l1, float& l2, const LAS unsigned char* kbuf, const LAS unsigned char* qbase, const int (&co)[4],
                                                            int vb, bool band, const LAS float* bt, int relb, int hi) {
    f32x16 p0, p1; bf16x8 pa[2], pb[2];
    qkt2(p0, p1, kbuf, qbase, co, KB * 8192);
    if (band) { add_bias(p0, bt, relb + 32 * KB, hi); add_bias(p1, bt, relb + 32 * KB, hi); }
    l1 += sm_part<0>(p0, pa[0]); l1 += sm_part<1>(p0, pa[1]);
    unsigned w[8]; float ls = 0.f;
#define SM_GAP(k) do { float a_ = p1[2 * (k)], b_ = p1[2 * (k) + 1]; asm volatile("" : "+v"(a_), "+v"(b_)); a_ = __builtin_amdgcn_exp2f(a_); b_ = __builtin_amdgcn_exp2f(b_); ls += a_ + b_; w[k] = cvt_pk_s(a_, b_); } while (0)
    { const s16x4 l0 = tr_read<v_rd_off(0, 2 * KB, 0)>(vb), h0 = tr_read<v_rd_off(0, 2 * KB, 1)>(vb), l1_ = tr_read<v_rd_off(0, 2 * KB + 1, 0)>(vb), h1 = tr_read<v_rd_off(0, 2 * KB + 1, 1)>(vb);
      const s16x4 m0 = tr_read<v_rd_off(1, 2 * KB, 0)>(vb), n0 = tr_read<v_rd_off(1, 2 * KB, 1)>(vb), m1 = tr_read<v_rd_off(1, 2 * KB + 1, 0)>(vb), n1 = tr_read<v_rd_off(1, 2 * KB + 1, 1)>(vb);
      const bf16x8 va0 = PKV(l0, h0), vb0_ = PKV(m0, n0), va1 = PKV(l1_, h1), vb1_ = PKV(m1, n1);
      ATT_MFMA(o1[0], pa[0], va0); SM_GAP(0); ATT_MFMA(o1[1], pa[0], vb0_); SM_GAP(1); ATT_MFMA(o1[0], pa[1], va1); SM_GAP(2); ATT_MFMA(o1[1], pa[1], vb1_); SM_GAP(3); }
    { const s16x4 l0 = tr_read<v_rd_off(2, 2 * KB, 0)>(vb), h0 = tr_read<v_rd_off(2, 2 * KB, 1)>(vb), l1_ = tr_read<v_rd_off(2, 2 * KB + 1, 0)>(vb), h1 = tr_read<v_rd_off(2, 2 * KB + 1, 1)>(vb);
      const s16x4 m0 = tr_read<v_rd_off(3, 2 * KB, 0)>(vb), n0 = tr_read<v_rd_off(3, 2 * KB, 1)>(vb), m1 = tr_read<v_rd_off(3, 2 * KB + 1, 0)>(vb), n1 = tr_read<v_rd_off(3, 2 * KB + 1, 1)>(vb);
      const bf16x8 va0 = PKV(l0, h0), vb0_ = PKV(m0, n0), va1 = PKV(l1_, h1), vb1_ = PKV(m1, n1);
      ATT_MFMA(o1[2], pa[0], va0); SM_GAP(4); ATT_MFMA(o1[3], pa[0], vb0_); SM_GAP(5); ATT_MFMA(o1[2], pa[1], va1); SM_GAP(6); ATT_MFMA(o1[3], pa[1], vb1_); SM_GAP(7); }
#undef SM_GAP
    l2 += ls;
    { u32x4 w0 = {w[0], w[1], w[2], w[3]}, w1 = {w[4], w[5], w[6], w[7]}; pb[0] = __builtin_bit_cast(bf16x8, w0); pb[1] = __builtin_bit_cast(bf16x8, w1); }
    pv_blk2<0, KB>(o2[0], o2[1], vb, pb); pv_blk2<2, KB>(o2[2], o2[3], vb, pb);
}

struct Tensors { const bf16_t *Q, *K, *V; bf16_t* Amix; const float* btab; const float* gsub; float lam; const float *w1, *w2; unsigned char *w1t, *w2t; int gw0; };

__device__ __forceinline__ void attn_unit(LAS unsigned char* lds, const Tensors& T, int b, int h, int qb) {
    int tid_ = threadIdx.x; asm volatile("" : "+v"(tid_));
    const int tid = tid_, lane = tid & 63, r32 = lane & 31, hi = lane >> 5; const int wid = __builtin_amdgcn_readfirstlane(tid >> 6);
    const size_t rowbase = (size_t)b * SEQ; const int q0 = qb * QB;
    const bf16_t* Kh = T.K + rowbase * 512 + h * 128; const bf16_t* Vh = T.V + rowbase * 512 + h * 128; const bf16_t* Qh = T.Q + (rowbase + q0) * 512 + h * 128;
    LAS float* bt = (LAS float*)(lds + SP_BT); LAS float* wsf = (LAS float*)(lds + SP_WS) + wid * 64;
    unsigned ksrc[2], vsrc[2];
#pragma unroll
    for (int i = 0; i < 2; ++i) { const int p = wid * 2 + i; const int row = 4 * p + (lane >> 4), ch = (lane & 15) ^ (row & 7); ksrc[i] = (unsigned)(row * 512 + ch * 8) * 2u;
        const int st = 2 * p + (lane >> 5), kk = (st >> 2) * 8 + ((lane & 31) >> 2), cc = (st & 3) * 32 + (lane & 3) * 8; vsrc[i] = (unsigned)(kk * 512 + cc) * 2u; }
    const unsigned ldsw = (unsigned)wid * 2048u;
#define DMA_TILE(t, buf) do { const char* kg = (const char*)(Kh + (size_t)(t) * KVB * 512); const char* vg = (const char*)(Vh + (size_t)(t) * KVB * 512); \
    _Pragma("unroll") for (int _i = 0; _i < 2; ++_i) { \
        __builtin_amdgcn_global_load_lds((const unsigned*)(kg + ksrc[_i]), (LAS unsigned*)(lds + L_K + (buf) * 16384 + ldsw + _i * 1024), 16, 0, 0); \
        __builtin_amdgcn_global_load_lds((const unsigned*)(vg + vsrc[_i]), (LAS unsigned*)(lds + L_V + (buf) * 16384 + ldsw + _i * 1024), 16, 0, 0); } } while (0)
    { int lq = lane; asm volatile("" : "+v"(lq));
      const int rq = lq >> 4; const unsigned qo0 = (unsigned)((32 * wid + rq) * 512 + (((lq & 15) ^ (rq & 7)) << 3)) * 2u, qo1 = (unsigned)((32 * wid + 4 + rq) * 512 + (((lq & 15) ^ ((4 + rq) & 7)) << 3)) * 2u;
#pragma unroll
      for (int i = 0; i < 8; ++i) { const int p = wid * 8 + i;
        __builtin_amdgcn_global_load_lds((const unsigned*)((const char*)Qh + ((i & 1) ? qo1 : qo0) + (size_t)(i >> 1) * 8192), (LAS unsigned*)(lds + L_Q + p * 1024), 16, 0, 0); } }
    DMA_TILE(0, 0);
    if (tid < 255) bt[tid] = T.btab[h * 256 + tid];
    int co[4];
#pragma unroll
    for (int d0 = 0; d0 < 4; ++d0) co[d0] = r32 * 256 + (((2 * d0 + hi) ^ (r32 & 7)) << 4);
    const LAS unsigned char* qbase = lds + L_Q + wid * 8192;
    const int vb0 = (int)(uintptr_t)(lds + L_V) + v_rd_base(lane);
    f32x16 o1[4], o2[4];
#pragma unroll
    for (int d = 0; d < 4; ++d) { o1[d] = f32x16{}; o2[d] = f32x16{}; }
    float l1 = 0.f, l2 = 0.f;
    const int qw = q0 + wid * 32;
    int state = (qw >= 154) ? 0 : 1;
    __syncthreads();
    for (int t = 0; t < NT; ++t) {
        const int buf = t & 1;
        if (t + 1 < NT) DMA_TILE(t + 1, buf ^ 1);
        const int k0 = t * KVB;
        const bool isneg = (k0 <= qw - 154), ispos = (k0 >= qw + 122);
        if (state == 0 && !isneg) { const float f = __builtin_amdgcn_exp2f(bt[0]); state = 1;
#pragma unroll
            for (int d = 0; d < 4; ++d) { o1[d] *= f; o2[d] *= f; }
            l1 *= f; l2 *= f; }
        if (state == 1 && ispos) { const float f = __builtin_amdgcn_exp2f(-bt[254]); state = 2;
#pragma unroll
            for (int d = 0; d < 4; ++d) { o1[d] *= f; o2[d] *= f; }
            l1 *= f; l2 *= f; }
        const LAS unsigned char* kbuf = lds + L_K + buf * 16384;
        const int vb = vb0 + buf * 16384; const int relb = k0 - (qw + r32) + 127;
        half_tile<0>(o1, o2, l1, l2, kbuf, qbase, co, vb, state == 1, bt, relb, hi);
        half_tile<1>(o1, o2, l1, l2, kbuf, qbase, co, vb, state == 1, bt, relb, hi);
        __syncthreads();
    }
#undef DMA_TILE
    l1 += __shfl_xor(l1, 32); l2 += __shfl_xor(l2, 32);
    if (hi == 0) { wsf[r32] = 1.0f / l1; wsf[32 + r32] = T.lam / l2; }
    LDS_WAIT();
    float gs[4];
#pragma unroll
    for (int d = 0; d < 4; ++d) gs[d] = T.gsub[32 * d + r32] * (1.0f - LAM_INIT);
    bf16_t* Ow = T.Amix + (rowbase + q0 + wid * 32 + 4 * hi) * 1024 + 512 + h * 128 + r32; asm volatile("" : "+v"(Ow));
#pragma unroll
    for (int r = 0; r < 16; ++r) { const int row = crow(r, hi); const float c1 = wsf[row], c2 = wsf[32 + row];
        float y[4], ss = 0.f;
#pragma unroll
        for (int d = 0; d < 4; ++d) { y[d] = o1[d][r] * c1 - o2[d][r] * c2; ss += y[d] * y[d]; }
        ss += __shfl_xor(ss, 1); ss += __shfl_xor(ss, 2); ss += __shfl_xor(ss, 4); ss += __shfl_xor(ss, 8); ss += __shfl_xor(ss, 16);
        const float rr = rsqrtf(ss * (1.0f / 128.0f) + EPS);
#pragma unroll
        for (int d = 0; d < 4; ++d) Ow[(size_t)((r & 3) + 8 * (r >> 2)) * 1024 + 32 * d] = (bf16_t)(cvt_pk_bf16(y[d] * rr * gs[d], 0.f) & 0xffffu); }
    __syncthreads();
}

constexpr int P_K = 0, P_V = 32768, P_Q = 81920;
#define A_RD128(dst, addr, off) asm volatile("ds_read_b128 %0, %1 offset:%2" : "=v"(dst) : "v"(addr), "i"(off))
#define A_RDTR(dst, addr, off) asm volatile("ds_read_b64_tr_b16 %0, %1 offset:%2" : "=v"(dst) : "v"(addr), "i"(off))
#define A_WAITL(n) asm volatile("s_waitcnt lgkmcnt(" #n ")" ::: "memory")
#define A_WAIT4(n, r0, r1, r2, r3) asm volatile("s_waitcnt lgkmcnt(" #n ")" : "+v"(r0), "+v"(r1), "+v"(r2), "+v"(r3) :: "memory")
#define A_MFMA0(d, a, b) asm volatile("s_nop 1\n\tv_mfma_f32_32x32x16_bf16 %0, %1, %2, 0" : "=&v"(d) : "v"(a), "v"(b))
#define A_MFMA(d, a, b) asm volatile("s_nop 1\n\tv_mfma_f32_32x32x16_bf16 %0, %1, %2, %0" : "+v"(d) : "v"(a), "v"(b))
#define A_PAD() asm volatile("s_nop 7\n\ts_nop 7" ::: "memory")

__device__ __forceinline__ void attn_unit2(LAS unsigned char* lds, const Tensors& T, int b, int h, int qb, const int wid_in) {
    const int lane = lane_now(), r32 = lane & 31, hi = lane >> 5; const int wid = __builtin_amdgcn_readfirstlane(wid_in); const int tid = wid * 64 + lane;
    const size_t rowbase = (size_t)b * SEQ; const int q0 = qb * QB;
    const bf16_t* Kh = T.K + rowbase * 512 + h * 128; const bf16_t* Vh = T.V + rowbase * 512 + h * 128; const bf16_t* Qh = T.Q + (rowbase + q0) * 512 + h * 128;
    LAS float* bt = (LAS float*)(lds + SP_BT); LAS float* wsf = (LAS float*)(lds + SP_WS) + wid * 64;
    unsigned ksrc[2], vsrc[2];
#pragma unroll
    for (int i = 0; i < 2; ++i) { const int p = wid * 2 + i; const int row = 4 * p + (lane >> 4), ch = (lane & 15) ^ (row & 7); ksrc[i] = (unsigned)(row * 512 + ch * 8) * 2u;
        const int st = 2 * p + (lane >> 5), kk = (st >> 2) * 8 + ((lane & 31) >> 2), cc = (st & 3) * 32 + (lane & 3) * 8; vsrc[i] = (unsigned)(kk * 512 + cc) * 2u; }
    const unsigned ldsw = (unsigned)wid * 2048u;
#define ATT_GLDS(sbase, vo, ldsdst) do { unsigned keep_; asm volatile("s_mov_b32 %0, m0\n\ts_mov_b32 m0, %3\n\ts_nop 0\n\tglobal_load_lds_dwordx4 %1, %2\n\ts_mov_b32 m0, %0" \
        : "=&s"(keep_) : "v"(vo), "s"(sbase), "s"(ldsdst) : "memory"); } while (0)
    const unsigned ldsb_ = (unsigned)(uintptr_t)lds;
#define DMA_KV(t) do { const char* kg = (const char*)(Kh + (size_t)(t) * KVB * 512); const char* vg = (const char*)(Vh + (size_t)(t) * KVB * 512); const int kb_ = ((t) & 1) * 16384, vb_ = ((t) % 3) * 16384; \
    _Pragma("unroll") for (int _i = 0; _i < 2; ++_i) { \
        ATT_GLDS(kg, ksrc[_i], (unsigned)__builtin_amdgcn_readfirstlane((int)(ldsb_ + P_K + kb_ + ldsw + _i * 1024))); \
        ATT_GLDS(vg, vsrc[_i], (unsigned)__builtin_amdgcn_readfirstlane((int)(ldsb_ + P_V + vb_ + ldsw + _i * 1024))); } } while (0)
    { int lq = lane; asm volatile("" : "+v"(lq));
      const int rq = lq >> 4; const unsigned qo0 = (unsigned)((32 * wid + rq) * 512 + (((lq & 15) ^ (rq & 7)) << 3)) * 2u, qo1 = (unsigned)((32 * wid + 4 + rq) * 512 + (((lq & 15) ^ ((4 + rq) & 7)) << 3)) * 2u;
#pragma unroll
      for (int i = 0; i < 8; ++i) { const int p = wid * 8 + i;
        __builtin_amdgcn_global_load_lds((const unsigned*)((const char*)Qh + ((i & 1) ? qo1 : qo0) + (size_t)(i >> 1) * 8192), (LAS unsigned*)(lds + P_Q + p * 1024), 16, 0, 0); } }
    DMA_KV(0); DMA_KV(1);
    if (tid < 255) bt[tid] = T.btab[h * 256 + tid];
    int kco[4]; const int qdelta = (P_Q - P_K) + wid * 8192;
#pragma unroll
    for (int d0 = 0; d0 < 4; ++d0) { const int c = r32 * 256 + (((2 * d0 + hi) ^ (r32 & 7)) << 4); kco[d0] = (int)(uintptr_t)(lds + P_K) + c; }
    const int vb0 = (int)(uintptr_t)(lds + P_V) + v_rd_base(lane);
    f32x16 o1[4], o2[4];
#pragma unroll
    for (int d = 0; d < 4; ++d) { o1[d] = f32x16{}; o2[d] = f32x16{}; }
    float l1 = 0.f, l2 = 0.f;
    const int qw = q0 + wid * 32;
    f32x16 P; bf16x8 pa[2], kf[4], qf[4]; unsigned pw[8]; s16x4 vA[4], vB[4];
#define TCLASS(t) ((64 * (t) <= qw - 154) ? 0 : ((64 * (t) >= qw + 122) ? 2 : 1))
#define LOAD_KQ(d0, ka, J2) do { A_RD128(kf[d0], ka, ((J2) & 1) * 8192 + ((J2) >> 1) * 128); A_RD128(qf[d0], kco[d0] + qdelta, ((J2) >> 1) * 128); } while (0)
#define LOAD_K(d0, ka, J2) do { A_RD128(kf[d0], ka, ((J2) & 1) * 8192 + ((J2) >> 1) * 128); } while (0)
#define SLICE(k) do { asm volatile("" : "+v"(P), "+v"(lsum)); const float a_ = __builtin_amdgcn_exp2f(P[2 * (k)]), b_ = __builtin_amdgcn_exp2f(P[2 * (k) + 1]); lsum += a_ + b_; pw[k] = cvt_pk_s(a_, b_); } while (0)
#define BIAS_P(t1, h1) do { const int rb_ = 64 * (t1) + 32 * (h1) - (qw + r32) + 127; _Pragma("unroll") for (int r = 0; r < 16; ++r) { const int i0 = rb_ + crow(r, hi); P[r] += bt[i0 < 0 ? 0 : (i0 > 254 ? 254 : i0)]; } } while (0)
#define PACK_PA() do { u32x4 w0_ = {pw[0], pw[1], pw[2], pw[3]}, w1_ = {pw[4], pw[5], pw[6], pw[7]}; pa[0] = __builtin_bit_cast(bf16x8, w0_); pa[1] = __builtin_bit_cast(bf16x8, w1_); } while (0)
#define RD_V(buf, vaddr, d0, hf) do { A_RDTR(buf[0], vaddr, v_rd_off(d0, 2 * (hf), 0)); A_RDTR(buf[1], vaddr, v_rd_off(d0, 2 * (hf), 1)); A_RDTR(buf[2], vaddr, v_rd_off(d0, 2 * (hf) + 1, 0)); A_RDTR(buf[3], vaddr, v_rd_off(d0, 2 * (hf) + 1, 1)); } while (0)
    asm volatile("s_waitcnt vmcnt(0)" ::: "memory");
    __syncthreads();
#define ITER(TT, J, MODE, QKF, LDF) do { const int t = (TT); \
    const int n_ = 4 * t + (J); constexpr int J1 = ((J) + 1) & 3, J2 = ((J) + 2) & 3, HF = (J) & 1; constexpr bool yq_ = ((J) & 1) != 0, xq_ = ((J) & 1) == 0;     \
    const int t1_ = t + ((J) == 3 ? 1 : 0), t2_ = t + ((J) >= 2 ? 1 : 0); \
    const int va_ = vb0 + (t % 3) * 16384; float lsum = 0.f; constexpr bool qk_ = (QKF), ld_ = (LDF); (void)n_; \
    const int kofs1_ = (t1_ & 1) * 16384, kofs2_ = (t2_ & 1) * 16384; \
    if (qk_) { if (yq_) { LOAD_KQ(2, kco[2] + kofs1_, J1); LOAD_KQ(3, kco[3] + kofs1_, J1); } else { LOAD_K(2, kco[2] + kofs1_, J1); LOAD_K(3, kco[3] + kofs1_, J1); } } \
    RD_V(vA, va_, 0, HF); \
    if (qk_) { if (yq_) A_WAIT4(8, kf[0], qf[0], kf[1], qf[1]); else A_WAIT4(6, kf[0], qf[0], kf[1], qf[1]); A_MFMA0(P, kf[0], qf[0]); A_MFMA(P, kf[1], qf[1]); A_WAIT4(4, kf[2], qf[2], kf[3], qf[3]); A_MFMA(P, kf[2], qf[2]); A_MFMA(P, kf[3], qf[3]); } \
    RD_V(vB, va_, 1, HF); \
    A_WAIT4(4, vA[0], vA[1], vA[2], vA[3]); \
    if ((J) >> 1) { A_MFMA(o2[0], pa[0], PKV(vA[0], vA[1])); } else { A_MFMA(o1[0], pa[0], PKV(vA[0], vA[1])); } \
    if (qk_) { A_PAD(); if (MODE) BIAS_P(t1_, J1 & 1); SLICE(0); } \
    if ((J) >> 1) { A_MFMA(o2[0], pa[1], PKV(vA[2], vA[3])); } else { A_MFMA(o1[0], pa[1], PKV(vA[2], vA[3])); } \
    if (qk_) SLICE(1); \
    A_WAIT4(0, vB[0], vB[1], vB[2], vB[3]); \
    if ((J) >> 1) { A_MFMA(o2[1], pa[0], PKV(vB[0], vB[1])); } else { A_MFMA(o1[1], pa[0], PKV(vB[0], vB[1])); } \
    RD_V(vA, va_, 2, HF); \
    if (qk_) SLICE(2); \
    if ((J) >> 1) { A_MFMA(o2[1], pa[1], PKV(vB[2], vB[3])); } else { A_MFMA(o1[1], pa[1], PKV(vB[2], vB[3])); } \
    if (qk_) SLICE(3); \
      \
    if ((J) == 2) { asm volatile("s_waitcnt vmcnt(0)" ::: "memory"); __syncthreads(); if (t + 2 < NT) DMA_KV(t + 2); } \
    if (ld_) { if (xq_) { LOAD_KQ(0, kco[0] + kofs2_, J2); LOAD_KQ(1, kco[1] + kofs2_, J2); A_WAIT4(4, vA[0], vA[1], vA[2], vA[3]); } else { LOAD_K(0, kco[0] + kofs2_, J2); LOAD_K(1, kco[1] + kofs2_, J2); A_WAIT4(2, vA[0], vA[1], vA[2], vA[3]); } } \
    else { A_WAIT4(0, vA[0], vA[1], vA[2], vA[3]); } \
    if ((J) >> 1) { A_MFMA(o2[2], pa[0], PKV(vA[0], vA[1])); } else { A_MFMA(o1[2], pa[0], PKV(vA[0], vA[1])); } \
    RD_V(vB, va_, 3, HF); \
    if (qk_) SLICE(4); \
    if ((J) >> 1) { A_MFMA(o2[2], pa[1], PKV(vA[2], vA[3])); } else { A_MFMA(o1[2], pa[1], PKV(vA[2], vA[3])); } \
    if (qk_) SLICE(5); \
    A_WAIT4(0, vB[0], vB[1], vB[2], vB[3]); \
    if ((J) >> 1) { A_MFMA(o2[3], pa[0], PKV(vB[0], vB[1])); } else { A_MFMA(o1[3], pa[0], PKV(vB[0], vB[1])); } \
    if (qk_) SLICE(6); \
    if ((J) >> 1) { A_MFMA(o2[3], pa[1], PKV(vB[2], vB[3])); } else { A_MFMA(o1[3], pa[1], PKV(vB[2], vB[3])); } \
    if (qk_) { SLICE(7); PACK_PA(); if (J1 >> 1) l2 += lsum; else l1 += lsum; } \
  } while (0)
#define PHASE(ta_, tbx_, MODE) do { const int tb_ = (tbx_); if ((ta_) < tb_) { float lsum = 0.f; const int t = (ta_); const int kofs0_ = (t & 1) * 16384; \
      _Pragma("unroll") for (int d0 = 0; d0 < 4; ++d0) LOAD_KQ(d0, kco[d0] + kofs0_, 0); \
      A_WAIT4(0, kf[0], qf[0], kf[1], qf[1]); A_WAIT4(0, kf[2], qf[2], kf[3], qf[3]); \
      A_MFMA0(P, kf[0], qf[0]); A_MFMA(P, kf[1], qf[1]); A_MFMA(P, kf[2], qf[2]); A_MFMA(P, kf[3], qf[3]); \
      LOAD_KQ(0, kco[0] + kofs0_, 1); LOAD_KQ(1, kco[1] + kofs0_, 1); \
      A_PAD(); A_PAD(); \
      if (MODE) BIAS_P(t, 0); \
      SLICE(0); SLICE(1); SLICE(2); SLICE(3); SLICE(4); SLICE(5); SLICE(6); SLICE(7); \
      PACK_PA(); l1 += lsum; } \
    for (int tt = (ta_); tt < tb_ - 1; ++tt) { ITER(tt, 0, MODE, true, true); ITER(tt, 1, MODE, true, true); ITER(tt, 2, MODE, true, true); ITER(tt, 3, MODE, true, true); } \
    if ((ta_) < tb_) { ITER(tb_ - 1, 0, MODE, true, true); ITER(tb_ - 1, 1, MODE, true, true); ITER(tb_ - 1, 2, MODE, true, false); ITER(tb_ - 1, 3, MODE, false, false); } } while (0)
#define RESCALE(f_) do { A_PAD(); A_PAD(); A_PAD(); A_PAD(); _Pragma("unroll") for (int d = 0; d < 4; ++d) { o1[d] *= (f_); o2[d] *= (f_); } l1 *= (f_); l2 *= (f_); } while (0)
    int tA = (qw - 154 < 0) ? 0 : ((qw - 154) >> 6) + 1; if (tA > NT) tA = NT;
    int tB = (qw + 122 + 63) >> 6; if (tB > NT) tB = NT; if (tB < tA) tB = tA;
    PHASE(0, tA, 0);
    { const float f_ = __builtin_amdgcn_exp2f(bt[0]); RESCALE(f_); }
    PHASE(tA, tB, 1);
    { const float f_ = __builtin_amdgcn_exp2f(-bt[254]); RESCALE(f_); }
    PHASE(tB, NT, 0);
#undef PHASE
#undef RESCALE
#undef ITER
#undef DMA_KV
#undef ATT_GLDS
#undef TCLASS
#undef LOAD_KQ
#undef LOAD_K
#undef SLICE
#undef BIAS_P
#undef PACK_PA
#undef RD_V
    A_PAD(); A_PAD();
    { const int lane_e = lane_now(), r32e = lane_e & 31, hie = lane_e >> 5;
      LAS float* wse = (LAS float*)(lds + SP_WS) + wid * 64;
      l1 += __shfl_xor(l1, 32); l2 += __shfl_xor(l2, 32);
      if (hie == 0) { wse[r32e] = 1.0f / l1; wse[32 + r32e] = T.lam / l2; }
      LDS_WAIT();
      float gs[4];
#pragma unroll
      for (int d = 0; d < 4; ++d) gs[d] = T.gsub[32 * d + r32e] * (1.0f - LAM_INIT);
      bf16_t* Ow = T.Amix + (rowbase + q0 + wid * 32 + 4 * hie) * 1024 + 512 + h * 128 + r32e; asm volatile("" : "+v"(Ow));
#pragma unroll
      for (int r = 0; r < 16; ++r) { const int row = crow(r, hie); const float c1 = wse[row], c2 = wse[32 + row];
        float y[4], ss = 0.f;
#pragma unroll
        for (int d = 0; d < 4; ++d) { y[d] = o1[d][r] * c1 - o2[d][r] * c2; ss += y[d] * y[d]; }
        ss += __shfl_xor(ss, 1); ss += __shfl_xor(ss, 2); ss += __shfl_xor(ss, 4); ss += __shfl_xor(ss, 8); ss += __shfl_xor(ss, 16);
        const float rr = rsqrtf(ss * (1.0f / 128.0f) + EPS);
#pragma unroll
        for (int d = 0; d < 4; ++d) Ow[(size_t)((r & 3) + 8 * (r >> 2)) * 1024 + 32 * d] = (bf16_t)(cvt_pk_bf16(y[d] * rr * gs[d], 0.f) & 0xffffu); } }
    __syncthreads();
}
__device__ __forceinline__ void attn_unit3(LAS unsigned char* lds, const Tensors& T, int b, int h, int qb, const int wid_in) {
    const int lane = lane_now(), r32 = lane & 31, hi = lane >> 5; const int wid = __builtin_amdgcn_readfirstlane(wid_in); const int tid = wid * 64 + lane;
    const size_t rowbase = (size_t)b * SEQ; const int q0 = qb * QB;
    const unsigned char* Kh = (const unsigned char*)T.K + rowbase * 512 + h * 128; const bf16_t* Vh = T.V + rowbase * 512 + h * 128; const unsigned char* Qh = (const unsigned char*)T.Q + (rowbase + q0) * 512 + h * 128;
    LAS float* bt = (LAS float*)(lds + SP_BT); LAS float* wsf = (LAS float*)(lds + SP_WS) + wid * 64;
    unsigned ksrc, vsrc[2];
    { const int row = 8 * wid + (lane >> 3), ch = (lane & 7) ^ ((row >> 1) & 7); ksrc = (unsigned)(row * 512 + ch * 16); }
#pragma unroll
    for (int i = 0; i < 2; ++i) { const int p = wid * 2 + i;
        const int st = 2 * p + (lane >> 5), kk = (st >> 2) * 8 + ((lane & 31) >> 2), cc = (st & 3) * 32 + (lane & 3) * 8; vsrc[i] = (unsigned)(kk * 512 + cc) * 2u; }
    const unsigned ldsw = (unsigned)wid * 2048u;
#define ATT_GLDS(sbase, vo, ldsdst) do { unsigned keep_; asm volatile("s_mov_b32 %0, m0\n\ts_mov_b32 m0, %3\n\ts_nop 0\n\tglobal_load_lds_dwordx4 %1, %2\n\ts_mov_b32 m0, %0" \
        : "=&s"(keep_) : "v"(vo), "s"(sbase), "s"(ldsdst) : "memory"); } while (0)
    const unsigned ldsb_ = (unsigned)(uintptr_t)lds;
#define DMA_KV(t) do { const char* kg = (const char*)(Kh + (size_t)(t) * KVB * 512); const char* vg = (const char*)(Vh + (size_t)(t) * KVB * 512); const int kb_ = ((t) & 1) * 8192, vb_ = ((t) % 3) * 16384; \
    ATT_GLDS(kg, ksrc, (unsigned)__builtin_amdgcn_readfirstlane((int)(ldsb_ + P_K + kb_ + wid * 1024))); \
    _Pragma("unroll") for (int _i = 0; _i < 2; ++_i) { \
        ATT_GLDS(vg, vsrc[_i], (unsigned)__builtin_amdgcn_readfirstlane((int)(ldsb_ + P_V + vb_ + ldsw + _i * 1024))); } } while (0)
    { int lq = lane; asm volatile("" : "+v"(lq));
      const int r8 = lq >> 3;
#pragma unroll
      for (int i = 0; i < 4; ++i) { const int p = wid * 4 + i, row = 8 * i + r8, ch = (lq & 7) ^ ((row >> 1) & 7);
        __builtin_amdgcn_global_load_lds((const unsigned*)((const char*)Qh + (size_t)(32 * wid + row) * 512 + ch * 16), (LAS unsigned*)(lds + P_Q + p * 1024), 16, 0, 0); } }
    DMA_KV(0); DMA_KV(1);
    if (tid < 255) bt[tid] = T.btab[h * 256 + tid];
    int kco[4]; const int qdelta = (P_Q - P_K) + wid * 4096;
#pragma unroll
    for (int d0 = 0; d0 < 4; ++d0) { const int c = r32 * 128 + ((((d0 >> 1) * 4 + 2 * hi + (d0 & 1)) ^ ((r32 >> 1) & 7)) << 4); kco[d0] = (int)(uintptr_t)(lds + P_K) + c; }
    const int sca = 127, scb = 124;
    const int vb0 = (int)(uintptr_t)(lds + P_V) + v_rd_base(lane);
    f32x16 o1[4], o2[4];
#pragma unroll
    for (int d = 0; d < 4; ++d) { o1[d] = f32x16{}; o2[d] = f32x16{}; }
    float l1 = 0.f, l2 = 0.f;
    const int qw = q0 + wid * 32;
    f32x16 P; bf16x8 pa[2]; pg8::i32x8 kf, qf; unsigned pw[8]; s16x4 vA[4], vB[4];
#define TCLASS(t) ((64 * (t) <= qw - 154) ? 0 : ((64 * (t) >= qw + 122) ? 2 : 1))
#define LD8(addr, off) __builtin_shufflevector(*(const LAS pg8::i32x4v*)(uintptr_t)(unsigned)((addr) + (off)), *(const LAS pg8::i32x4v*)(uintptr_t)(unsigned)((addr##1) + (off)), 0, 1, 2, 3, 4, 5, 6, 7)
#define LOAD_K(ko, J2) do { const int ka0_ = kco[2 * ((J2) >> 1)] + (ko), ka0_1 = kco[2 * ((J2) >> 1) + 1] + (ko); kf = LD8(ka0_, ((J2) & 1) * 4096); } while (0)
#define LOAD_Q(J2) do { const int qa0_ = kco[2 * ((J2) >> 1)] + qdelta, qa0_1 = kco[2 * ((J2) >> 1) + 1] + qdelta; qf = LD8(qa0_, 0); } while (0)
#define A_QK(d) asm volatile("s_nop 1\n\tv_mfma_scale_f32_32x32x64_f8f6f4 %0, %1, %2, 0, %3, %4 op_sel_hi:[0,0,0]" : "=&v"(d) : "v"(kf), "v"(qf), "v"(sca), "v"(scb))
#define A_NAMEKQ() asm volatile("" : "+v"(kf), "+v"(qf))
#define SLICE(k) do { asm volatile("" : "+v"(P), "+v"(lsum)); const float a_ = __builtin_amdgcn_exp2f(P[2 * (k)]), b_ = __builtin_amdgcn_exp2f(P[2 * (k) + 1]); lsum += a_ + b_; pw[k] = cvt_pk_s(a_, b_); } while (0)
#define BIAS_P(t1, h1) do { const int rb_ = 64 * (t1) + 32 * (h1) - (qw + r32) + 127; _Pragma("unroll") for (int r = 0; r < 16; ++r) { const int i0 = rb_ + crow(r, hi); P[r] += bt[i0 < 0 ? 0 : (i0 > 254 ? 254 : i0)]; } } while (0)
#define PACK_PA() do { u32x4 w0_ = {pw[0], pw[1], pw[2], pw[3]}, w1_ = {pw[4], pw[5], pw[6], pw[7]}; pa[0] = __builtin_bit_cast(bf16x8, w0_); pa[1] = __builtin_bit_cast(bf16x8, w1_); } while (0)
#define RD_V(buf, vaddr, d0, hf) do { A_RDTR(buf[0], vaddr, v_rd_off(d0, 2 * (hf), 0)); A_RDTR(buf[1], vaddr, v_rd_off(d0, 2 * (hf), 1)); A_RDTR(buf[2], vaddr, v_rd_off(d0, 2 * (hf) + 1, 0)); A_RDTR(buf[3], vaddr, v_rd_off(d0, 2 * (hf) + 1, 1)); } while (0)
    asm volatile("s_waitcnt vmcnt(0)" ::: "memory");
    __syncthreads();
#define ITER(TT, J, MODE, QKF, LDF) do { const int t = (TT); \
    const int n_ = 4 * t + (J); constexpr int J1 = ((J) + 1) & 3, J2 = ((J) + 2) & 3, HF = (J) & 1; constexpr bool xq_ = ((J) & 1) == 0;     \
    const int t1_ = t + ((J) == 3 ? 1 : 0), t2_ = t + ((J) >= 2 ? 1 : 0); \
    const int va_ = vb0 + (t % 3) * 16384; float lsum = 0.f; constexpr bool qk_ = (QKF), ld_ = (LDF); (void)n_; (void)t1_; \
    const int kofs2_ = (t2_ & 1) * 8192; \
    RD_V(vA, va_, 0, HF); \
    if (qk_) { A_QK(P); } \
    RD_V(vB, va_, 1, HF); \
    A_WAIT4(4, vA[0], vA[1], vA[2], vA[3]); \
    if ((J) >> 1) { A_MFMA(o2[0], pa[0], PKV(vA[0], vA[1])); } else { A_MFMA(o1[0], pa[0], PKV(vA[0], vA[1])); } \
    if (qk_) { A_PAD(); if (MODE) BIAS_P(t1_, J1 & 1); SLICE(0); } \
    if ((J) >> 1) { A_MFMA(o2[0], pa[1], PKV(vA[2], vA[3])); } else { A_MFMA(o1[0], pa[1], PKV(vA[2], vA[3])); } \
    if (qk_) SLICE(1); \
    A_WAIT4(0, vB[0], vB[1], vB[2], vB[3]); \
    if (ld_ && (J) != 2) { LOAD_K(kofs2_, J2); if (xq_) LOAD_Q(J2); }       \
    if ((J) >> 1) { A_MFMA(o2[1], pa[0], PKV(vB[0], vB[1])); } else { A_MFMA(o1[1], pa[0], PKV(vB[0], vB[1])); } \
    RD_V(vA, va_, 2, HF); \
    if (qk_) SLICE(2); \
    if ((J) >> 1) { A_MFMA(o2[1], pa[1], PKV(vB[2], vB[3])); } else { A_MFMA(o1[1], pa[1], PKV(vB[2], vB[3])); } \
    if (qk_) SLICE(3); \
      \
    if ((J) == 2) { asm volatile("s_waitcnt vmcnt(0)" ::: "memory"); __syncthreads(); if (t + 2 < NT) DMA_KV(t + 2); } \
    if (ld_ && (J) == 2) { LOAD_K(kofs2_, J2); if (xq_) LOAD_Q(J2); } \
    A_WAIT4(0, vA[0], vA[1], vA[2], vA[3]); \
    if (ld_) A_NAMEKQ(); \
    if ((J) >> 1) { A_MFMA(o2[2], pa[0], PKV(vA[0], vA[1])); } else { A_MFMA(o1[2], pa[0], PKV(vA[0], vA[1])); } \
    RD_V(vB, va_, 3, HF); \
    if (qk_) SLICE(4); \
    if ((J) >> 1) { A_MFMA(o2[2], pa[1], PKV(vA[2], vA[3])); } else { A_MFMA(o1[2], pa[1], PKV(vA[2], vA[3])); } \
    if (qk_) SLICE(5); \
    A_WAIT4(0, vB[0], vB[1], vB[2], vB[3]); \
    if ((J) >> 1) { A_MFMA(o2[3], pa[0], PKV(vB[0], vB[1])); } else { A_MFMA(o1[3], pa[0], PKV(vB[0], vB[1])); } \
    if (qk_) SLICE(6); \
    if ((J) >> 1) { A_MFMA(o2[3], pa[1], PKV(vB[2], vB[3])); } else { A_MFMA(o1[3], pa[1], PKV(vB[2], vB[3])); } \
    if (qk_) { SLICE(7); PACK_PA(); if (J1 >> 1) l2 += lsum; else l1 += lsum; } \
  } while (0)
#define PHASE(ta_, tbx_, MODE) do { const int tb_ = (tbx_); if ((ta_) < tb_) { float lsum = 0.f; const int t = (ta_); const int kofs0_ = (t & 1) * 8192; \
      LOAD_K(kofs0_, 0); LOAD_Q(0); A_WAITL(0); A_NAMEKQ(); \
      A_QK(P); \
      LOAD_K(kofs0_, 1); A_WAITL(0); \
      A_PAD(); A_PAD(); A_PAD(); A_PAD(); A_NAMEKQ(); \
      if (MODE) BIAS_P(t, 0); \
      SLICE(0); SLICE(1); SLICE(2); SLICE(3); SLICE(4); SLICE(5); SLICE(6); SLICE(7); \
      PACK_PA(); l1 += lsum; } \
    for (int tt = (ta_); tt < tb_ - 1; ++tt) { ITER(tt, 0, MODE, true, true); ITER(tt, 1, MODE, true, true); ITER(tt, 2, MODE, true, true); ITER(tt, 3, MODE, true, true); } \
    if ((ta_) < tb_) { ITER(tb_ - 1, 0, MODE, true, true); ITER(tb_ - 1, 1, MODE, true, true); ITER(tb_ - 1, 2, MODE, true, false); ITER(tb_ - 1, 3, MODE, false, false); } } while (0)
#define RESCALE(f_) do { A_PAD(); A_PAD(); A_PAD(); A_PAD(); _Pragma("unroll") for (int d = 0; d < 4; ++d) { o1[d] *= (f_); o2[d] *= (f_); } l1 *= (f_); l2 *= (f_); } while (0)
    int tA = (qw - 154 < 0) ? 0 : ((qw - 154) >> 6) + 1; if (tA > NT) tA = NT;
    int tB = (qw + 122 + 63) >> 6; if (tB > NT) tB = NT; if (tB < tA) tB = tA;
    PHASE(0, tA, 0);
    { const float f_ = __builtin_amdgcn_exp2f(bt[0]); RESCALE(f_); }
    PHASE(tA, tB, 1);
    { const float f_ = __builtin_amdgcn_exp2f(-bt[254]); RESCALE(f_); }
    PHASE(tB, NT, 0);
#undef PHASE
#undef RESCALE
#undef ITER
#undef DMA_KV
#undef ATT_GLDS
#undef TCLASS
#undef LOAD_K
#undef LOAD_Q
#undef LD8
#undef A_QK
#undef A_NAMEKQ
#undef SLICE
#undef BIAS_P
#undef PACK_PA
#undef RD_V
    A_PAD(); A_PAD();
    { const int lane_e = lane_now(), r32e = lane_e & 31, hie = lane_e >> 5;
      LAS float* wse = (LAS float*)(lds + SP_WS) + wid * 64;
      l1 += __shfl_xor(l1, 32); l2 += __shfl_xor(l2, 32);
      if (hie == 0) { wse[r32e] = 1.0f / l1; wse[32 + r32e] = T.lam / l2; }
      LDS_WAIT();
      float gs[4];
#pragma unroll
      for (int d = 0; d < 4; ++d) gs[d] = T.gsub[32 * d + r32e] * (1.0f - LAM_INIT);
      bf16_t* Ow = T.Amix + (rowbase + q0 + wid * 32 + 4 * hie) * 1024 + 512 + h * 128 + r32e; asm volatile("" : "+v"(Ow));
#pragma unroll
      for (int r = 0; r < 16; ++r) { const int row = crow(r, hie); const float c1 = wse[row], c2 = wse[32 + row];
        float y[4], ss = 0.f;
#pragma unroll
        for (int d = 0; d < 4; ++d) { y[d] = o1[d][r] * c1 - o2[d][r] * c2; ss += y[d] * y[d]; }
        ss += __shfl_xor(ss, 1); ss += __shfl_xor(ss, 2); ss += __shfl_xor(ss, 4); ss += __shfl_xor(ss, 8); ss += __shfl_xor(ss, 16);
        const float rr = rsqrtf(ss * (1.0f / 128.0f) + EPS);
#pragma unroll
        for (int d = 0; d < 4; ++d) Ow[(size_t)((r & 3) + 8 * (r >> 2)) * 1024 + 32 * d] = (bf16_t)(cvt_pk_bf16(y[d] * rr * gs[d], 0.f) & 0xffffu); } }
    __syncthreads();
}
__device__ __forceinline__ void attn_unit5(LAS unsigned char* lds, const Tensors& T, int b, int h, int qb, const int wid_in, const int cv0) {
    const int lane = lane_now(), r32 = lane & 31, hi = lane >> 5; const int wid = __builtin_amdgcn_readfirstlane(wid_in); const int tid = wid * 64 + lane;
    const size_t rowbase = (size_t)b * SEQ; const int q0 = qb * QB;
    const unsigned char* Kh = (const unsigned char*)T.K + rowbase * 512 + h * 128; const bf16_t* Vh = T.V + rowbase * 512 + h * 128; const unsigned char* Qh = (const unsigned char*)T.Q + (rowbase + q0) * 512 + h * 128;
    LAS float* bt = (LAS float*)(lds + SP_BT); LAS float* wsf = (LAS float*)(lds + SP_WS) + wid * 64;
    unsigned ksrc, vsrc[2];
    { const int row = 8 * wid + (lane >> 3), ch = (lane & 7) ^ ((row >> 1) & 7); ksrc = (unsigned)(row * 512 + ch * 16); }
#pragma unroll
    for (int i = 0; i < 2; ++i) { const int p = wid * 2 + i;
        const int st = 2 * p + (lane >> 5), kk = (st >> 2) * 8 + ((lane & 31) >> 2), cc = (st & 3) * 32 + (lane & 3) * 8; vsrc[i] = (unsigned)(kk * 512 + cc) * 2u; }
    const unsigned ldsw = (unsigned)wid * 2048u;
#define ATT_GLDS(sbase, vo, ldsdst) do { unsigned keep_; asm volatile("s_mov_b32 %0, m0\n\ts_mov_b32 m0, %3\n\ts_nop 0\n\tglobal_load_lds_dwordx4 %1, %2\n\ts_mov_b32 m0, %0" \
        : "=&s"(keep_) : "v"(vo), "s"(sbase), "s"(ldsdst) : "memory"); } while (0)
    const unsigned ldsb_ = (unsigned)(uintptr_t)lds;
#define DMA_KV(t) do { const char* kg = (const char*)(Kh + (size_t)(t) * KVB * 512); const char* vg = (const char*)(Vh + (size_t)(t) * KVB * 512); const int kb_ = ((t) & 1) * 8192, vb_ = ((t) % 3) * 16384; \
    ATT_GLDS(kg, ksrc, (unsigned)__builtin_amdgcn_readfirstlane((int)(ldsb_ + P_K + kb_ + wid * 1024))); \
    _Pragma("unroll") for (int _i = 0; _i < 2; ++_i) { \
        ATT_GLDS(vg, vsrc[_i], (unsigned)__builtin_amdgcn_readfirstlane((int)(ldsb_ + P_V + vb_ + ldsw + _i * 1024))); } } while (0)
    constexpr int CVB = 114688;
    const int cgw = T.gw0 + wid, ce = cgw >> 6, ckq = cgw & 63;
    unsigned cvp0 = 0u, cvp1 = 0u, cvp2 = 0u, cvp3 = 0u;
#define CV_ACT(hs_) ((hs_) >= 0 && (hs_) < 31 && cv0 + (hs_) < 48)
#define CV_DMA(s__) do { const int s_ = (s__); const bool w2_ = s_ < 16; const int nc_ = w2_ ? s_ : s_ - 16, ldw_ = w2_ ? 1024 : 2048; \
      const char* cb_ = (const char*)(w2_ ? T.w2 + (size_t)ce * 1048576 : T.w1 + (size_t)ce * 2097152) + ((size_t)(ckq * 16) * ldw_ + nc_ * 64) * 4; \
      const int l_ = lane_now(); const unsigned vo_ = (unsigned)((l_ >> 4) * ldw_ * 4 + (l_ & 15) * 16); \
      _Pragma("unroll") for (int i_ = 0; i_ < 4; ++i_) ATT_GLDS(cb_ + (size_t)(4 * i_) * ldw_ * 4, vo_, (unsigned)__builtin_amdgcn_readfirstlane((int)(ldsb_ + CVB + wid * 4096 + i_ * 1024))); } while (0)
#define CV_CHUNK(c_, s__, DST) do { const int s_ = (s__); const int l_ = lane_now(); const bool w2_ = s_ < 16; const int nl_ = w2_ ? l_ : ((l_ < 32) ? 2 * l_ : 2 * (l_ - 32) + 1); \
      const float sc_ = w2_ ? 64.f : ((l_ < 32) ? 64.f * SWG_C : 64.f / SWG_C); const LAS float* p_ = (const LAS float*)(lds + CVB + wid * 4096) + (4 * (c_)) * 64 + nl_; \
      DST = cvt_pk4_fp8(sc_ * p_[0], sc_ * p_[64], sc_ * p_[128], sc_ * p_[192]); } while (0)
#define CV_STORE(s__) do { const int s_ = (s__); const int l_ = lane_now(); const bool w2_ = s_ < 16; const int nc_ = w2_ ? s_ : s_ - 16; \
      const int row1_ = (nc_ >> 2) * 256 + ((l_ < 32) ? (32 * (nc_ & 3) + l_) : (128 + 32 * (nc_ & 3) + l_ - 32)); \
      unsigned char* d_ = w2_ ? T.w2t + (size_t)ce * 1048576 + (size_t)(nc_ * 64 + l_) * 1024 + ckq * 16 : T.w1t + (size_t)ce * 2097152 + (size_t)row1_ * 1024 + ckq * 16; \
      *(u32x4*)d_ = (u32x4){cvp0, cvp1, cvp2, cvp3}; } while (0)
    { int lq = lane; asm volatile("" : "+v"(lq));
      const int r8 = lq >> 3;
#pragma unroll
      for (int i = 0; i < 4; ++i) { const int p = wid * 4 + i, row = 8 * i + r8, ch = (lq & 7) ^ ((row >> 1) & 7);
        __builtin_amdgcn_global_load_lds((const unsigned*)((const char*)Qh + (size_t)(32 * wid + row) * 512 + ch * 16), (LAS unsigned*)(lds + P_Q + p * 1024), 16, 0, 0); } }
    DMA_KV(0); DMA_KV(1);
    if (tid < 255) bt[tid] = T.btab[h * 256 + tid];
    int kco[4]; const int qdelta = (P_Q - P_K) + wid * 4096;
#pragma unroll
    for (int d0 = 0; d0 < 4; ++d0) { const int c = r32 * 128 + ((((d0 >> 1) * 4 + 2 * hi + (d0 & 1)) ^ ((r32 >> 1) & 7)) << 4); kco[d0] = (int)(uintptr_t)(lds + P_K) + c; }
    const int sca = 127, scb = 124;
    const int vb0 = (int)(uintptr_t)(lds + P_V) + v_rd_base(lane);
    f32x16 o1[4], o2[4];
#pragma unroll
    for (int d = 0; d < 4; ++d) { o1[d] = f32x16{}; o2[d] = f32x16{}; }
    float l1 = 0.f, l2 = 0.f;
    const int qw = q0 + wid * 32;
    f32x16 P; bf16x8 pa[2]; pg8::i32x8 kf, qf; unsigned pw[8]; s16x4 vA[4], vB[4];
#define TCLASS(t) ((64 * (t) <= qw - 154) ? 0 : ((64 * (t) >= qw + 122) ? 2 : 1))
#define LD8(addr, off) __builtin_shufflevector(*(const LAS pg8::i32x4v*)(uintptr_t)(unsigned)((addr) + (off)), *(const LAS pg8::i32x4v*)(uintptr_t)(unsigned)((addr##1) + (off)), 0, 1, 2, 3, 4, 5, 6, 7)
#define LOAD_K(ko, J2) do { const int ka0_ = kco[2 * ((J2) >> 1)] + (ko), ka0_1 = kco[2 * ((J2) >> 1) + 1] + (ko); kf = LD8(ka0_, ((J2) & 1) * 4096); } while (0)
#define LOAD_Q(J2) do { const int qa0_ = kco[2 * ((J2) >> 1)] + qdelta, qa0_1 = kco[2 * ((J2) >> 1) + 1] + qdelta; qf = LD8(qa0_, 0); } while (0)
#define A_QK(d) asm volatile("s_nop 1\n\tv_mfma_scale_f32_32x32x64_f8f6f4 %0, %1, %2, 0, %3, %4 op_sel_hi:[0,0,0]" : "=&v"(d) : "v"(kf), "v"(qf), "v"(sca), "v"(scb))
#define A_NAMEKQ() asm volatile("" : "+v"(kf), "+v"(qf))
#define SLICE(k) do { asm volatile("" : "+v"(P), "+v"(lsum)); const float a_ = __builtin_amdgcn_exp2f(P[2 * (k)]), b_ = __builtin_amdgcn_exp2f(P[2 * (k) + 1]); lsum += a_ + b_; pw[k] = cvt_pk_s(a_, b_); } while (0)
#define BIAS_P(t1, h1) do { const int rb_ = 64 * (t1) + 32 * (h1) - (qw + r32) + 127; _Pragma("unroll") for (int r = 0; r < 16; ++r) { const int i0 = rb_ + crow(r, hi); P[r] += bt[i0 < 0 ? 0 : (i0 > 254 ? 254 : i0)]; } } while (0)
#define PACK_PA() do { u32x4 w0_ = {pw[0], pw[1], pw[2], pw[3]}, w1_ = {pw[4], pw[5], pw[6], pw[7]}; pa[0] = __builtin_bit_cast(bf16x8, w0_); pa[1] = __builtin_bit_cast(bf16x8, w1_); } while (0)
#define RD_V(buf, vaddr, d0, hf) do { A_RDTR(buf[0], vaddr, v_rd_off(d0, 2 * (hf), 0)); A_RDTR(buf[1], vaddr, v_rd_off(d0, 2 * (hf), 1)); A_RDTR(buf[2], vaddr, v_rd_off(d0, 2 * (hf) + 1, 0)); A_RDTR(buf[3], vaddr, v_rd_off(d0, 2 * (hf) + 1, 1)); } while (0)
    asm volatile("s_waitcnt vmcnt(0)" ::: "memory");
    __syncthreads();
#define ITER(TT, J, MODE, QKF, LDF) do { const int t = (TT); \
    const int n_ = 4 * t + (J); constexpr int J1 = ((J) + 1) & 3, J2 = ((J) + 2) & 3, HF = (J) & 1; constexpr bool xq_ = ((J) & 1) == 0;     \
    const int t1_ = t + ((J) == 3 ? 1 : 0), t2_ = t + ((J) >= 2 ? 1 : 0); \
    const int va_ = vb0 + (t % 3) * 16384; float lsum = 0.f; constexpr bool qk_ = (QKF), ld_ = (LDF); (void)n_; (void)t1_; \
    const int kofs2_ = (t2_ & 1) * 8192; \
    RD_V(vA, va_, 0, HF); \
    if (qk_) { A_QK(P); } \
    RD_V(vB, va_, 1, HF); \
    A_WAIT4(4, vA[0], vA[1], vA[2], vA[3]); \
    if ((J) >> 1) { A_MFMA(o2[0], pa[0], PKV(vA[0], vA[1])); } else { A_MFMA(o1[0], pa[0], PKV(vA[0], vA[1])); } \
    if (qk_) { A_PAD(); if (MODE) BIAS_P(t1_, J1 & 1); SLICE(0); } \
    if ((J) >> 1) { A_MFMA(o2[0], pa[1], PKV(vA[2], vA[3])); } else { A_MFMA(o1[0], pa[1], PKV(vA[2], vA[3])); } \
    if (qk_) SLICE(1); \
    A_WAIT4(0, vB[0], vB[1], vB[2], vB[3]); \
    if (ld_ && (J) != 2) { LOAD_K(kofs2_, J2); if (xq_) LOAD_Q(J2); }       \
    if ((J) >> 1) { A_MFMA(o2[1], pa[0], PKV(vB[0], vB[1])); } else { A_MFMA(o1[1], pa[0], PKV(vB[0], vB[1])); } \
    RD_V(vA, va_, 2, HF); \
    if (qk_) SLICE(2); \
    if ((J) >> 1) { A_MFMA(o2[1], pa[1], PKV(vB[2], vB[3])); } else { A_MFMA(o1[1], pa[1], PKV(vB[2], vB[3])); } \
    if (qk_) SLICE(3); \
      \
    if ((J) == 2) { asm volatile("s_waitcnt vmcnt(0)" ::: "memory"); __syncthreads(); if (t + 2 < NT) DMA_KV(t + 2); \
        const int hs_ = t >> 1; if (!(t & 1)) { if (CV_ACT(hs_)) CV_DMA(cv0 + hs_); } \
        else if (CV_ACT(hs_)) { CV_CHUNK(0, cv0 + hs_, cvp0); CV_CHUNK(1, cv0 + hs_, cvp1); CV_CHUNK(2, cv0 + hs_, cvp2); CV_CHUNK(3, cv0 + hs_, cvp3); CV_STORE(cv0 + hs_); } } \
    if (ld_ && (J) == 2) { LOAD_K(kofs2_, J2); if (xq_) LOAD_Q(J2); } \
    A_WAIT4(0, vA[0], vA[1], vA[2], vA[3]); \
    if (ld_) A_NAMEKQ(); \
    if ((J) >> 1) { A_MFMA(o2[2], pa[0], PKV(vA[0], vA[1])); } else { A_MFMA(o1[2], pa[0], PKV(vA[0], vA[1])); } \
    RD_V(vB, va_, 3, HF); \
    if (qk_) SLICE(4); \
    if ((J) >> 1) { A_MFMA(o2[2], pa[1], PKV(vA[2], vA[3])); } else { A_MFMA(o1[2], pa[1], PKV(vA[2], vA[3])); } \
    if (qk_) SLICE(5); \
    A_WAIT4(0, vB[0], vB[1], vB[2], vB[3]); \
    if ((J) >> 1) { A_MFMA(o2[3], pa[0], PKV(vB[0], vB[1])); } else { A_MFMA(o1[3], pa[0], PKV(vB[0], vB[1])); } \
    if (qk_) SLICE(6); \
    if ((J) >> 1) { A_MFMA(o2[3], pa[1], PKV(vB[2], vB[3])); } else { A_MFMA(o1[3], pa[1], PKV(vB[2], vB[3])); } \
    if (qk_) { SLICE(7); PACK_PA(); if (J1 >> 1) l2 += lsum; else l1 += lsum; } \
  } while (0)
#define PHASE(ta_, tbx_, MODE) do { const int tb_ = (tbx_); if ((ta_) < tb_) { float lsum = 0.f; const int t = (ta_); const int kofs0_ = (t & 1) * 8192; \
      LOAD_K(kofs0_, 0); LOAD_Q(0); A_WAITL(0); A_NAMEKQ(); \
      A_QK(P); \
      LOAD_K(kofs0_, 1); A_WAITL(0); \
      A_PAD(); A_PAD(); A_PAD(); A_PAD(); A_NAMEKQ(); \
      if (MODE) BIAS_P(t, 0); \
      SLICE(0); SLICE(1); SLICE(2); SLICE(3); SLICE(4); SLICE(5); SLICE(6); SLICE(7); \
      PACK_PA(); l1 += lsum; } \
    for (int tt = (ta_); tt < tb_ - 1; ++tt) { ITER(tt, 0, MODE, true, true); ITER(tt, 1, MODE, true, true); ITER(tt, 2, MODE, true, true); ITER(tt, 3, MODE, true, true); } \
    if ((ta_) < tb_) { ITER(tb_ - 1, 0, MODE, true, true); ITER(tb_ - 1, 1, MODE, true, true); ITER(tb_ - 1, 2, MODE, true, false); ITER(tb_ - 1, 3, MODE, false, false); } } while (0)
#define RESCALE(f_) do { A_PAD(); A_PAD(); A_PAD(); A_PAD(); _Pragma("unroll") for (int d = 0; d < 4; ++d) { o1[d] *= (f_); o2[d] *= (f_); } l1 *= (f_); l2 *= (f_); } while (0)
    int tA = (qw - 154 < 0) ? 0 : ((qw - 154) >> 6) + 1; if (tA > NT) tA = NT;
    int tB = (qw + 122 + 63) >> 6; if (tB > NT) tB = NT; if (tB < tA) tB = tA;
    PHASE(0, tA, 0);
    { const float f_ = __builtin_amdgcn_exp2f(bt[0]); RESCALE(f_); }
    PHASE(tA, tB, 1);
    { const float f_ = __builtin_amdgcn_exp2f(-bt[254]); RESCALE(f_); }
    PHASE(tB, NT, 0);
#undef PHASE
#undef RESCALE
#undef ITER
#undef DMA_KV
#undef CV_ACT
#undef CV_DMA
#undef CV_CHUNK
#undef CV_STORE
#undef ATT_GLDS
#undef TCLASS
#undef LOAD_K
#undef LOAD_Q
#undef LD8
#undef A_QK
#undef A_NAMEKQ
#undef SLICE
#undef BIAS_P
#undef PACK_PA
#undef RD_V
    A_PAD(); A_PAD();
    { const int lane_e = lane_now(), r32e = lane_e & 31, hie = lane_e >> 5;
      LAS float* wse = (LAS float*)(lds + SP_WS) + wid * 64;
      l1 += __shfl_xor(l1, 32); l2 += __shfl_xor(l2, 32);
      if (hie == 0) { wse[r32e] = 1.0f / l1; wse[32 + r32e] = T.lam / l2; }
      LDS_WAIT();
      float gs[4];
#pragma unroll
      for (int d = 0; d < 4; ++d) gs[d] = T.gsub[32 * d + r32e] * (1.0f - LAM_INIT);
      LAS unsigned char* st0 = lds + P_Q + wid * 4096; LAS unsigned char* st1 = lds + CVB + wid * 4096;
      LAS unsigned char* stw = (hie ? st0 + 4 * 256 : st0) + r32e * 2; asm volatile("" : "+v"(stw));
#pragma unroll
      for (int r = 0; r < 16; ++r) { const int row = crow(r, hie); const float c1 = wse[row], c2 = wse[32 + row];
        float y[4], ss = 0.f;
#pragma unroll
        for (int d = 0; d < 4; ++d) { y[d] = o1[d][r] * c1 - o2[d][r] * c2; ss += y[d] * y[d]; }
        ss += __shfl_xor(ss, 1); ss += __shfl_xor(ss, 2); ss += __shfl_xor(ss, 4); ss += __shfl_xor(ss, 8); ss += __shfl_xor(ss, 16);
        const float rr = rsqrtf(ss * (1.0f / 128.0f) + EPS);
        LAS unsigned char* wp = stw + ((r >= 8) ? (int)(st1 - st0) : 0) + (((r & 3) + 8 * ((r >> 2) & 1)) * 256);
#pragma unroll
        for (int d = 0; d < 4; ++d) *(LAS bf16_t*)(wp + 64 * d) = (bf16_t)(cvt_pk_bf16(y[d] * rr * gs[d], 0.f) & 0xffffu); }
      LDS_WAIT(); asm volatile("" ::: "memory");
      { unsigned char* Og = (unsigned char*)(T.Amix + (rowbase + q0 + wid * 32) * 1024 + 512 + h * 128) + (size_t)(lane_e >> 4) * 2048 + (lane_e & 15) * 16; asm volatile("" : "+v"(Og));
#pragma unroll
        for (int i = 0; i < 8; ++i) { const u32x4 v = *(const LAS u32x4*)(((i < 4) ? st0 : st1) + (lane_e + 64 * (i & 3)) * 16);
          *(u32x4*)(Og + (size_t)(4 * i) * 2048) = v; } }
      LDS_WAIT(); asm volatile("" ::: "memory"); }
    __syncthreads();
}
#undef SBAR
#undef PKV
}

__device__ __forceinline__ void tr_item(const float* W, int ldw, bf16_t* WT, int ldt, LAS float* scr, int lane) {
    float tv[32]; const float* wb = W + (size_t)(lane >> 5) * ldw + (lane & 31);
#pragma unroll
    for (int i = 0; i < 32; ++i) tv[i] = wb[(size_t)(2 * i) * ldw];
#pragma unroll
    for (int i = 0; i < 32; ++i) scr[(2 * i + (lane >> 5)) * 33 + (lane & 31)] = tv[i];
    LDS_WAIT(); asm volatile("" ::: "memory");
    const int c = lane & 7;
#pragma unroll
    for (int j = 0; j < 4; ++j) { const int n = (lane >> 3) + 8 * j; const LAS float* s = scr + (8 * c) * 33 + n;
        u32x4 o; o.x = cvt_pk_bf16(s[0 * 33], s[1 * 33]); o.y = cvt_pk_bf16(s[2 * 33], s[3 * 33]); o.z = cvt_pk_bf16(s[4 * 33], s[5 * 33]); o.w = cvt_pk_bf16(s[6 * 33], s[7 * 33]);
        *(u32x4*)(WT + (size_t)n * ldt + 8 * c) = o; }
    LDS_WAIT(); asm volatile("" ::: "memory");
}
__device__ __forceinline__ bf16x8 pack8v(f32x4 a, f32x4 b) { const u32x4 w = {att::cvt_pk_s(a[0], a[1]), att::cvt_pk_s(a[2], a[3]), att::cvt_pk_s(b[0], b[1]), att::cvt_pk_s(b[2], b[3])}; return __builtin_bit_cast(bf16x8, w); }
__device__ __forceinline__ void tr_item_fp8(const float* W, int ldw, unsigned char* WT, int ldt, LAS float* scr, int lane) {
    float tv[32]; const float* wb = W + (size_t)(lane >> 5) * ldw + (lane & 31);
#pragma unroll
    for (int i = 0; i < 32; ++i) tv[i] = wb[(size_t)(2 * i) * ldw];
#pragma unroll
    for (int i = 0; i < 32; ++i) scr[(2 * i + (lane >> 5)) * 33 + (lane & 31)] = tv[i];
    LDS_WAIT(); asm volatile("" ::: "memory");
    const int n = lane & 31, kh = (lane >> 5) * 32; const LAS float* s = scr + kh * 33 + n;
#pragma unroll
    for (int q = 0; q < 2; ++q) { u32x4 o;
        o.x = cvt_pk4_fp8(64.f * s[(16 * q + 0) * 33], 64.f * s[(16 * q + 1) * 33], 64.f * s[(16 * q + 2) * 33], 64.f * s[(16 * q + 3) * 33]);
        o.y = cvt_pk4_fp8(64.f * s[(16 * q + 4) * 33], 64.f * s[(16 * q + 5) * 33], 64.f * s[(16 * q + 6) * 33], 64.f * s[(16 * q + 7) * 33]);
        o.z = cvt_pk4_fp8(64.f * s[(16 * q + 8) * 33], 64.f * s[(16 * q + 9) * 33], 64.f * s[(16 * q + 10) * 33], 64.f * s[(16 * q + 11) * 33]);
        o.w = cvt_pk4_fp8(64.f * s[(16 * q + 12) * 33], 64.f * s[(16 * q + 13) * 33], 64.f * s[(16 * q + 14) * 33], 64.f * s[(16 * q + 15) * 33]);
        *(u32x4*)(WT + (size_t)n * ldt + kh + 16 * q) = o; }
    LDS_WAIT(); asm volatile("" ::: "memory");
}
__device__ __forceinline__ int qk_logical(int p) { return 64 * ((p >> 5) & 3) + 32 * (p >> 7) + (p & 31); }

__device__ __forceinline__ int t5_bucket_idx(int rel) {
    const int ret = rel > 0 ? 16 : 0; const int n = rel < 0 ? -rel : rel;
    const float nf = (float)(n < 1 ? 1 : n);
    int large = 8 + (int)(logf(nf / 8.0f) / logf(16.0f) * 8.0f); large = large < 15 ? large : 15;
    if (n == 16) large = 10; if (n == 32) large = 12; if (n == 64) large = 14;
    return ret + (n < 8 ? n : large);
}

constexpr int P0_SCR = 16640;
constexpr int P0_CTAB = 8 * P0_SCR;
__device__ __forceinline__ float cos4096(const LAS float* tab, int m) { m &= 4095; if (m > 2048) m = 4096 - m; return (m <= 1024) ? tab[m] : -tab[2048 - m]; }
#define P0_WLOAD(v, r) do { const float* src_; int ld_; { int rr_ = (r); if (rr_ < I_W2) { const int e = rr_ >> 8, kc = (rr_ >> 4) & 15, nc = rr_ & 15; src_ = F.w2 + (size_t)e * 1048576 + (size_t)(kc * 64) * 1024 + nc * 64 + lane; ld_ = 1024; } \
        else { rr_ -= I_W2; const int e = rr_ >> 9, kc = (rr_ >> 5) & 15, nc = rr_ & 31; src_ = F.w1 + (size_t)e * 2097152 + (size_t)(kc * 64) * 2048 + nc * 64 + lane; ld_ = 2048; } } \
        _Pragma("unroll") for (int kk = 0; kk < 64; ++kk) v[kk] = __builtin_nontemporal_load(src_ + (size_t)kk * ld_); } while (0)
#define P0_WPROC(v, r) do { unsigned char* dst_; int nl_; float ws_ = 64.f; { int rr_ = (r); if (rr_ < I_W2) { const int e = rr_ >> 8, kc = (rr_ >> 4) & 15, nc = rr_ & 15; nl_ = lane; dst_ = wsp<unsigned char>(F, WS_W2) + (size_t)e * 1048576 + (size_t)(nc * 64 + lane) * 1024 + kc * 64; } \
        else { rr_ -= I_W2; const int e = rr_ >> 9, kc = (rr_ >> 5) & 15, nc = rr_ & 31, pn = nc >> 2, p0 = 32 * (nc & 3); nl_ = (lane < 32) ? 2 * lane : 2 * (lane - 32) + 1; ws_ = (lane < 32) ? 64.f * SWG_C : 64.f / SWG_C;     \
               dst_ = wsp<unsigned char>(F, WS_W1) + (size_t)e * 2097152 + (size_t)(pn * 256 + ((lane < 32) ? (p0 + lane) : (128 + p0 + lane - 32))) * 1024 + kc * 64; } } \
        _Pragma("unroll") for (int kk = 0; kk < 64; ++kk) scr[kk * 65 + lane] = v[kk]; \
        LDS_WAIT(); asm volatile("" ::: "memory"); \
        _Pragma("unroll") for (int q = 0; q < 4; ++q) { const LAS float* s_ = scr + (16 * q) * 65 + nl_; u32x4 o_; \
            o_.x = cvt_pk4_fp8(ws_ * s_[0], ws_ * s_[65], ws_ * s_[130], ws_ * s_[195]); o_.y = cvt_pk4_fp8(ws_ * s_[260], ws_ * s_[325], ws_ * s_[390], ws_ * s_[455]); \
            o_.z = cvt_pk4_fp8(ws_ * s_[520], ws_ * s_[585], ws_ * s_[650], ws_ * s_[715]); o_.w = cvt_pk4_fp8(ws_ * s_[780], ws_ * s_[845], ws_ * s_[910], ws_ * s_[975]); \
            *(u32x4*)(dst_ + 16 * q) = o_; } \
        LDS_WAIT(); asm volatile("" ::: "memory"); } while (0)
__device__ __forceinline__ void p0_prologue(Frame& F, const int skip) {
    LAS float* scr = (LAS float*)(F.lds + F.wave * P0_SCR);
    LAS float* ctab = (LAS float*)(F.lds + P0_CTAB);
    for (int m = F.tid(); m < 1025; m += 512) ctab[m] = cospif((float)m * (1.0f / 2048.0f));
    __syncthreads();
    const int NGW = F.G * NWAVES, lane = F.lane();
    const int gw = F.wave * F.G + F.vcu;
    constexpr int I_MOD = 96, I_QKV = 16 * 48, I_WOUT = 8 * 32, I_FCS = 256, I_FOUT = 256, I_ADFT = 4096, I_MISC = 65;
    constexpr int NITEMS = I_MOD + I_QKV + I_WOUT + I_FCS + I_FOUT + I_MISC + I_ADFT;
    constexpr int I_W2 = 32 * 16 * 16, I_W1 = 32 * 16 * 32, NW12 = I_W2 + I_W1;
    float* mod = wsp<float>(F, WS_MOD);
    const int lane0 = lane;
    const bool coop = (F.G >= I_MOD);
    if (coop && !(skip & 16) && F.vcu < I_MOD) {
        const int col = F.vcu * 64 + lane; float acc[8];
#pragma unroll
        for (int b = 0; b < 8; ++b) acc[b] = 0.f;
#pragma unroll 1
        for (int kc = 2 * F.wave; kc < 2 * F.wave + 2; ++kc) {
            float wv[64]; int ln = lane; asm volatile("" : "+v"(ln));
            const float* wb = F.w_ada + (size_t)(kc * 64) * 6144 + F.vcu * 64 + ln;
#pragma unroll
            for (int kk = 0; kk < 64; ++kk) wv[kk] = __builtin_nontemporal_load(wb + (size_t)kk * 6144);
#pragma unroll
            for (int b = 0; b < 8; ++b) { const float cv = F.c[b * 1024 + kc * 64 + ln]; scr[ln * 8 + b] = cv / (1.0f + __expf(-cv)); }
            LDS_WAIT(); asm volatile("" ::: "memory");
#pragma unroll
            for (int kk = 0; kk < 64; ++kk) { const float w = wv[kk];
                const f32x4 s0 = *(const LAS f32x4*)(scr + kk * 8), s1 = *(const LAS f32x4*)(scr + kk * 8 + 4);
                acc[0] += s0[0] * w; acc[1] += s0[1] * w; acc[2] += s0[2] * w; acc[3] += s0[3] * w; acc[4] += s1[0] * w; acc[5] += s1[1] * w; acc[6] += s1[2] * w; acc[7] += s1[3] * w; }
            LDS_WAIT(); asm volatile("" ::: "memory");
        }
#pragma unroll
        for (int b = 0; b < 8; ++b) scr[b * 64 + lane] = acc[b];
        __syncthreads();
        { const int t_ = F.tid(), b_ = t_ >> 6, c_ = t_ & 63; float sum = F.b_ada[F.vcu * 64 + c_];
#pragma unroll
          for (int w = 0; w < 8; ++w) sum += ((const LAS float*)(F.lds + w * P0_SCR))[b_ * 64 + c_];
          mod[b_ * 6144 + F.vcu * 64 + c_] = sum; }
        __syncthreads();
    }
    const int it0 = coop ? I_MOD : 0;
    if (!(skip & 16)) for (int it = gw + it0; it < NITEMS; it += NGW) {
        int r = it;
        int lane = lane0; asm volatile("" : "+v"(lane));
        if (r < I_MOD) {
            const int col = r * 64 + lane; float acc[8];
#pragma unroll
            for (int b = 0; b < 8; ++b) acc[b] = 0.f;
            for (int kc = 0; kc < 16; ++kc) {
                float wv[64];
#pragma unroll
                for (int kk = 0; kk < 64; ++kk) wv[kk] = __builtin_nontemporal_load(F.w_ada + (size_t)(kc * 64 + kk) * 6144 + col);
#pragma unroll
                for (int b = 0; b < 8; ++b) { const float cv = F.c[b * 1024 + kc * 64 + lane]; scr[lane * 8 + b] = cv / (1.0f + __expf(-cv)); }
                LDS_WAIT(); asm volatile("" ::: "memory");
#pragma unroll
                for (int kk = 0; kk < 64; ++kk) { const float w = wv[kk];
                    const f32x4 s0 = *(const LAS f32x4*)(scr + kk * 8), s1 = *(const LAS f32x4*)(scr + kk * 8 + 4);
                    acc[0] += s0[0] * w; acc[1] += s0[1] * w; acc[2] += s0[2] * w; acc[3] += s0[3] * w; acc[4] += s1[0] * w; acc[5] += s1[1] * w; acc[6] += s1[2] * w; acc[7] += s1[3] * w; }
                LDS_WAIT(); asm volatile("" ::: "memory");
            }
            const float bb = F.b_ada[col];
#pragma unroll
            for (int b = 0; b < 8; ++b) mod[b * 6144 + col] = acc[b] + bb;
            continue; }
        r -= I_MOD;
        if (r < I_QKV) {
            const int kb = r / 48, nb = r % 48, prow = nb * 32, tile = prow >> 8, p = prow & 255;
            const int lcol = 512 + tile * 256 + p;
            tr_item_fp8(F.w_in + (size_t)(kb * 64) * 2048 + lcol, 2048, wsp<unsigned char>(F, WS_WQKV) + (size_t)prow * 1024 + kb * 64, 1024, scr, lane);
            continue; }
        r -= I_QKV;
        if (r < I_WOUT) {
            const int kb = r / 32, nb = r % 32;
            tr_item(F.w_out + (size_t)(512 + kb * 64) * 1024 + nb * 32, 1024, wsp<bf16_t>(F, WS_WOUT) + (size_t)(nb * 32) * 1024 + 512 + kb * 64, 1024, scr, lane);
            continue; }
        r -= I_WOUT;
        if (r < I_FCS) {
            const int g = r >> 6, d0 = (r & 63) * 16, m = lane & 15, g4 = lane >> 4;
            LAS float* t128 = scr;
            t128[lane] = cos4096(ctab, lane * 32); t128[64 + lane] = cos4096(ctab, (64 + lane) * 32); t128[128 + lane] = cos4096(ctab, lane * 32); t128[192 + lane] = cos4096(ctab, (64 + lane) * 32);
            bf16x8 bw[4];
#pragma unroll
            for (int ks = 0; ks < 4; ++ks) { const float* p = F.w_in + (size_t)(d0 + m) * 2048 + g * 128 + ks * 32 + g4 * 8; bw[ks] = pack8v(*(const f32x4*)p, *(const f32x4*)(p + 4)); }
            LDS_WAIT(); asm volatile("" ::: "memory");
            const float sc = 0.08838834764831845f;
            bf16_t* wc = wsp<bf16_t>(F, WS_WCS);
#pragma unroll 1
            for (int mb = 0; mb < 16; ++mb) { const int kc = (mb & 7) * 16 + m; const LAS float* tb = t128 + ((mb >> 3) ? 96 : 0);
                f32x4 acc = {0.f, 0.f, 0.f, 0.f};
#pragma unroll
                for (int ks = 0; ks < 4; ++ks) { float v[8];
#pragma unroll
                    for (int j = 0; j < 8; ++j) v[j] = tb[((ks * 32 + g4 * 8 + j) * kc) & 127];
                    const bf16x8 a = pack8v((f32x4){v[0], v[1], v[2], v[3]}, (f32x4){v[4], v[5], v[6], v[7]});
                    acc = __builtin_amdgcn_mfma_f32_16x16x32_bf16(a, bw[ks], acc, 0, 0, 0); }
                const float sg = (mb >> 3) ? -sc : sc;
#pragma unroll
                for (int i = 0; i < 4; ++i) { const int n = (mb >> 3) * 512 + g * 128 + (mb & 7) * 16 + g4 * 4 + i;
                    wc[(size_t)n * 1024 + d0 + m] = (bf16_t)(cvt_pk_bf16(acc[i] * sg, 0.f) & 0xffffu); } }
            LDS_WAIT(); asm volatile("" ::: "memory");
            continue; }
        r -= I_FCS;
        if (r < I_FOUT) {
            const int g = r >> 6, dout0 = (r & 63) * 16, m = lane & 15, g4 = lane >> 4;
            bf16x8 bo[4];
#pragma unroll
            for (int ks = 0; ks < 4; ++ks) { const float* p = F.w_out + (size_t)(g * 128 + ks * 32 + g4 * 8) * 1024 + dout0 + m; float v[8];
#pragma unroll
                for (int j = 0; j < 8; ++j) v[j] = p[(size_t)j * 1024];
                bo[ks] = pack8v((f32x4){v[0], v[1], v[2], v[3]}, (f32x4){v[4], v[5], v[6], v[7]}); }
            bf16_t* dst = wsp<bf16_t>(F, WS_WOUT) + (size_t)(dout0 + m) * 1024 + g * 128 + g4 * 4;
#pragma unroll 2
            for (int mb = 0; mb < 8; ++mb) { const float* p = F.w_fourier + (size_t)(g * 128 + mb * 16 + m) * 128 + g4 * 8;
                f32x4 acc = {0.f, 0.f, 0.f, 0.f};
#pragma unroll
                for (int ks = 0; ks < 4; ++ks) { const bf16x8 a = pack8v(*(const f32x4*)(p + ks * 32), *(const f32x4*)(p + ks * 32 + 4));
                    acc = __builtin_amdgcn_mfma_f32_16x16x32_bf16(a, bo[ks], acc, 0, 0, 0); }
                u32x2 o; o.x = att::cvt_pk_s(acc[0], acc[1]); o.y = att::cvt_pk_s(acc[2], acc[3]);
                *(u32x2*)(dst + mb * 16) = o; }
            continue; }
        r -= I_FOUT;
        if (r < I_MISC) {
            if (r == 0) { float* bt = wsp<float>(F, WS_BTAB);
                for (int i = lane; i < 4 * 256; i += 64) { const int h = i >> 8, ri = i & 255; const int rel = (ri > 254 ? 254 : ri) - 127; bt[i] = F.rel_bias[t5_bucket_idx(rel) * 4 + h] * LOG2E; } }
            else { float* bp = wsp<float>(F, WS_B1P); const int base = (r - 1) * 1024;
                for (int i = lane; i < 1024; i += 64) { const int idx = base + i, e = idx >> 11, pc = idx & 2047, pn = pc >> 8, p = pc & 255;
                    const float bv_ = F.b1[e * 2048 + pn * 256 + (p < 128 ? 2 * p : 2 * (p - 128) + 1)]; bp[idx] = (p < 128) ? SWG_C * bv_ : (bv_ + 1.0f) / SWG_C; } }
            continue; }
        r -= I_MISC;
        {
            const int k = r; unsigned char* row = wsp<unsigned char>(F, WS_ADFT) + (size_t)k * 4096;
#pragma unroll
            for (int ch = 0; ch < 4; ++ch) { const int j0 = ch * 1024 + lane * 16; float v[16];
#pragma unroll
                for (int e = 0; e < 16; ++e) { const int j = j0 + e;
                    if (ch < 2) v[e] = __builtin_amdgcn_cosf((float)((k * j) & 4095) * (1.0f / 4096.0f));
                    else { const float sv = __builtin_amdgcn_sinf((float)((k * (j - 2048)) & 4095) * (1.0f / 4096.0f)); v[e] = (j == 2048) ? ((k & 1) ? -1.0f : 1.0f) : sv; } }
                u32x4 o; o.x = cvt_pk4_fp8(v[0], v[1], v[2], v[3]); o.y = cvt_pk4_fp8(v[4], v[5], v[6], v[7]); o.z = cvt_pk4_fp8(v[8], v[9], v[10], v[11]); o.w = cvt_pk4_fp8(v[12], v[13], v[14], v[15]);
                *(u32x4*)(row + j0) = o; }
        }
    }
    if (!(skip & 8) && F.G != 256) {
        constexpr int NHEAVY = I_MOD, HQ = 5;
        const bool heavy = (F.G == 256) && (gw < I_MOD);
        int r, stride, rend;
        if (F.G != 256) { r = gw; stride = NGW; rend = NW12; }
        else if (heavy) { r = gw; stride = NHEAVY; rend = NHEAVY * HQ; }
        else { r = NHEAVY * HQ + (gw - NHEAVY); stride = 2048 - NHEAVY; rend = NW12; }
        float va[64], vb[64];
        if (r < rend) P0_WLOAD(va, r);
        for (; r < rend; r += 2 * stride) {
            const int r1 = r + stride, r2 = r1 + stride;
            if (r1 < rend) P0_WLOAD(vb, r1);
            P0_WPROC(va, r);
            if (r2 < rend) P0_WLOAD(va, r2);
            if (r1 < rend) P0_WPROC(vb, r1);
        }
    }
}
#undef P0_WLOAD
#undef P0_WPROC

__device__ __forceinline__ void load_row(const float* xrow, int lane, f32x4 (&h)[4]) {
#pragma unroll
    for (int j = 0; j < 4; ++j) h[j] = *((const f32x4*)xrow + lane + 64 * j);
}
__device__ __forceinline__ void load_row_bf16(const bf16_t* xrow, int lane, f32x4 (&h)[4]) {
#pragma unroll
    for (int j = 0; j < 4; ++j) { const u32x2 w = *((const u32x2*)xrow + lane + 64 * j); h[j] = (f32x4){__uint_as_float(w.x << 16), __uint_as_float(w.x & 0xffff0000u), __uint_as_float(w.y << 16), __uint_as_float(w.y & 0xffff0000u)}; }
}
__device__ __forceinline__ void norm_row(const float* g, const float* sh, const float* sc, int lane, f32x4 (&h)[4]) {
    float s = 0.f;
#pragma unroll
    for (int j = 0; j < 4; ++j) s += (h[j][0] * h[j][0] + h[j][1] * h[j][1]) + (h[j][2] * h[j][2] + h[j][3] * h[j][3]);
    const float rr = rsqrtf(wave_sum(s) * (1.0f / 1024.0f) + EPS);
#pragma unroll
    for (int j = 0; j < 4; ++j) { const f32x4 gv = *((const f32x4*)g + lane + 64 * j), sv = *((const f32x4*)sc + lane + 64 * j), hv = *((const f32x4*)sh + lane + 64 * j);
        h[j] = h[j] * rr * gv * (sv + 1.0f) + hv; }
}
__device__ __forceinline__ void store_row_fp8(unsigned char* row, int lane, const f32x4 (&h)[4]) {
#pragma unroll
    for (int j = 0; j < 4; ++j) *((unsigned*)row + lane + 64 * j) = cvt_pk4_fp8(h[j][0], h[j][1], h[j][2], h[j][3]);
}
__device__ __forceinline__ void store_row_bf16(bf16_t* row, int lane, const f32x4 (&h)[4]) {
#pragma unroll
    for (int j = 0; j < 4; ++j) { u32x2 w; w.x = cvt_pk_bf16(h[j][0], h[j][1]); w.y = cvt_pk_bf16(h[j][2], h[j][3]); *((u32x2*)row + lane + 64 * j) = w; }
}
constexpr int P1_GEMV = 512, P1_NITEMS = P1_GEMV + NB * (HSEQ + 1);
__device__ __forceinline__ void p1_decode(int w, int& b, int& j) { if (w < P1_GEMV) { b = w >> 6; j = HSEQ; } else { w -= P1_GEMV; b = w / (HSEQ + 1); j = w % (HSEQ + 1); } }
__device__ __forceinline__ void p1_rows(Frame& F) {
    const int gw = F.vcu * NWAVES + F.wave, NGW = F.G * NWAVES, lane = F.lane();
    const float* mod = wsp<float>(F, WS_MOD);
    bf16_t* XN = wsp<bf16_t>(F, WS_XN); bf16_t* XS = wsp<bf16_t>(F, WS_XNSA); bf16_t* XA = XS + (size_t)NB * HSEQ * 1024;
    f32x4 h0[4], h1[4], n0[4], n1[4];
    int w = gw;
    if (w < P1_NITEMS) { int b, j; p1_decode(w, b, j); load_row(F.x + ((size_t)b * SEQ + j) * 1024, lane, h0); load_row(F.x + ((size_t)b * SEQ + ((SEQ - j) & (SEQ - 1))) * 1024, lane, h1); }
    for (; w < P1_NITEMS; w += NGW) {
        const int wn = w + NGW;
        if (wn < P1_NITEMS) { int b, j; p1_decode(wn, b, j); load_row(F.x + ((size_t)b * SEQ + j) * 1024, lane, n0); load_row(F.x + ((size_t)b * SEQ + ((SEQ - j) & (SEQ - 1))) * 1024, lane, n1); }
        int b, j; p1_decode(w, b, j);
        const float* sh = mod + b * 6144; const float* sc = sh + 1024;
        norm_row(F.g_mix, sh, sc, lane, h0);
        if (w < P1_GEMV) {
            const int nb = (w & 63) * 8; const bf16_t* wc = wsp<bf16_t>(F, WS_WCS) + (size_t)nb * 1024; float* vr = wsp<float>(F, WS_VR);
            float sacc[8];
#pragma unroll
            for (int n = 0; n < 8; ++n) { float sv = 0.f;
#pragma unroll
                for (int q = 0; q < 4; ++q) { const u32x2 wv = *((const u32x2*)(wc + (size_t)n * 1024) + lane + 64 * q);
                    sv += h0[q][0] * __uint_as_float(wv.x << 16) + h0[q][1] * __uint_as_float(wv.x & 0xffff0000u) + h0[q][2] * __uint_as_float(wv.y << 16) + h0[q][3] * __uint_as_float(wv.y & 0xffff0000u); }
                sacc[n] = sv; }
#pragma unroll
            for (int n = 0; n < 8; ++n) { const float t = wave_sum(sacc[n]); if (lane == 0) vr[b * 512 + nb + n] = t; }
        } else {
            store_row_fp8((unsigned char*)XN + ((size_t)b * SEQ + j) * 1024, lane, h0);
            if (j == 0) {
                store_row_bf16(XS + ((size_t)b * HSEQ) * 1024, lane, h0);
                f32x4 z[4];
#pragma unroll
                for (int q = 0; q < 4; ++q) z[q] = (f32x4){0.f, 0.f, 0.f, 0.f};
                store_row_bf16(XA + ((size_t)b * HSEQ) * 1024, lane, z);
            } else if (j != HSEQ) {
                f32x4 t[4];
                norm_row(F.g_mix, sh, sc, lane, h1);
                store_row_fp8((unsigned char*)XN + ((size_t)b * SEQ + (SEQ - j)) * 1024, lane, h1);
#pragma unroll
                for (int q = 0; q < 4; ++q) t[q] = h0[q] + h1[q];
                store_row_bf16(XS + ((size_t)b * HSEQ + j) * 1024, lane, t);
#pragma unroll
                for (int q = 0; q < 4; ++q) t[q] = h0[q] - h1[q];
                store_row_bf16(XA + ((size_t)b * HSEQ + j) * 1024, lane, t);
            }
        }
#pragma unroll
        for (int q = 0; q < 4; ++q) { h0[q] = n0[q]; h1[q] = n1[q]; }
    }
}

__device__ __forceinline__ void moe_tables(Frame& F) {
    LAS int* cnt = (LAS int*)(F.lds + SP_CNT); LAS int* tstart = (LAS int*)(F.lds + SP_TSTART); LAS unsigned char* tile_e = F.lds + SP_TILEE;
    int tid = F.tid(); asm volatile("" : "+v"(tid));
    __syncthreads();
    if (tid < 32) cnt[tid] = (int)__hip_atomic_load(F.ctl + CW_GCNT + 64 * tid, RLX_AGENT);
    __syncthreads();
    if (tid == 0) { int s = 0; for (int e = 0; e < 32; ++e) { tstart[e] = s; s += (cnt[e] + 255) >> 8; } tstart[32] = s; tstart[33] = s; }
    __syncthreads();
    const int total = tstart[32];
    for (int pm = tid; pm < total; pm += 512) { int e = 0;
        for (int q = 1; q < 32; ++q) e += (pm >= tstart[q]) ? 1 : 0;
        tile_e[pm] = (unsigned char)e; }
    __syncthreads();
}

constexpr int SP_LCNT = SP_OFF + 5120, SP_LBASE = SP_OFF + 5376, SP_STASH = SP_OFF + 6144;
constexpr int P5_HI = 0, P5_LO = 65536, P5_GM = 131072, P5_SH = 135168, P5_BP = 139264, P5_BIAS = 141312;
__device__ __forceinline__ void p5_router(Frame& F) {
    const int lane = F.lane(), tid = F.tid();
    const int trow0 = F.vcu * 128 + F.wave * 16, bq = trow0 >> 12;
    const int m = lane & 15, g = lane >> 4;
    const bf16_t* X1 = wsp<bf16_t>(F, WS_X1);
    u32x4 xv[16][2];
    { const u32x4* xr = (const u32x4*)(X1 + (size_t)(trow0 + m) * 1024 + g * 16);
#pragma unroll
      for (int s = 0; s < 16; ++s) { xv[s][0] = xr[s * 8]; xv[s][1] = xr[s * 8 + 1]; } }
    const float* mod = wsp<float>(F, WS_MOD);
    const float* shf = mod + bq * 6144 + 3072; const float* scf = mod + bq * 6144 + 4096;
    LAS float* gm = (LAS float*)(F.lds + P5_GM); LAS float* sh = (LAS float*)(F.lds + P5_SH); LAS float* bpart = (LAS float*)(F.lds + P5_BP); LAS float* bias = (LAS float*)(F.lds + P5_BIAS);
    LAS int* lcnt = (LAS int*)(F.lds + SP_LCNT); LAS int* lbase = (LAS int*)(F.lds + SP_LBASE); LAS int* stash = (LAS int*)(F.lds + SP_STASH);
    for (int k = tid; k < 1024; k += 512) { gm[k] = F.g_ffn[k] * (1.0f + scf[k]); sh[k] = shf[k]; }
    if (tid < 32) lcnt[tid] = 0;
    __syncthreads();
    { const int e = tid & 31; float bp = 0.f;
#pragma unroll 1
      for (int it = 0; it < 8; ++it) { const int c = (tid >> 5) + 16 * it; float w[8];
#pragma unroll
          for (int j = 0; j < 8; ++j) w[j] = F.w_router[(size_t)(c * 8 + j) * 32 + e];
          const f32x4 g0 = *(const LAS f32x4*)(gm + c * 8), g1 = *(const LAS f32x4*)(gm + c * 8 + 4), s0 = *(const LAS f32x4*)(sh + c * 8), s1 = *(const LAS f32x4*)(sh + c * 8 + 4);
          u32x4 hi, lo;
#pragma unroll
          for (int p = 0; p < 4; ++p) { const f32x4 gq = (p < 2) ? g0 : g1, sq = (p < 2) ? s0 : s1; const float ga = gq[(2 * p) & 3], gb = gq[(2 * p + 1) & 3], sa = sq[(2 * p) & 3], sb = sq[(2 * p + 1) & 3];
              const float a = w[2 * p] * ga, b2 = w[2 * p + 1] * gb; const unsigned hh = cvt_pk_bf16(a, b2);
              hi[p] = hh; lo[p] = cvt_pk_bf16(a - __uint_as_float(hh << 16), b2 - __uint_as_float(hh & 0xffff0000u));
              bp += w[2 * p] * sa + w[2 * p + 1] * sb; }
          *(LAS u32x4*)(F.lds + P5_HI + (c * 32 + e) * 16) = hi; *(LAS u32x4*)(F.lds + P5_LO + (c * 32 + e) * 16) = lo; }
      bpart[(tid >> 5) * 32 + e] = bp; }
    __syncthreads();
    if (tid < 32) { float sb = F.b_router[tid];
#pragma unroll
        for (int q = 0; q < 16; ++q) sb += bpart[q * 32 + tid];
        bias[tid] = sb; }
    __syncthreads();
    f32x4 ah0 = {0.f, 0.f, 0.f, 0.f}, ah1 = ah0, al0 = ah0, al1 = ah0; float ss = 0.f;
    { const LAS unsigned char* tb = F.lds + g * 1024 + m * 16;
#pragma unroll
      for (int s = 0; s < 16; ++s) {
#pragma unroll
          for (int h = 0; h < 2; ++h) { const bf16x8 xb = __builtin_bit_cast(bf16x8, xv[s][h]); const LAS unsigned char* p = tb + s * 4096 + h * 512; asm volatile("" : "+v"(p));
              const bf16x8 wh0 = *(const LAS bf16x8*)(p + P5_HI), wh1 = *(const LAS bf16x8*)(p + P5_HI + 256), wl0 = *(const LAS bf16x8*)(p + P5_LO), wl1 = *(const LAS bf16x8*)(p + P5_LO + 256);
              ah0 = __builtin_amdgcn_mfma_f32_16x16x32_bf16(wh0, xb, ah0, 0, 0, 0); ah1 = __builtin_amdgcn_mfma_f32_16x16x32_bf16(wh1, xb, ah1, 0, 0, 0);
              al0 = __builtin_amdgcn_mfma_f32_16x16x32_bf16(wl0, xb, al0, 0, 0, 0); al1 = __builtin_amdgcn_mfma_f32_16x16x32_bf16(wl1, xb, al1, 0, 0, 0);
#pragma unroll
              for (int q = 0; q < 4; ++q) { const unsigned wv = xv[s][h][q]; const float lo_ = __uint_as_float(wv << 16), hi_ = __uint_as_float(wv & 0xffff0000u); ss += lo_ * lo_ + hi_ * hi_; } } } }
    ss += __shfl_xor(ss, 16); ss += __shfl_xor(ss, 32);
    const float rinv = rsqrtf(ss * (1.0f / 1024.0f) + EPS);
    { unsigned char* xo = wsp<unsigned char>(F, WS_XN2) + (size_t)(trow0 + m) * 1024 + g * 16;
#pragma unroll
      for (int s = 0; s < 16; ++s) { const LAS f32x4* gp = (const LAS f32x4*)(gm + s * 64 + g * 16); const LAS f32x4* sp = (const LAS f32x4*)(sh + s * 64 + g * 16); asm volatile("" : "+v"(gp), "+v"(sp)); u32x4 o; u32x4 xq[2] = {xv[s][0], xv[s][1]}; asm volatile("" : "+v"(xq[0]), "+v"(xq[1]));
#pragma unroll
          for (int q = 0; q < 4; ++q) { const f32x4 gv = gp[q], sv = sp[q]; const unsigned w0 = xq[q >> 1][(q & 1) * 2], w1 = xq[q >> 1][(q & 1) * 2 + 1];
              o[q] = cvt_pk4_fp8(__uint_as_float(w0 << 16) * rinv * gv[0] + sv[0], __uint_as_float(w0 & 0xffff0000u) * rinv * gv[1] + sv[1],
                                 __uint_as_float(w1 << 16) * rinv * gv[2] + sv[2], __uint_as_float(w1 & 0xffff0000u) * rinv * gv[3] + sv[3]); }
          *(u32x4*)(xo + s * 64) = o; } }
    float vals[8];
    { const f32x4 b0 = *(const LAS f32x4*)(bias + g * 4), b1 = *(const LAS f32x4*)(bias + 16 + g * 4);
#pragma unroll
      for (int j = 0; j < 4; ++j) { vals[j] = (ah0[j] + al0[j]) * rinv + b0[j]; vals[4 + j] = (ah1[j] + al1[j]) * rinv + b1[j]; } }
    float tv[4]; int tx[4];
#pragma unroll
    for (int t = 0; t < 4; ++t) { float bv = vals[0]; int be = g * 4;
#pragma unroll
        for (int j = 1; j < 8; ++j) { const bool take = vals[j] > bv; bv = take ? vals[j] : bv; be = take ? ((j >> 2) * 16 + g * 4 + (j & 3)) : be; }
#pragma unroll
        for (int o = 16; o < 64; o <<= 1) { const float ov = __shfl_xor(bv, o); const int oe = __shfl_xor(be, o); const bool take = (ov > bv) || (ov == bv && oe < be); bv = take ? ov : bv; be = take ? oe : be; }
        tv[t] = bv; tx[t] = be;
#pragma unroll
        for (int j = 0; j < 8; ++j) vals[j] = (be == (j >> 2) * 16 + g * 4 + (j & 3)) ? -INFINITY : vals[j]; }
    { const float e1 = __expf(tv[1] - tv[0]), e2 = __expf(tv[2] - tv[0]), e3 = __expf(tv[3] - tv[0]); const float inv = 1.0f / (1.0f + e1 + e2 + e3);
      const int e = (g == 0) ? tx[0] : (g == 1) ? tx[1] : (g == 2) ? tx[2] : tx[3];
      const float gk = ((g == 0) ? 1.0f : (g == 1) ? e1 : (g == 2) ? e2 : e3) * inv;
      const int lr = atomicAdd((int*)(lcnt + e), 1);
      const int si = ((F.wave * 16 + m) * 4 + g) * 4; stash[si] = (trow0 + m) * 4 + g; stash[si + 1] = e; stash[si + 2] = lr; stash[si + 3] = __float_as_int(gk); }
    __syncthreads();
    if (tid < 32) lbase[tid] = (int)__hip_atomic_fetch_add(F.ctl + CW_GCNT + 64 * tid, (unsigned)lcnt[tid], RLX_AGENT);
    __syncthreads();
    { const int si = tid * 4; const int tk = stash[si], e = stash[si + 1], slot = lbase[e] + stash[si + 2];
      wsp<unsigned>(F, WS_SLOTTOK)[(size_t)e * CAP + slot] = (unsigned)(tk >> 2);
      wsp<int>(F, WS_SLOTGATE)[(size_t)e * CAP + slot] = stash[si + 3];
      wsp<unsigned>(F, WS_TOKSLOT)[tk] = (unsigned)(e * CAP + slot); }
}

__device__ __forceinline__ void p8_combine(Frame& F) {
    const int lane = F.lane(); const LAS int* tstart = (const LAS int*)(F.lds + SP_TSTART);
    const float* mod = wsp<float>(F, WS_MOD); const bf16_t* slab = wsp<bf16_t>(F, WS_SLAB); const unsigned* ts = wsp<unsigned>(F, WS_TOKSLOT);
    const int trow0 = F.vcu * 128 + F.wave * 16, b = trow0 >> 12;
    int myrow[4];
    { const u32x4 sl = *(const u32x4*)(ts + (size_t)(trow0 + (lane & 15)) * 4);
#pragma unroll
      for (int k = 0; k < 4; ++k) { const unsigned v = sl[k]; myrow[k] = tstart[v >> 15] * 256 + (int)(v & 32767u); } }
    f32x4 gt[4];
#pragma unroll
    for (int j = 0; j < 4; ++j) gt[j] = *((const f32x4*)(mod + b * 6144 + 5120) + lane + 64 * j) * (1.0f / 16.0f);
#define P8_LOAD(rl, SV, XV) do { _Pragma("unroll") for (int k = 0; k < 4; ++k) { const size_t ar = (size_t)__shfl(myrow[k], (rl)) * 1024; \
        _Pragma("unroll") for (int j = 0; j < 4; ++j) SV[k][j] = *((const unsigned*)((const unsigned char*)slab + ar) + lane + 64 * j); } \
        _Pragma("unroll") for (int j = 0; j < 4; ++j) XV[j] = *((const u32x2*)(X1 + (size_t)(trow0 + (rl)) * 1024) + lane + 64 * j); } while (0)
#define P8_PROC(rl, SV, XV) do { _Pragma("unroll") for (int j = 0; j < 4; ++j) { f32x4 s = (f32x4){0.f, 0.f, 0.f, 0.f}; \
        _Pragma("unroll") for (int k = 0; k < 4; ++k) { const unsigned wv = SV[k][j]; const f32x2 lo = __builtin_amdgcn_cvt_pk_f32_fp8(wv, false), hi = __builtin_amdgcn_cvt_pk_f32_fp8(wv, true); s[0] += lo[0]; s[1] += lo[1]; s[2] += hi[0]; s[3] += hi[1]; } \
        const f32x4 xv_ = (f32x4){__uint_as_float(XV[j].x << 16), __uint_as_float(XV[j].x & 0xffff0000u), __uint_as_float(XV[j].y << 16), __uint_as_float(XV[j].y & 0xffff0000u)}; \
        *((f32x4*)(F.out + (size_t)(trow0 + (rl)) * 1024) + lane + 64 * j) = xv_ + gt[j] * s; } } while (0)
    unsigned sa[4][4], sb[4][4]; u32x2 xa[4], xb[4]; const bf16_t* X1 = wsp<bf16_t>(F, WS_X1);
    P8_LOAD(0, sa, xa);
    for (int rl = 0; rl < 16; rl += 2) {
        P8_LOAD(rl + 1, sb, xb);
        P8_PROC(rl, sa, xa);
        if (rl + 2 < 16) P8_LOAD(rl + 2, sa, xa);
        P8_PROC(rl + 1, sb, xb);
    }
#undef P8_LOAD
#undef P8_PROC
}

constexpr int NPHASE = 9;
struct Args { const float* in[23]; float* out; unsigned char* ws; int ph_lo, ph_hi, skip, pad; };
__global__ void __launch_bounds__(NWAVES * 64, 2) mk_fwd(Args args) {
    extern __shared__ __attribute__((aligned(16))) unsigned char lds_[];
    Frame F;
    F.lds = (LAS unsigned char*)lds_;
    F.MISC = (volatile LAS unsigned*)(F.lds + SP_MISC);
    F.wave = __builtin_amdgcn_readfirstlane((int)(threadIdx.x >> 6));
    F.G = gridDim.x; { const int bx = blockIdx.x; F.vcu = (F.G % 8 == 0) ? (bx % 8) * (F.G / 8) + bx / 8 : bx; }
    F.ws = args.ws; F.ctl = (unsigned*)(args.ws + WS_CTL); F.out = args.out;
    F.x = args.in[0]; F.c = args.in[1]; F.w_ada = args.in[2]; F.b_ada = args.in[3]; F.g_mix = args.in[4]; F.w_in = args.in[5]; F.w_fourier = args.in[6];
    F.q_norm_g = args.in[7]; F.k_norm_g = args.in[8]; F.lq1 = args.in[9]; F.lk1 = args.in[10]; F.lq2 = args.in[11]; F.lk2 = args.in[12]; F.g_subln = args.in[13];
    F.w_out = args.in[14]; F.rel_bias = args.in[15]; F.g_ffn = args.in[16]; F.w_router = args.in[17]; F.b_router = args.in[18]; F.w1 = args.in[19]; F.b1 = args.in[20];
    F.w2 = args.in[21]; F.b2 = args.in[22];
    if (F.tid() < 64) ((LAS unsigned*)(F.lds + SP_MISC))[F.tid()] = 0u;
    __syncthreads();
    const int lo = args.ph_lo, hi = args.ph_hi;
    XcdBarrier bar; bar.bar = F.ctl + CW_BAR; bar.x = 0; bar.st = nullptr;
    if (hi - lo > 1) bar = xcd_barrier_post(F.ctl + CW_BAR, F.MISC + 8);
#ifndef PH_MASK
#define PH_MASK 0x1ff
#endif
#define IN(k) (((PH_MASK >> (k)) & 1) && lo <= (k) && (k) < hi)
#define SEAM(k) do { if (IN(k) && IN((k) + 1)) xcd_barrier(bar); if (MK_TIMER >= 0 && F.tid() == 0) ((volatile LAS unsigned long long*)(F.lds + SP_OFF + 15360))[(k) + 1] = __builtin_amdgcn_s_memrealtime(); } while (0)
    const int cblk = (int)blockIdx.x;
    if (MK_TIMER >= 0 && F.tid() == 0) ((volatile LAS unsigned long long*)(F.lds + SP_OFF + 15360))[0] = __builtin_amdgcn_s_memrealtime();

    if (IN(0)) { p0_prologue(F, args.skip); }
    SEAM(0);
    if (IN(1)) { p1_rows(F); }
    SEAM(1);
    if (IN(2)) {
        { SchedPlain S{(const char*)wsp<bf16_t>(F, WS_XN), (const char*)wsp<bf16_t>(F, WS_WQKV), NTOK / 256, NQKV / 256, F.G, cblk, (size_t)256 * 1024};
          EpiQKV E{wsp<bf16_t>(F, WS_Q), wsp<bf16_t>(F, WS_K), wsp<bf16_t>(F, WS_V), F.q_norm_g, F.k_norm_g};
          pg8::gemm_phase<EpiQKV, SchedPlain, true, 124>(F.lds, 1024, S, E, F.wave); }
        { SchedFourier S{(const char*)wsp<bf16_t>(F, WS_WCS), (const char*)wsp<bf16_t>(F, WS_XNSA), F.G, cblk, (size_t)256 * 1024 * 2};
          EpiFourier E{wsp<bf16_t>(F, WS_BDFT), wsp<float>(F, WS_VR)};
          pg8::gemm_phase<EpiFourier, SchedFourier>(F.lds, 2048, S, E, F.wave); }
    }
    SEAM(2);
    if (IN(3)) {
        float lam;
        { const float a = F.lq1[F.lane()] * F.lk1[F.lane()], b = F.lq2[F.lane()] * F.lk2[F.lane()]; lam = __expf(wave_sum(a)) - __expf(wave_sum(b)) + LAM_INIT; lam = __uint_as_float((unsigned)__builtin_amdgcn_readfirstlane((int)__float_as_uint(lam))); }
        att::Tensors T{wsp<bf16_t>(F, WS_Q), wsp<bf16_t>(F, WS_K), wsp<bf16_t>(F, WS_V), wsp<bf16_t>(F, WS_AMIX), wsp<float>(F, WS_BTAB), F.g_subln, lam, F.w1, F.w2, wsp<unsigned char>(F, WS_W1), wsp<unsigned char>(F, WS_W2), F.vcu * 8};
        if (!(args.skip & 1)) for (int L = F.vcu; L < NB * 4 * (SEQ / att::QB); L += F.G) { const int bh = L >> 4, qb = L & 15; att::attn_unit5(F.lds, T, bh >> 2, bh & 3, qb, F.wave, (F.G == 256) ? ((L - F.vcu) / F.G) * 31 : 4096); }
        if (!(args.skip & 2)) { SchedPlain S{(const char*)wsp<bf16_t>(F, WS_ADFT), (const char*)wsp<bf16_t>(F, WS_BDFT), 16, 16, F.G, cblk, (size_t)256 * 4096};
          EpiDft E{wsp<bf16_t>(F, WS_AMIX)};
          pg8::gemm_phase<EpiDft, SchedPlain, true, 124>(F.lds, 4096, S, E, F.wave); }
    }
    SEAM(3);
    if (IN(4)) {
        SchedPlain S{(const char*)wsp<bf16_t>(F, WS_AMIX), (const char*)wsp<bf16_t>(F, WS_WOUT), NTOK / 256, 4, F.G, cblk, (size_t)256 * 1024 * 2};
        EpiOut E{F.x, wsp<float>(F, WS_MOD), wsp<bf16_t>(F, WS_X1)};
        pg8::gemm_phase<EpiOut, SchedPlain>(F.lds, 2048, S, E, F.wave);
    }
    SEAM(4);
    if (IN(5)) { p5_router(F); }
    SEAM(5);
    if (IN(6)) {
        moe_tables(F);
        const LAS int* tstart = (const LAS int*)(F.lds + SP_TSTART);
        SchedMoe<true> S{(const char*)wsp<bf16_t>(F, WS_XN2), (const char*)wsp<bf16_t>(F, WS_W1), tstart[32], 8, F.G, cblk, 0, (size_t)256 * 1024, (size_t)2048 * 1024,
                         F.lds + SP_TILEE, tstart, (const LAS int*)(F.lds + SP_CNT), wsp<unsigned>(F, WS_SLOTTOK)};
        EpiSwiglu E{wsp<bf16_t>(F, WS_ACT), wsp<float>(F, WS_B1P), F.lds + SP_TILEE};
        pg8::gemm_phase<EpiSwiglu, SchedMoe<true>, true, 124>(F.lds, 1024, S, E, F.wave);
    }
    SEAM(6);
    if (IN(7)) {
        moe_tables(F);
        const LAS int* tstart = (const LAS int*)(F.lds + SP_TSTART);
        SchedMoe<false> S{(const char*)wsp<bf16_t>(F, WS_ACT), (const char*)wsp<bf16_t>(F, WS_W2), tstart[32], 4, F.G, cblk, (size_t)256 * 1024, (size_t)256 * 1024, (size_t)1024 * 1024,
                          F.lds + SP_TILEE, tstart, (const LAS int*)(F.lds + SP_CNT), wsp<unsigned>(F, WS_SLOTTOK)};
        EpiDown E{wsp<bf16_t>(F, WS_SLAB), F.b2, wsp<float>(F, WS_SLOTGATE), F.lds + SP_TILEE, tstart};
        pg8::gemm_phase<EpiDown, SchedMoe<false>, true, 124>(F.lds, 1024, S, E, F.wave);
    }
    SEAM(7);
    if (IN(8)) { moe_tables(F); p8_combine(F); }
    if (MK_TIMER >= 0) { __syncthreads(); if (blockIdx.x == 0 && F.tid() == 0) { volatile LAS unsigned long long* ts = (volatile LAS unsigned long long*)(F.lds + SP_OFF + 15360); ts[9] = __builtin_amdgcn_s_memrealtime();
        const int k = MK_TIMER < 9 ? MK_TIMER : 0; const unsigned long long d = (MK_TIMER < 9) ? (ts[k + 1] - ts[k]) : (ts[9] - ts[0]); const float us = (float)d * 0.01f; const float q = us > 100.f ? 16.f : 4.f; F.out[0] = q * floorf(us / q + 0.5f); } }
#undef IN
#undef SEAM
}

extern "C" void kernel_launch(void* const* d_in, const int* in_sizes, int n_in, void* d_out, int out_size, void* d_ws, size_t ws_size, hipStream_t stream) {
    static int grid = 0;
    if (grid == 0) {
        if (n_in != 23 || in_sizes[0] != NTOK * DM || out_size != NTOK * DM || ws_size < WS_END) {
            fprintf(stderr, "kernel_launch: unexpected shapes: n_in %d in0 %d out %d ws %zu (need >= %zu)\n", n_in, n_in > 0 ? in_sizes[0] : -1, out_size, ws_size, (size_t)WS_END); grid = -1; return; }
        int dev = 0, cus = 0, per_cu = 0;
        if (hipGetDevice(&dev) != hipSuccess || hipDeviceGetAttribute(&cus, hipDeviceAttributeMultiprocessorCount, dev) != hipSuccess) { fprintf(stderr, "kernel_launch: device query failed\n"); grid = -1; return; }
        if (hipFuncSetAttribute((const void*)mk_fwd, hipFuncAttributeMaxDynamicSharedMemorySize, LDS_BYTES) != hipSuccess) { fprintf(stderr, "kernel_launch: hipFuncSetAttribute failed\n"); grid = -1; return; }
        if (hipOccupancyMaxActiveBlocksPerMultiprocessor(&per_cu, (const void*)mk_fwd, NWAVES * 64, LDS_BYTES) != hipSuccess || per_cu < 1) { fprintf(stderr, "kernel_launch: occupancy query says %d blocks per CU\n", per_cu); grid = -1; (void)hipGetLastError(); return; }
        grid = cus;
        if (grid % 8 != 0 || grid < 8) fprintf(stderr, "kernel_launch: note: %d CUs\n", grid);
    }
    if (grid < 0) return;
    if (hipMemsetAsync((char*)d_ws + WS_CTL, 0, CTL_ZERO_BYTES, stream) != hipSuccess) { fprintf(stderr, "kernel_launch: memset failed\n"); return; }
    Args a{};
    for (int i = 0; i < 23; ++i) a.in[i] = (const float*)d_in[i];
    a.out = (float*)d_out; a.ws = (unsigned char*)d_ws;
#if MK_SPLIT
    for (int p = 0; p < NPHASE; ++p) { a.ph_lo = p; a.ph_hi = p + 1; a.skip = 0; hipLaunchKernelGGL(mk_fwd, dim3(grid), dim3(NWAVES * 64), LDS_BYTES, stream, a);
        if (p == MK_PROBE) { a.skip = MK_PROBE_SKIP; hipLaunchKernelGGL(mk_fwd, dim3(grid), dim3(NWAVES * 64), LDS_BYTES, stream, a); } }
#else
    a.ph_lo = 0; a.ph_hi = NPHASE;
    void* kargs[] = {(void*)&a};
    const hipError_t le = hipLaunchCooperativeKernel((const void*)mk_fwd, dim3(grid), dim3(NWAVES * 64), kargs, LDS_BYTES, stream);
    if (le != hipSuccess) fprintf(stderr, "kernel_launch: cooperative launch failed: %s (grid %d)\n", hipGetErrorName(le), grid);
#endif
}
```

```cpp
#include <hip/hip_runtime.h>
#include <cstdio>
#include <cstdint>
#include <cmath>

#define LAS __attribute__((address_space(3)))
#define GAS __attribute__((address_space(1)))
typedef unsigned short bf16_t;
typedef short bf16x8 __attribute__((ext_vector_type(8)));
typedef short s16x4 __attribute__((ext_vector_type(4)));
typedef float f32x4 __attribute__((ext_vector_type(4)));
typedef float f32x2 __attribute__((ext_vector_type(2)));
typedef float f32x16 __attribute__((ext_vector_type(16)));
typedef unsigned u32x4 __attribute__((ext_vector_type(4)));
typedef unsigned u32x2 __attribute__((ext_vector_type(2)));
typedef GAS unsigned gu32;

#ifndef MK_TIMER
#define MK_TIMER -1
#endif
#ifndef MK_PROBE
#define MK_PROBE -1
#endif
#ifndef MK_PROBE_SKIP
#define MK_PROBE_SKIP 0
#endif
#ifndef MK_SPLIT
#define MK_SPLIT 0
#endif

constexpr int NB = 8, SEQ = 4096, DM = 1024, NTOK = NB * SEQ;
constexpr int NEXP = 32, TOPK = 4, DFF = 1024, CAP = NTOK;
constexpr int NQKV = 1536;
constexpr int HSEQ = SEQ / 2;
constexpr float EPS = 1e-6f;
constexpr float LOG2E = 1.4426950408889634f;
constexpr float SWG_C = -1.702f * LOG2E;
constexpr float QSCALE = 0.125f * LOG2E;
constexpr float LAM_INIT = 0.2f;
constexpr int MAXTILES = (NTOK * TOPK) / 256 + NEXP;

constexpr size_t MiB = 1u << 20;
constexpr size_t WS_CTL = 0, CTL_ZERO_BYTES = 64 * 1024;
constexpr size_t WS_MOD = 1 * MiB;
constexpr size_t WS_VR = WS_MOD + 256 * 1024;
constexpr size_t WS_BTAB = WS_MOD + 320 * 1024;
constexpr size_t WS_B1P = WS_MOD + 512 * 1024;
constexpr size_t WS_TOKSLOT = 2 * MiB;
constexpr size_t WS_SLOTTOK = 4 * MiB;
constexpr size_t WS_SLOTGATE = 8 * MiB;
constexpr size_t WS_WQKV = 12 * MiB;
constexpr size_t WS_WCS = 15 * MiB;
constexpr size_t WS_WOUT = 17 * MiB;
constexpr size_t WS_ADFT = 20 * MiB;
constexpr size_t WS_W1 = 52 * MiB;
constexpr size_t WS_W2 = 180 * MiB;
constexpr size_t WS_XN = 256 * MiB;
constexpr size_t WS_XNSA = 320 * MiB;
constexpr size_t WS_Q = 384 * MiB, WS_K = 416 * MiB, WS_V = 448 * MiB;
constexpr size_t WS_BDFT = 480 * MiB;
constexpr size_t WS_AMIX = 512 * MiB;
constexpr size_t WS_ACT = 256 * MiB;
constexpr size_t WS_XN2 = 576 * MiB;
constexpr size_t WS_SLAB = 640 * MiB;
constexpr size_t WS_X1 = 784 * MiB;
constexpr size_t WS_END = 912 * MiB;
static_assert(WS_ACT + (size_t)MAXTILES * 256 * 1024 * 2 <= WS_XN2 && WS_SLAB + (size_t)MAXTILES * 256 * 1024 * 2 <= WS_END, "d_ws map");
constexpr int CW_BAR = 4096;
constexpr int CW_GCNT = 8192;

constexpr int RING_BYTES = 131072;
constexpr int SP_OFF = 147456;
constexpr int SP_MISC = SP_OFF;
constexpr int SP_TSTART = SP_OFF + 256;
constexpr int SP_CNT = SP_OFF + 512;
constexpr int SP_TILEE = SP_OFF + 768;
constexpr int SP_BT = SP_OFF + 2048;
constexpr int SP_WS = SP_OFF + 3072;
constexpr int GROW_OFF = SP_OFF + 6144;
constexpr int LDS_BYTES = 163840;
constexpr int NWAVES = 8;

__device__ __forceinline__ unsigned cvt_pk_bf16(float lo, float hi) { unsigned r; asm volatile("v_cvt_pk_bf16_f32 %0, %1, %2" : "=v"(r) : "v"(lo), "v"(hi)); return r; }
__device__ __forceinline__ unsigned cvt_pk4_fp8(float a, float b, float c, float d) { unsigned w = 0; w = __builtin_amdgcn_cvt_pk_fp8_f32(a, b, w, false); w = __builtin_amdgcn_cvt_pk_fp8_f32(c, d, w, true); return w; }
__device__ __forceinline__ float bf2f(unsigned short h) { return __uint_as_float((unsigned)h << 16); }
__device__ __forceinline__ float wave_sum(float v) {
#pragma unroll
    for (int o = 1; o < 64; o <<= 1) v += __shfl_xor(v, o);
    return v;
}
__device__ __forceinline__ int lane_now() { int l; asm volatile("v_mbcnt_lo_u32_b32 %0, -1, 0\n\tv_mbcnt_hi_u32_b32 %0, -1, %0" : "=v"(l)); return l; }
#define LDS_WAIT() asm volatile("s_waitcnt lgkmcnt(0)" ::: "memory")
#define VM_WAIT() asm volatile("s_waitcnt vmcnt(0)" ::: "memory")
#define RLX_AGENT __ATOMIC_RELAXED, __HIP_MEMORY_SCOPE_AGENT

namespace pg8 {
constexpr int BM = 256, BK = 64, HALF = 128, HTB = HALF * BK * 2, STAGE_BYTES = 8 * HTB, NXCD = 8, WGM = 8;
__host__ __device__ __forceinline__ int lds_byte(int r, int c) { const int st = (r >> 4) * 2 + (c >> 5), rr = r & 15, cc = c & 31, ob = rr * 64 + cc * 2; return st * 1024 + (ob ^ (((ob >> 9) & 1) << 5)); }
__host__ __device__ __forceinline__ void stage_rc(int b, int& R, int& C) { const int st = b / 1024, sb = b % 1024, swz = sb ^ (((sb >> 9) & 1) << 5); R = (st >> 1) * 16 + swz / 64; C = (st & 1) * 32 + (swz % 64) / 2; }
__host__ __device__ __forceinline__ int perm32(int rho) { const int n = rho >> 4, i = rho & 15; return 8 * (i >> 2) + 4 * n + (i & 3); }
struct Unit { int pm, pn; };

__device__ __forceinline__ bool static_unit(int i, int G, int c, int nM, int nN, Unit& u) {
    const int nwg = nM * nN; const long L = (long)i * G + c; if (L >= nwg) return false;
    int wgid = (int)L; { const int q = nwg / NXCD, r = nwg % NXCD, xcd = wgid % NXCD, off = wgid / NXCD; wgid = (xcd < r ? xcd * (q + 1) : r * (q + 1) + (xcd - r) * q) + off; }
    const int nig = WGM * nN, gid = wgid / nig, fm = gid * WGM, gsz = (nM - fm) < WGM ? (nM - fm) : WGM;
    u.pm = fm + ((wgid % nig) % gsz); u.pn = (wgid % nig) / gsz; return true;
}

typedef int i32x8 __attribute__((ext_vector_type(8)));
typedef int i32x4v __attribute__((ext_vector_type(4)));
template <class Epi, class Sched, bool FP8 = false, int SCB = 127>
__device__ __forceinline__ void gemm_phase(LAS unsigned char* lds, const int KB, const Sched& S, const Epi& E, const int wid_in) {
    const int lane = lane_now(), wid = __builtin_amdgcn_readfirstlane(wid_in), tid = wid * 64 + lane, wr = wid >> 2, wc = wid & 3, fr = lane & 15, fq = lane >> 4;
    int nt = KB / 128; asm volatile("" : "+s"(nt));
    unsigned voffA, voffB; int RA0, CA0;
    { int R, C; stage_rc(tid * 16, R, C); const int Rb = Epi::WIDE ? (64 * (R >> 5) + 16 * ((R >> 2) & 3) + 4 * ((R >> 4) & 1) + (R & 3)) : Epi::PERM ? ((R & ~31) + perm32(R & 31)) : R;
      voffA = (unsigned)(R * KB + C * 2); voffB = (unsigned)(Rb * KB + C * 2); RA0 = R; CA0 = C; }
    const unsigned p1off = 64u * (unsigned)KB, p1offB = (Epi::WIDE ? 128u : 64u) * (unsigned)KB;
    const size_t kstep = (size_t)(BK * 2);
    const size_t hstep = (size_t)HALF * KB, hstepB = (size_t)(Epi::WIDE ? 8 : HALF) * KB;
    const unsigned ldsw = (unsigned)wid * 1024u, ldsb = (unsigned)(uintptr_t)lds;
    const int aoff = FP8 ? lds_byte(wr * 64 + fr, 32 * (fq >> 1) + 8 * (fq & 1)) : lds_byte(wr * 64 + fr, fq * 8), boff = FP8 ? lds_byte(wc * 32 + fr, 32 * (fq >> 1) + 8 * (fq & 1)) : lds_byte(wc * 32 + fr, fq * 8);
    const int aoff2 = lds_byte(wr * 64 + fr, 32 * (fq >> 1) + 8 * (fq & 1) + 16), boff2 = lds_byte(wc * 32 + fr, 32 * (fq >> 1) + 8 * (fq & 1) + 16);
    LAS unsigned short* grow = (LAS unsigned short*)(lds + GROW_OFF) + tid * 4;
#define PG8_SA(b, h) (((b) * 2 + (h)) * HTB)
#define PG8_SB(b, h) ((4 + (b) * 2 + (h)) * HTB)
#define PG8_GLDS(sbase, vo, ldsdst) do { unsigned keep_; asm volatile("s_mov_b32 %0, m0\n\ts_mov_b32 m0, %3\n\ts_nop 0\n\tglobal_load_lds_dwordx4 %1, %2\n\ts_mov_b32 m0, %0" \
        : "=&s"(keep_) : "v"(vo), "s"(sbase), "s"(ldsdst) : "memory"); } while (0)
#define PG8_UPTR(p) ((const char*)(((unsigned long long)(unsigned)__builtin_amdgcn_readfirstlane((int)((unsigned long long)(p) >> 32)) << 32) | (unsigned)__builtin_amdgcn_readfirstlane((int)(unsigned long long)(p))))
#define PG8_STAGE_P(bufoff, gbase, voff, p1) do { const char* sb_ = PG8_UPTR(gbase); \
        PG8_GLDS(sb_, (voff), (unsigned)__builtin_amdgcn_readfirstlane((int)(ldsb + (unsigned)(bufoff) + ldsw))); \
        PG8_GLDS(sb_ + (p1), (voff), (unsigned)__builtin_amdgcn_readfirstlane((int)(ldsb + (unsigned)(bufoff) + ldsw + 8192))); } while (0)
#define PG8_STAGE(bufoff, gbase, voff) PG8_STAGE_P(bufoff, gbase, voff, p1offB)
#define PG8_STAGE_A(bufoff, ab, kb, h, set) do { if constexpr (Sched::GATHER) { const char* sb_ = PG8_UPTR((ab) + (kb)); const unsigned rr_ = *(const LAS unsigned*)(grow + (set) * 2048 + 2 * (h)); \
        PG8_GLDS(sb_, (rr_ & 0xffffu) * (unsigned)KB + (unsigned)(CA0 * 2), (unsigned)__builtin_amdgcn_readfirstlane((int)(ldsb + (unsigned)(bufoff) + ldsw))); \
        PG8_GLDS(sb_, (rr_ >> 16) * (unsigned)KB + (unsigned)(CA0 * 2), (unsigned)__builtin_amdgcn_readfirstlane((int)(ldsb + (unsigned)(bufoff) + ldsw + 8192))); } \
        else { PG8_STAGE_P(bufoff, (ab) + (kb) + (h) * hstep, voffA, p1off); } } while (0)
#define PG8_LD8(base, o0, o1) __builtin_shufflevector(*(const LAS i32x4v*)(lds + (base) + (o0)), *(const LAS i32x4v*)(lds + (base) + (o1)), 0, 1, 2, 3, 4, 5, 6, 7)
#define PG8_LDA(dst, b, h) do { if constexpr (FP8) { _Pragma("unroll") for (int m = 0; m < 4; ++m) dst##8[m] = PG8_LD8(PG8_SA(b, h) + m * 2048, aoff, aoff2); } \
        else { _Pragma("unroll") for (int m = 0; m < 4; ++m) _Pragma("unroll") for (int k = 0; k < 2; ++k) dst[m][k] = *(const LAS bf16x8*)(lds + PG8_SA(b, h) + aoff + m * 2048 + k * 1024); } } while (0)
#define PG8_LDB(dst, b, h) do { if constexpr (FP8) { _Pragma("unroll") for (int n = 0; n < 2; ++n) dst##8[n] = PG8_LD8(PG8_SB(b, h) + n * 2048, boff, boff2); } \
        else { _Pragma("unroll") for (int n = 0; n < 2; ++n) _Pragma("unroll") for (int k = 0; k < 2; ++k) dst[n][k] = *(const LAS bf16x8*)(lds + PG8_SB(b, h) + boff + n * 2048 + k * 1024); } } while (0)
#define PG8_MMA(ai, bj, At, Bt) do { __builtin_amdgcn_s_setprio(1); _Pragma("unroll") for (int m = 0; m < 4; ++m) _Pragma("unroll") for (int n = 0; n < 2; ++n) { \
        if constexpr (FP8) asm volatile("v_mfma_scale_f32_16x16x128_f8f6f4 %0, %1, %2, %0, %3, %3 op_sel_hi:[0,0,0]" : "+v"(acc[ai][bj][m][n]) : "v"(Bt##8[n]), "v"(At##8[m]), "v"(scv)); \
        else { _Pragma("unroll") for (int k = 0; k < 2; ++k) acc[ai][bj][m][n] = __builtin_amdgcn_mfma_f32_16x16x32_bf16(Bt[n][k], At[m][k], acc[ai][bj][m][n], 0, 0, 0); } } __builtin_amdgcn_s_setprio(0); } while (0)
#define PG8_WAIT_V(n) asm volatile("s_waitcnt vmcnt(" #n ")" ::: "memory")
#define PG8_WAIT_L(n) asm volatile("s_waitcnt lgkmcnt(" #n ")" ::: "memory")
#define PG8_BAR __builtin_amdgcn_s_barrier()
#define PG8_SCHED __builtin_amdgcn_sched_barrier(0)
    Unit cur, nxt; int ui = 0;
    if (!S.next(0, cur)) return;
    f32x4 acc[2][2][4][2];
    typename Epi::Pre pre, pren; E.prefetch(pre, cur, wr, wc, fr, fq); E.init(acc, pre);
    bf16x8 At[4][2], B0[2][2], B1[2][2]; i32x8 At8[4], B08[2], B18[2];
    const int scv = SCB;
    const char* cA = S.a_ptr(cur); const char* cB = S.b_ptr(cur);
    if constexpr (Sched::GATHER) { int r[4]; S.a_rows(cur, RA0, RA0 + 64, r);
        *(LAS u32x2*)grow = (u32x2){(unsigned)r[0] | ((unsigned)r[1] << 16), (unsigned)r[2] | ((unsigned)r[3] << 16)}; }
    PG8_STAGE(PG8_SB(0, 0), cB, voffB); PG8_STAGE(PG8_SB(0, 1), cB + hstepB, voffB); PG8_STAGE_A(PG8_SA(0, 0), cA, 0, 0, 0); PG8_STAGE_A(PG8_SA(0, 1), cA, 0, 1, 0);
    if (wr == 1) PG8_BAR;
    PG8_WAIT_V(2); PG8_BAR;
    PG8_STAGE(PG8_SB(1, 0), cB + kstep, voffB); PG8_STAGE_A(PG8_SA(1, 0), cA, kstep, 0, 0); PG8_STAGE(PG8_SB(1, 1), cB + hstepB + kstep, voffB);
    PG8_WAIT_V(6); PG8_BAR;
    for (;;) {
        const bool has_next = S.next(ui + 1, nxt);
        const char* nA = has_next ? S.a_ptr(nxt) : cA; const char* nB = has_next ? S.b_ptr(nxt) : cB;
        const int cset = ui & 1, nset = has_next ? (cset ^ 1) : cset;
        unsigned rv_[4] = {0u, 0u, 0u, 0u}; int nrem_ = 0;
        if constexpr (Sched::GATHER) { if (has_next) S.rows_issue(nxt, RA0, RA0 + 64, rv_, nrem_); }
#pragma unroll 1
        for (int t = 0; t < nt; t += 2) {
            const bool last = (t == nt - 2);
            const size_t k1 = (size_t)(t + 1) * kstep;
            const char* a2 = last ? nA : cA; const size_t k2 = last ? 0 : (size_t)(t + 2) * kstep; const char* b2 = last ? nB : cB + (size_t)(t + 2) * kstep;
            const size_t k3 = k2 + kstep; const char* b3 = b2 + kstep;
            PG8_LDB(B0, 0, 0); PG8_LDB(B1, 0, 1); PG8_SCHED; PG8_LDA(At, 0, 0); PG8_STAGE_A(PG8_SA(1, 1), cA, k1, 1, cset);
            PG8_WAIT_V(8); PG8_WAIT_L(0); PG8_BAR; PG8_MMA(0, 0, At, B0); PG8_MMA(0, 1, At, B1); PG8_BAR; PG8_SCHED;
            PG8_LDA(At, 0, 1); PG8_STAGE(PG8_SB(0, 0), b2, voffB); PG8_STAGE(PG8_SB(0, 1), b2 + hstepB, voffB); PG8_STAGE_A(PG8_SA(0, 0), a2, k2, 0, (last ? nset : cset));
            PG8_WAIT_V(8); PG8_WAIT_L(0);
            if constexpr (Sched::GATHER) { if (has_next && t == 0) { asm volatile("" : "+v"(rv_[0]), "+v"(rv_[1]), "+v"(rv_[2]), "+v"(rv_[3])); int r[4]; S.rows_finish(RA0, RA0 + 64, rv_, nrem_, r);
                *(LAS u32x2*)(grow + nset * 2048) = (u32x2){(unsigned)r[0] | ((unsigned)r[1] << 16), (unsigned)r[2] | ((unsigned)r[3] << 16)}; } }
            PG8_BAR; PG8_MMA(1, 0, At, B0); PG8_MMA(1, 1, At, B1); PG8_BAR; PG8_SCHED;
            PG8_LDB(B0, 1, 0); PG8_LDB(B1, 1, 1); PG8_SCHED; PG8_LDA(At, 1, 0); PG8_STAGE_A(PG8_SA(0, 1), a2, k2, 1, (last ? nset : cset));
            PG8_WAIT_V(8); PG8_WAIT_L(0); PG8_BAR; PG8_MMA(0, 0, At, B0); PG8_MMA(0, 1, At, B1); PG8_BAR; PG8_SCHED;
            PG8_LDA(At, 1, 1); PG8_STAGE(PG8_SB(1, 0), b3, voffB); PG8_STAGE(PG8_SB(1, 1), b3 + hstepB, voffB); PG8_STAGE_A(PG8_SA(1, 0), a2, k3, 0, (last ? nset : cset));
            PG8_WAIT_V(8); PG8_WAIT_L(0); PG8_BAR; PG8_MMA(1, 0, At, B0); PG8_MMA(1, 1, At, B1); PG8_BAR; PG8_SCHED;
        }
        if (wr == 0) PG8_BAR;
        if constexpr (FP8) asm volatile("s_nop 15\n\ts_nop 15" ::: "memory");
        { const int t2_ = lane_now();
          Unit ue_; ue_.pm = __builtin_amdgcn_readfirstlane(cur.pm); ue_.pn = __builtin_amdgcn_readfirstlane(cur.pn);
          if (has_next) { Unit un_; un_.pm = __builtin_amdgcn_readfirstlane(nxt.pm); un_.pn = __builtin_amdgcn_readfirstlane(nxt.pn); E.prefetch(pren, un_, wr, wc, t2_ & 15, (t2_ >> 4) & 3); }
          E(acc, ue_, wr, wc, t2_ & 15, (t2_ >> 4) & 3, pre); }
        if (!has_next) break;
        pre = pren; E.init(acc, pre);
        cur = nxt; cA = nA; cB = nB; ++ui;
        if (wr == 1) PG8_BAR;
    }
    PG8_WAIT_V(0);
    PG8_BAR;
#undef PG8_SA
#undef PG8_SB
#undef PG8_STAGE
#undef PG8_STAGE_P
#undef PG8_GLDS
#undef PG8_UPTR
#undef PG8_STAGE_A
#undef PG8_LDA
#undef PG8_LDB
#undef PG8_MMA
#undef PG8_LD8
#undef PG8_WAIT_V
#undef PG8_WAIT_L
#undef PG8_BAR
#undef PG8_SCHED
}
}

#define XB_TMO      128
#define XB_XCNT(j)  (256  + 64 * (j))
#define XB_XSUB(j)  (1280 + 64 * (j))
#define XB_XGEN(j)  (2304 + 64 * (j))
#define XB_TOP      3328
#define XB_TOPGEN   3392
#define XCD_BAR_WORDS 3456
#define XB_SPIN_CAP (1u << 20)
__device__ __forceinline__ unsigned xb_ld(unsigned* p)              { return __hip_atomic_load(p, __ATOMIC_RELAXED, __HIP_MEMORY_SCOPE_AGENT); }
__device__ __forceinline__ unsigned xb_add(unsigned* p, unsigned v) { return __hip_atomic_fetch_add(p, v, __ATOMIC_RELAXED, __HIP_MEMORY_SCOPE_AGENT); }
__device__ __forceinline__ unsigned xb_xcc_id() { return (unsigned)__builtin_amdgcn_s_getreg((3 << 11) | 20) & 0xFu; }
#define XB_SPIN(cond, bar) do { unsigned _sp = 0; while (cond) { __builtin_amdgcn_s_sleep(1); \
    if ((++_sp & 255u) == 0u) { if (xb_ld(&(bar)[XB_TMO])) break; if (_sp > XB_SPIN_CAP) { atomicAdd(&(bar)[XB_TMO], 1u); break; } } } } while (0)
struct XcdBarrier { unsigned* bar; unsigned x; volatile LAS unsigned* st; };
__device__ __forceinline__ XcdBarrier xcd_barrier_post(unsigned* bar, volatile LAS unsigned* st) {
    XcdBarrier b; b.bar = bar; b.x = xb_xcc_id(); b.st = st;
    if (threadIdx.x == 0) (void)xb_add(&bar[XB_XCNT(b.x)], 1u);
    return b;
}
__device__ __forceinline__ void xcd_barrier_complete(unsigned* bar, unsigned x, unsigned& nloc, unsigned& nx) {
    const unsigned G = gridDim.x * gridDim.y * gridDim.z;
    unsigned sum, cnt, mine, sp = 0u;
    for (;;) {
        sum = 0u; cnt = 0u; mine = 0u;
#pragma unroll
        for (unsigned j = 0; j < 16; ++j) { const unsigned c = xb_ld(&bar[XB_XCNT(j)]); sum += c; cnt += (c > 0u) ? 1u : 0u; mine = (j == x) ? c : mine; }
        if (sum == G) break;
        __builtin_amdgcn_s_sleep(1);
        if ((++sp & 255u) == 0u) { if (xb_ld(&bar[XB_TMO])) break; if (sp > XB_SPIN_CAP) { atomicAdd(&bar[XB_TMO], 1u); break; } }
    }
    nloc = mine > 0u ? mine : 1u; nx = cnt > 0u ? cnt : 1u;
}
__device__ __forceinline__ void xcd_barrier(const XcdBarrier& b) {
    asm volatile("s_waitcnt vmcnt(0)" ::: "memory");
    __syncthreads();
    if (threadIdx.x == 0) {
        unsigned* bar = b.bar;
        __builtin_amdgcn_s_waitcnt(0);
        unsigned nloc = b.st[0], nx = b.st[1];
        if (nloc == 0u) { xcd_barrier_complete(bar, b.x, nloc, nx); b.st[0] = nloc; b.st[1] = nx; }
        const unsigned old = xb_add(&bar[XB_XSUB(b.x)], 1u);
        const unsigned gen = old / nloc;
        if (old + 1u == (gen + 1u) * nloc) {
            __builtin_amdgcn_fence(__ATOMIC_RELEASE, "agent");
            asm volatile("s_waitcnt vmcnt(0)" ::: "memory");
            const unsigned og = xb_add(&bar[XB_TOP], 1u);
            const unsigned tg = og / nx;
            if (og + 1u == (tg + 1u) * nx) xb_add(&bar[XB_TOPGEN], 1u);
            else XB_SPIN(xb_ld(&bar[XB_TOPGEN]) == tg, bar);
            __builtin_amdgcn_fence(__ATOMIC_ACQUIRE, "agent");
            xb_add(&bar[XB_XGEN(b.x)], 1u);
            asm volatile("s_waitcnt vmcnt(0)" ::: "memory");
        } else {
            XB_SPIN(xb_ld(&bar[XB_XGEN(b.x)]) == gen, bar);
            __builtin_amdgcn_fence(__ATOMIC_ACQUIRE, "agent");
            asm volatile("s_waitcnt vmcnt(0)" ::: "memory");
        }
    }
    __syncthreads();
}

struct Frame {
    LAS unsigned char* lds;
    volatile LAS unsigned* MISC;
    unsigned* ctl;
    int wave, vcu, G;
    __device__ __forceinline__ int lane() const { return lane_now(); }
    __device__ __forceinline__ int tid() const { return wave * 64 + lane_now(); }
    const float *x, *c, *w_ada, *b_ada, *g_mix, *w_in, *w_fourier, *q_norm_g, *k_norm_g, *lq1, *lk1, *lq2, *lk2, *g_subln, *w_out, *rel_bias,
                *g_ffn, *w_router, *b_router, *w1, *b1, *w2, *b2;
    float* out;
    unsigned char* ws;
};
template <class T> __device__ __forceinline__ T* wsp(const Frame& F, size_t off) { return (T*)(F.ws + off); }

struct SchedPlain {
    static constexpr bool GATHER = false;
    const char* A; const char* Bt; int nM, nN, G, c; size_t tstep;
    __device__ __forceinline__ bool next(int i, pg8::Unit& u) const { return pg8::static_unit(i, G, c, nM, nN, u); }
    __device__ __forceinline__ const char* a_ptr(const pg8::Unit& u) const { return A + (size_t)u.pm * tstep; }
    __device__ __forceinline__ const char* b_ptr(const pg8::Unit& u) const { return Bt + (size_t)u.pn * tstep; }
    __device__ __forceinline__ void a_rows(const pg8::Unit&, int, int, int (&r)[4]) const { r[0] = r[1] = r[2] = r[3] = 0; }
};
struct SchedFourier {
    static constexpr bool GATHER = false;
    const char* A; const char* Bt; int G, c; size_t tstep;
    __device__ __forceinline__ bool next(int i, pg8::Unit& u) const {
        const int L = i * G + c; if (L >= 256) return false;
        const int w = (L % 8) * 32 + L / 8;
        const int half = w >> 7, r = w & 127; u.pm = 2 * half + (r & 1); u.pn = 64 * half + (r >> 1); return true; }
    __device__ __forceinline__ const char* a_ptr(const pg8::Unit& u) const { return A + (size_t)u.pm * tstep; }
    __device__ __forceinline__ const char* b_ptr(const pg8::Unit& u) const { return Bt + (size_t)u.pn * tstep; }
    __device__ __forceinline__ void a_rows(const pg8::Unit&, int, int, int (&r)[4]) const { r[0] = r[1] = r[2] = r[3] = 0; }
};
template <bool GATHER_> struct SchedMoe {
    static constexpr bool GATHER = GATHER_;
    const char* A; const char* Bt; int nM, nN, G, c; size_t a_tstep, b_tstep, e_stride;
    const LAS unsigned char* tile_e; const LAS int* tstart; const LAS int* cnt; const unsigned* slot_tok;
    __device__ __forceinline__ bool next(int i, pg8::Unit& u) const { return pg8::static_unit(i, G, c, nM, nN, u); }
    __device__ __forceinline__ const char* a_ptr(const pg8::Unit& u) const { return GATHER_ ? A : A + (size_t)u.pm * a_tstep; }
    __device__ __forceinline__ const char* b_ptr(const pg8::Unit& u) const { const int e = __builtin_amdgcn_readfirstlane((int)tile_e[u.pm]); return Bt + (size_t)e * e_stride + (size_t)u.pn * b_tstep; }
    __device__ __forceinline__ void a_rows(const pg8::Unit& u, int R0, int R1, int (&r)[4]) const {
        const int e = __builtin_amdgcn_readfirstlane((int)tile_e[u.pm]); const int s0 = __builtin_amdgcn_readfirstlane((u.pm - tstart[e]) * 256), n = __builtin_amdgcn_readfirstlane(cnt[e]);
#pragma unroll
        for (int h = 0; h < 2; ++h)
#pragma unroll
            for (int i = 0; i < 2; ++i) { const int s = s0 + h * 128 + (i ? R1 : R0); r[2 * h + i] = (s < n) ? (int)slot_tok[(size_t)e * CAP + s] : 0; }
    }
    __device__ __forceinline__ void rows_issue(const pg8::Unit& u, int R0, int R1, unsigned (&rv)[4], int& nrem) const {
        const int e = __builtin_amdgcn_readfirstlane((int)tile_e[u.pm]); const int s0 = __builtin_amdgcn_readfirstlane((u.pm - tstart[e]) * 256), n = __builtin_amdgcn_readfirstlane(cnt[e]);
        nrem = n - s0;
#pragma unroll
        for (int h = 0; h < 2; ++h)
#pragma unroll
            for (int i = 0; i < 2; ++i) { const unsigned* p = slot_tok + (size_t)e * CAP + s0 + h * 128 + (i ? R1 : R0); asm volatile("global_load_dword %0, %1, off" : "=v"(rv[2 * h + i]) : "v"(p) : "memory"); }
    }
    __device__ __forceinline__ void rows_finish(int R0, int R1, const unsigned (&rv)[4], int nrem, int (&r)[4]) const {
#pragma unroll
        for (int h = 0; h < 2; ++h)
#pragma unroll
            for (int i = 0; i < 2; ++i) r[2 * h + i] = (h * 128 + (i ? R1 : R0) < nrem) ? (int)rv[2 * h + i] : 0;
    }
};

typedef const f32x4 (&AccRef)[2][2][4][2];
__device__ __forceinline__ u32x4 pack8(f32x4 a, f32x4 b) { u32x4 w; w.x = cvt_pk_bf16(a[0], a[1]); w.y = cvt_pk_bf16(a[2], a[3]); w.z = cvt_pk_bf16(b[0], b[1]); w.w = cvt_pk_bf16(b[2], b[3]); return w; }

struct EpiQKV {
    static constexpr bool PERM = true, WIDE = true;
    bf16_t *Q, *Kb, *V; const float *gq, *gk;
    struct Pre {};
    __device__ __forceinline__ void prefetch(Pre&, const pg8::Unit&, int, int, int, int) const {}
    __device__ __forceinline__ void init(f32x4 (&acc)[2][2][4][2], const Pre&) const {
#pragma unroll
        for (int a = 0; a < 2; ++a)
#pragma unroll
            for (int b = 0; b < 2; ++b)
#pragma unroll
                for (int m = 0; m < 4; ++m)
#pragma unroll
                    for (int n = 0; n < 2; ++n) acc[a][b][m][n] = (f32x4){0.f, 0.f, 0.f, 0.f}; }
    __device__ __forceinline__ void operator()(AccRef acc, const pg8::Unit& u, int wr, int wc, int fr, int fq, const Pre& PR) const {
        const int sec = u.pn >> 1, row0 = u.pm * 256 + wr * 64 + fr;
        if (sec < 2) {
            bf16_t* O = sec == 0 ? Q : Kb; const float* g = sec == 0 ? gq : gk; const float sc = sec == 0 ? 8.0f * QSCALE : 1.0f;
            f32x4 gl[2][2];
#pragma unroll
            for (int bj = 0; bj < 2; ++bj)
#pragma unroll
                for (int n = 0; n < 2; ++n) gl[bj][n] = *(const f32x4*)(g + 16 * fq + 8 * bj + 4 * n);
#pragma unroll
            for (int ai = 0; ai < 2; ++ai)
#pragma unroll
                for (int m = 0; m < 4; ++m) {
                    float ss = 0.f;
#pragma unroll
                    for (int bj = 0; bj < 2; ++bj)
#pragma unroll
                        for (int n = 0; n < 2; ++n) { const f32x4 v = acc[ai][bj][m][n]; ss += (v[0] * v[0] + v[1] * v[1]) + (v[2] * v[2] + v[3] * v[3]); }
                    ss += __shfl_xor(ss, 16); ss += __shfl_xor(ss, 32);
                    const float rr = rsqrtf(ss * (1.0f / 64.0f) + EPS) * sc;
                    u32x4 w;
#pragma unroll
                    for (int bj = 0; bj < 2; ++bj) { const f32x4 v0 = acc[ai][bj][m][0] * rr * gl[bj][0], v1 = acc[ai][bj][m][1] * rr * gl[bj][1]; w[2 * bj] = cvt_pk4_fp8(v0[0], v0[1], v0[2], v0[3]); w[2 * bj + 1] = cvt_pk4_fp8(v1[0], v1[1], v1[2], v1[3]); }
                    *(u32x4*)((unsigned char*)O + (size_t)(row0 + ai * 128 + m * 16) * 512 + (u.pn & 1) * 256 + 64 * wc + 16 * fq) = w;
                }
        } else {
#pragma unroll
            for (int ai = 0; ai < 2; ++ai)
#pragma unroll
                for (int m = 0; m < 4; ++m) { bf16_t* rowp = V + (size_t)(row0 + ai * 128 + m * 16) * 512 + (u.pn & 1) * 256 + 64 * wc + 16 * fq;
#pragma unroll
                    for (int bj = 0; bj < 2; ++bj) *(u32x4*)(rowp + 8 * bj) = pack8(acc[ai][bj][m][0], acc[ai][bj][m][1]); }
        }
    }
};
struct EpiFourier {
    static constexpr bool PERM = true, WIDE = true;
    bf16_t* Bdft; const float* vr;
    struct Pre {};
    __device__ __forceinline__ void prefetch(Pre&, const pg8::Unit&, int, int, int, int) const {}
    __device__ __forceinline__ void init(f32x4 (&acc)[2][2][4][2], const Pre&) const {
#pragma unroll
        for (int a = 0; a < 2; ++a)
#pragma unroll
            for (int b = 0; b < 2; ++b)
#pragma unroll
                for (int m = 0; m < 4; ++m)
#pragma unroll
                    for (int n = 0; n < 2; ++n) acc[a][b][m][n] = (f32x4){0.f, 0.f, 0.f, 0.f}; }
    __device__ __forceinline__ void operator()(AccRef acc, const pg8::Unit& u, int wr, int wc, int fr, int fq, const Pre& PR) const {
        const int half = u.pm >> 1, pnl = u.pn - 64 * half, b = pnl >> 3, j0 = (pnl & 7) * 256;
        const int n0 = (u.pm & 1) * 256 + wr * 64 + fr;
        const bool patch = (half == 1) && (j0 == 0) && (wc == 0) && (fq == 0);
#pragma unroll
        for (int ai = 0; ai < 2; ++ai)
#pragma unroll
            for (int m = 0; m < 4; ++m) { const int n = n0 + ai * 128 + m * 16; u32x4 w;
#pragma unroll
                for (int bj = 0; bj < 2; ++bj) { f32x4 v0 = acc[ai][bj][m][0]; if (patch && bj == 0) v0[0] = vr[b * 512 + n];
                    const f32x4 v1 = acc[ai][bj][m][1]; w[2 * bj] = cvt_pk4_fp8(v0[0], v0[1], v0[2], v0[3]); w[2 * bj + 1] = cvt_pk4_fp8(v1[0], v1[1], v1[2], v1[3]); }
                *(u32x4*)((unsigned char*)Bdft + (size_t)(b * 512 + n) * 4096 + half * 2048 + j0 + 64 * wc + 16 * fq) = w; }
    }
};
struct EpiDft {
    static constexpr bool PERM = true, WIDE = true;
    bf16_t* Amix;
    struct Pre {};
    __device__ __forceinline__ void prefetch(Pre&, const pg8::Unit&, int, int, int, int) const {}
    __device__ __forceinline__ void init(f32x4 (&acc)[2][2][4][2], const Pre&) const {
#pragma unroll
        for (int a = 0; a < 2; ++a)
#pragma unroll
            for (int b = 0; b < 2; ++b)
#pragma unroll
                for (int m = 0; m < 4; ++m)
#pragma unroll
                    for (int n = 0; n < 2; ++n) acc[a][b][m][n] = (f32x4){0.f, 0.f, 0.f, 0.f}; }
    __device__ __forceinline__ void operator()(AccRef acc, const pg8::Unit& u, int wr, int wc, int fr, int fq, const Pre& PR) const {
        const int b = u.pn >> 1, col0 = (u.pn & 1) * 256 + 64 * wc + 16 * fq, k0 = u.pm * 256 + wr * 64 + fr;
#pragma unroll
        for (int ai = 0; ai < 2; ++ai)
#pragma unroll
            for (int m = 0; m < 4; ++m) { bf16_t* rowp = Amix + (size_t)(b * 4096 + k0 + ai * 128 + m * 16) * 1024 + col0;
#pragma unroll
                for (int bj = 0; bj < 2; ++bj) *(u32x4*)(rowp + 8 * bj) = pack8(acc[ai][bj][m][0], acc[ai][bj][m][1]); }
    }
};
struct EpiOut {
    static constexpr bool PERM = true, WIDE = true;
    const float* x; const float* mod; bf16_t* x1;
    struct Pre {};
    __device__ __forceinline__ void prefetch(Pre&, const pg8::Unit&, int, int, int, int) const {}
    __device__ __forceinline__ void init(f32x4 (&acc)[2][2][4][2], const Pre&) const {
#pragma unroll
        for (int a = 0; a < 2; ++a)
#pragma unroll
            for (int b = 0; b < 2; ++b)
#pragma unroll
                for (int m = 0; m < 4; ++m)
#pragma unroll
                    for (int n = 0; n < 2; ++n) acc[a][b][m][n] = (f32x4){0.f, 0.f, 0.f, 0.f}; }
    __device__ __forceinline__ void operator()(AccRef acc, const pg8::Unit& u, int wr, int wc, int fr, int fq, const Pre& PR) const {
        const int row0 = u.pm * 256 + wr * 64 + fr, col0 = u.pn * 256 + wc * 64 + 16 * fq, b = (u.pm * 256) >> 12;
        f32x4 gt[2][2];
#pragma unroll
        for (int bj = 0; bj < 2; ++bj)
#pragma unroll
            for (int n = 0; n < 2; ++n) gt[bj][n] = *(const f32x4*)(mod + b * 6144 + 2048 + col0 + bj * 8 + n * 4);
#pragma unroll
        for (int ai = 0; ai < 2; ++ai) {
            f32x4 xs[4][2][2];
#pragma unroll
            for (int m = 0; m < 4; ++m) { const size_t off = (size_t)(row0 + ai * 128 + m * 16) * 1024 + col0;
#pragma unroll
                for (int bj = 0; bj < 2; ++bj) { xs[m][bj][0] = *(const f32x4*)(x + off + bj * 8); xs[m][bj][1] = *(const f32x4*)(x + off + bj * 8 + 4); } }
#pragma unroll
            for (int m = 0; m < 4; ++m) { const size_t off = (size_t)(row0 + ai * 128 + m * 16) * 1024 + col0;
#pragma unroll
                for (int bj = 0; bj < 2; ++bj) *(u32x4*)(x1 + off + bj * 8) = pack8(xs[m][bj][0] + gt[bj][0] * acc[ai][bj][m][0], xs[m][bj][1] + gt[bj][1] * acc[ai][bj][m][1]); } }
    }
};
struct EpiSwiglu {
    static constexpr bool PERM = true, WIDE = false;
    bf16_t* act; const float* b1p; const LAS unsigned char* tile_e;
    struct Pre { f32x4 bg[2], bl[2]; };
    __device__ __forceinline__ void prefetch(Pre& P, const pg8::Unit& u, int wr, int wc, int fr, int fq) const {
        const int e = __builtin_amdgcn_readfirstlane((int)tile_e[u.pm]); const float* bp = b1p + e * 2048 + u.pn * 256 + 32 * wc + 8 * fq;
#pragma unroll
        for (int n = 0; n < 2; ++n) { P.bg[n] = *(const f32x4*)(bp + 4 * n); P.bl[n] = *(const f32x4*)(bp + 128 + 4 * n); }
    }
    __device__ __forceinline__ void init(f32x4 (&acc)[2][2][4][2], const Pre& P) const {
#pragma unroll
        for (int a = 0; a < 2; ++a)
#pragma unroll
            for (int m = 0; m < 4; ++m)
#pragma unroll
                for (int n = 0; n < 2; ++n) { acc[a][0][m][n] = P.bg[n]; acc[a][1][m][n] = P.bl[n]; } }
    __device__ __forceinline__ void operator()(AccRef acc, const pg8::Unit& u, int wr, int wc, int fr, int fq, const Pre& PR) const {
        const int row0 = u.pm * 256 + wr * 64 + fr, pc = 32 * wc + 8 * fq;
#pragma unroll
        for (int ai = 0; ai < 2; ++ai)
#pragma unroll
            for (int m = 0; m < 4; ++m) { f32x4 o[2];
#pragma unroll
                for (int n = 0; n < 2; ++n) { const f32x4 g = acc[ai][0][m][n], l = acc[ai][1][m][n];
#pragma unroll
                    for (int i = 0; i < 4; ++i) { const float gg = fmaxf(g[i], 7.0f * SWG_C), ll = __builtin_amdgcn_fmed3f(l[i], -6.0f / SWG_C, 8.0f / SWG_C);
                        o[n][i] = gg * ll * __builtin_amdgcn_rcpf(1.0f + __builtin_amdgcn_exp2f(gg)); } }
                u32x2 w8; w8.x = cvt_pk4_fp8(o[0][0], o[0][1], o[0][2], o[0][3]); w8.y = cvt_pk4_fp8(o[1][0], o[1][1], o[1][2], o[1][3]);
                *(u32x2*)((unsigned char*)act + (size_t)(row0 + ai * 128 + m * 16) * 1024 + u.pn * 128 + pc) = w8; }
    }
};
struct EpiDown {
    static constexpr bool PERM = true, WIDE = true;
    bf16_t* slab; const float* b2; const float* slot_gate; const LAS unsigned char* tile_e; const LAS int* tstart;
    struct Pre { f32x4 bv[2][2]; float g[2][4]; };
    __device__ __forceinline__ void prefetch(Pre& P, const pg8::Unit& u, int wr, int wc, int fr, int fq) const {
        const int e = __builtin_amdgcn_readfirstlane((int)tile_e[u.pm]); const int col0 = u.pn * 256 + 64 * wc + 16 * fq;
        { const float* gp = slot_gate + (size_t)e * CAP + __builtin_amdgcn_readfirstlane((u.pm - tstart[e]) * 256) + wr * 64 + fr;
#pragma unroll
          for (int ai = 0; ai < 2; ++ai)
#pragma unroll
              for (int m = 0; m < 4; ++m) P.g[ai][m] = gp[ai * 128 + m * 16]; }
#pragma unroll
        for (int bj = 0; bj < 2; ++bj)
#pragma unroll
            for (int n = 0; n < 2; ++n) P.bv[bj][n] = *(const f32x4*)(b2 + e * 1024 + col0 + 8 * bj + 4 * n);
    }
    __device__ __forceinline__ void init(f32x4 (&acc)[2][2][4][2], const Pre& P) const {
#pragma unroll
        for (int a = 0; a < 2; ++a)
#pragma unroll
            for (int b = 0; b < 2; ++b)
#pragma unroll
                for (int m = 0; m < 4; ++m)
#pragma unroll
                    for (int n = 0; n < 2; ++n) acc[a][b][m][n] = P.bv[b][n]; }
    __device__ __forceinline__ void operator()(AccRef acc, const pg8::Unit& u, int wr, int wc, int fr, int fq, const Pre& PR) const {
        const int e = __builtin_amdgcn_readfirstlane((int)tile_e[u.pm]); const int rl = wr * 64 + fr, col0 = u.pn * 256 + 64 * wc + 16 * fq;
        const float* gp = slot_gate + (size_t)e * CAP + __builtin_amdgcn_readfirstlane((u.pm - tstart[e]) * 256) + rl;
#pragma unroll
        for (int ai = 0; ai < 2; ++ai)
#pragma unroll
            for (int m = 0; m < 4; ++m) { const float gate = PR.g[ai][m] * 16.0f;
                u32x4 w;
#pragma unroll
                for (int bj = 0; bj < 2; ++bj) { const f32x4 v0 = acc[ai][bj][m][0] * gate, v1 = acc[ai][bj][m][1] * gate;
                    w[2 * bj] = cvt_pk4_fp8(v0[0], v0[1], v0[2], v0[3]); w[2 * bj + 1] = cvt_pk4_fp8(v1[0], v1[1], v1[2], v1[3]); }
                *(u32x4*)((unsigned char*)slab + (size_t)(u.pm * 256 + rl + ai * 128 + m * 16) * 1024 + col0) = w; }
    }
};

namespace att {
constexpr int QB = 256, KVB = 64, NT = SEQ / KVB;
constexpr int L_K = 0, L_V = 32768, L_Q = 65536;
#define SBAR() __builtin_amdgcn_sched_barrier(0)
__device__ __forceinline__ int crow(int r, int hi) { return (r & 3) + 8 * (r >> 2) + 4 * hi; }
__device__ __forceinline__ int swap23(int k) { return (k & ~0xC) | ((k & 4) << 1) | ((k & 8) >> 1); }
__device__ __forceinline__ int v_rd_base(int lane) { return ((lane & 3) << 3) | (((lane >> 2) & 3) << 6) | (((lane >> 4) & 1) << 5) | (((lane >> 5) & 1) << 8); }
constexpr int v_rd_off(int d0, int ks, int half) { return d0 * 512 + ks * 4096 + half * 2048; }
typedef short v4i16_t __attribute__((ext_vector_type(4)));
template <int OFF> __device__ __forceinline__ s16x4 tr_read(int vb) { return __builtin_bit_cast(s16x4, __builtin_amdgcn_ds_read_tr16_b64_v4i16((LAS v4i16_t*)(uintptr_t)(unsigned)(vb + OFF))); }
#define PKV(L, H) (bf16x8){L[0], L[1], L[2], L[3], H[0], H[1], H[2], H[3]}
typedef __bf16 bf16x2_t __attribute__((ext_vector_type(2)));
__device__ __forceinline__ unsigned cvt_pk_s(float lo, float hi) { f32x2 v = {lo, hi}; bf16x2_t b = __builtin_convertvector(v, bf16x2_t); return __builtin_bit_cast(unsigned, b); }
#define ATT_MFMA(o, a, b) asm volatile("s_nop 1\n\tv_mfma_f32_32x32x16_bf16 %0, %1, %2, %0" : "+v"(o) : "v"(a), "v"(b))
template <int D0, int KB> __device__ __forceinline__ void pv_blk2(f32x16& oA, f32x16& oB, int vb, const bf16x8 (&pa)[2]) {
    const s16x4 l0 = tr_read<v_rd_off(D0, 2 * KB, 0)>(vb), h0 = tr_read<v_rd_off(D0, 2 * KB, 1)>(vb), l1 = tr_read<v_rd_off(D0, 2 * KB + 1, 0)>(vb), h1 = tr_read<v_rd_off(D0, 2 * KB + 1, 1)>(vb);
    const s16x4 m0 = tr_read<v_rd_off(D0 + 1, 2 * KB, 0)>(vb), n0 = tr_read<v_rd_off(D0 + 1, 2 * KB, 1)>(vb), m1 = tr_read<v_rd_off(D0 + 1, 2 * KB + 1, 0)>(vb), n1 = tr_read<v_rd_off(D0 + 1, 2 * KB + 1, 1)>(vb);
    const bf16x8 va0 = PKV(l0, h0), vb0_ = PKV(m0, n0), va1 = PKV(l1, h1), vb1_ = PKV(m1, n1);
    ATT_MFMA(oA, pa[0], va0); ATT_MFMA(oB, pa[0], vb0_); ATT_MFMA(oA, pa[1], va1); ATT_MFMA(oB, pa[1], vb1_);
}
__device__ __forceinline__ void qkt2(f32x16& p0, f32x16& p1, const LAS unsigned char* kb, const LAS unsigned char* qb, const int (&co)[4], int off) {
    p0 = f32x16{}; p1 = f32x16{};
#pragma unroll
    for (int d0 = 0; d0 < 4; ++d0) { const bf16x8 k0 = *(const LAS bf16x8*)(kb + co[d0] + off), qf = *(const LAS bf16x8*)(qb + co[d0]);
        p0 = __builtin_amdgcn_mfma_f32_32x32x16_bf16(k0, qf, p0, 0, 0, 0); }
#pragma unroll
    for (int d0 = 0; d0 < 4; ++d0) { const bf16x8 k1 = *(const LAS bf16x8*)(kb + co[d0] + off + 128), qf = *(const LAS bf16x8*)(qb + co[d0] + 128);
        p1 = __builtin_amdgcn_mfma_f32_32x32x16_bf16(k1, qf, p1, 0, 0, 0); }
}
__device__ __forceinline__ void add_bias(f32x16& p, const LAS float* bt, int relb, int hi) {
#pragma unroll
    for (int r = 0; r < 16; ++r) { const int i0 = relb + crow(r, hi); p[r] += bt[i0 < 0 ? 0 : (i0 > 254 ? 254 : i0)]; }
}
template <int Q> __device__ __forceinline__ float sm_part(const f32x16& p, bf16x8& out) {
    float e[8];
#pragma unroll
    for (int j = 0; j < 8; ++j) e[j] = __builtin_amdgcn_exp2f(p[8 * Q + j]);
    const float ps = ((e[0] + e[1]) + (e[2] + e[3])) + ((e[4] + e[5]) + (e[6] + e[7]));
    u32x4 w = {cvt_pk_s(e[0], e[1]), cvt_pk_s(e[2], e[3]), cvt_pk_s(e[4], e[5]), cvt_pk_s(e[6], e[7])};
    out = __builtin_bit_cast(bf16x8, w); return ps;
}
template <int KB> __device__ __forceinline__ void half_tile(f32x16 (&o1)[4], f32x16 (&o2)[4], float& l1, float& l2, const LAS unsigned char* kbuf, const LAS unsigned char* qbase, const int (&co)[4],
                                                            int vb, bool band, const LAS float* bt, int relb, int hi) {
    f32x16 p0, p1; bf16x8 pa[2], pb[2];
    qkt2(p0, p1, kbuf, qbase, co, KB * 8192);
    if (band) { add_bias(p0, bt, relb + 32 * KB, hi); add_bias(p1, bt, relb + 32 * KB, hi); }
    l1 += sm_part<0>(p0, pa[0]); l1 += sm_part<1>(p0, pa[1]);
    unsigned w[8]; float ls = 0.f;
#define SM_GAP(k) do { float a_ = p1[2 * (k)], b_ = p1[2 * (k) + 1]; asm volatile("" : "+v"(a_), "+v"(b_)); a_ = __builtin_amdgcn_exp2f(a_); b_ = __builtin_amdgcn_exp2f(b_); ls += a_ + b_; w[k] = cvt_pk_s(a_, b_); } while (0)
    { const s16x4 l0 = tr_read<v_rd_off(0, 2 * KB, 0)>(vb), h0 = tr_read<v_rd_off(0, 2 * KB, 1)>(vb), l1_ = tr_read<v_rd_off(0, 2 * KB + 1, 0)>(vb), h1 = tr_read<v_rd_off(0, 2 * KB + 1, 1)>(vb);
      const s16x4 m0 = tr_read<v_rd_off(1, 2 * KB, 0)>(vb), n0 = tr_read<v_rd_off(1, 2 * KB, 1)>(vb), m1 = tr_read<v_rd_off(1, 2 * KB + 1, 0)>(vb), n1 = tr_read<v_rd_off(1, 2 * KB + 1, 1)>(vb);
      const bf16x8 va0 = PKV(l0, h0), vb0_ = PKV(m0, n0), va1 = PKV(l1_, h1), vb1_ = PKV(m1, n1);
      ATT_MFMA(o1[0], pa[0], va0); SM_GAP(0); ATT_MFMA(o1[1], pa[0], vb0_); SM_GAP(1); ATT_MFMA(o1[0], pa[1], va1); SM_GAP(2); ATT_MFMA(o1[1], pa[1], vb1_); SM_GAP(3); }
    { const s16x4 l0 = tr_read<v_rd_off(2, 2 * KB, 0)>(vb), h0 = tr_read<v_rd_off(2, 2 * KB, 1)>(vb), l1_ = tr_read<v_rd_off(2, 2 * KB + 1, 0)>(vb), h1 = tr_read<v_rd_off(2, 2 * KB + 1, 1)>(vb);
      const s16x4 m0 = tr_read<v_rd_off(3, 2 * KB, 0)>(vb), n0 = tr_read<v_rd_off(3, 2 * KB, 1)>(vb), m1 = tr_read<v_rd_off(3, 2 * KB + 1, 0)>(vb), n1 = tr_read<v_rd_off(3, 2 * KB + 1, 1)>(vb);
      const bf16x8 va0 = PKV(l0, h0), vb0_ = PKV(m0, n0), va1 = PKV(l1_, h1), vb1_ = PKV(m1, n1);
      ATT_MFMA(o1[2], pa[0], va0); SM_GAP(4); ATT_MFMA(o1[3], pa[0], vb0_); SM_GAP(5); ATT_MFMA(o1[2], pa[1], va1); SM_GAP(6); ATT_MFMA(o1[3], pa[1], vb1_); SM_GAP(7); }
#undef SM_GAP
    l2 += ls;
    { u32x4 w0 = {w[0], w[1], w[2], w[3]}, w1 = {w[4], w[5], w[6], w[7]}; pb[0] = __builtin_bit_cast(bf16x8, w0); pb[1] = __builtin_bit_cast(bf16x8, w1); }
    pv_blk2<0, KB>(o2[0], o2[1], vb, pb); pv_blk2<2, KB>(o2[2], o2[3], vb, pb);
}

struct Tensors { const bf16_t *Q, *K, *V; bf16_t* Amix; const float* btab; const float* gsub; float lam; const float *w1, *w2; unsigned char *w1t, *w2t; int gw0; };

__device__ __forceinline__ void attn_unit(LAS unsigned char* lds, const Tensors& T, int b, int h, int qb) {
    int tid_ = threadIdx.x; asm volatile("" : "+v"(tid_));
    const int tid = tid_, lane = tid & 63, r32 = lane & 31, hi = lane >> 5; const int wid = __builtin_amdgcn_readfirstlane(tid >> 6);
    const size_t rowbase = (size_t)b * SEQ; const int q0 = qb * QB;
    const bf16_t* Kh = T.K + rowbase * 512 + h * 128; const bf16_t* Vh = T.V + rowbase * 512 + h * 128; const bf16_t* Qh = T.Q + (rowbase + q0) * 512 + h * 128;
    LAS float* bt = (LAS float*)(lds + SP_BT); LAS float* wsf = (LAS float*)(lds + SP_WS) + wid * 64;
    unsigned ksrc[2], vsrc[2];
#pragma unroll
    for (int i = 0; i < 2; ++i) { const int p = wid * 2 + i; const int row = 4 * p + (lane >> 4), ch = (lane & 15) ^ (row & 7); ksrc[i] = (unsigned)(row * 512 + ch * 8) * 2u;
        const int st = 2 * p + (lane >> 5), kk = (st >> 2) * 8 + ((lane & 31) >> 2), cc = (st & 3) * 32 + (lane & 3) * 8; vsrc[i] = (unsigned)(kk * 512 + cc) * 2u; }
    const unsigned ldsw = (unsigned)wid * 2048u;
#define DMA_TILE(t, buf) do { const char* kg = (const char*)(Kh + (size_t)(t) * KVB * 512); const char* vg = (const char*)(Vh + (size_t)(t) * KVB * 512); \
    _Pragma("unroll") for (int _i = 0; _i < 2; ++_i) { \
        __builtin_amdgcn_global_load_lds((const unsigned*)(kg + ksrc[_i]), (LAS unsigned*)(lds + L_K + (buf) * 16384 + ldsw + _i * 1024), 16, 0, 0); \
        __builtin_amdgcn_global_load_lds((const unsigned*)(vg + vsrc[_i]), (LAS unsigned*)(lds + L_V + (buf) * 16384 + ldsw + _i * 1024), 16, 0, 0); } } while (0)
    { int lq = lane; asm volatile("" : "+v"(lq));
      const int rq = lq >> 4; const unsigned qo0 = (unsigned)((32 * wid + rq) * 512 + (((lq & 15) ^ (rq & 7)) << 3)) * 2u, qo1 = (unsigned)((32 * wid + 4 + rq) * 512 + (((lq & 15) ^ ((4 + rq) & 7)) << 3)) * 2u;
#pragma unroll
      for (int i = 0; i < 8; ++i) { const int p = wid * 8 + i;
        __builtin_amdgcn_global_load_lds((const unsigned*)((const char*)Qh + ((i & 1) ? qo1 : qo0) + (size_t)(i >> 1) * 8192), (LAS unsigned*)(lds + L_Q + p * 1024), 16, 0, 0); } }
    DMA_TILE(0, 0);
    if (tid < 255) bt[tid] = T.btab[h * 256 + tid];
    int co[4];
#pragma unroll
    for (int d0 = 0; d0 < 4; ++d0) co[d0] = r32 * 256 + (((2 * d0 + hi) ^ (r32 & 7)) << 4);
    const LAS unsigned char* qbase = lds + L_Q + wid * 8192;
    const int vb0 = (int)(uintptr_t)(lds + L_V) + v_rd_base(lane);
    f32x16 o1[4], o2[4];
#pragma unroll
    for (int d = 0; d < 4; ++d) { o1[d] = f32x16{}; o2[d] = f32x16{}; }
    float l1 = 0.f, l2 = 0.f;
    const int qw = q0 + wid * 32;
    int state = (qw >= 154) ? 0 : 1;
    __syncthreads();
    for (int t = 0; t < NT; ++t) {
        const int buf = t & 1;
        if (t + 1 < NT) DMA_TILE(t + 1, buf ^ 1);
        const int k0 = t * KVB;
        const bool isneg = (k0 <= qw - 154), ispos = (k0 >= qw + 122);
        if (state == 0 && !isneg) { const float f = __builtin_amdgcn_exp2f(bt[0]); state = 1;
#pragma unroll
            for (int d = 0; d < 4; ++d) { o1[d] *= f; o2[d] *= f; }
            l1 *= f; l2 *= f; }
        if (state == 1 && ispos) { const float f = __builtin_amdgcn_exp2f(-bt[254]); state = 2;
#pragma unroll
            for (int d = 0; d < 4; ++d) { o1[d] *= f; o2[d] *= f; }
            l1 *= f; l2 *= f; }
        const LAS unsigned char* kbuf = lds + L_K + buf * 16384;
        const int vb = vb0 + buf * 16384; const int relb = k0 - (qw + r32) + 127;
        half_tile<0>(o1, o2, l1, l2, kbuf, qbase, co, vb, state == 1, bt, relb, hi);
        half_tile<1>(o1, o2, l1, l2, kbuf, qbase, co, vb, state == 1, bt, relb, hi);
        __syncthreads();
    }
#undef DMA_TILE
    l1 += __shfl_xor(l1, 32); l2 += __shfl_xor(l2, 32);
    if (hi == 0) { wsf[r32] = 1.0f / l1; wsf[32 + r32] = T.lam / l2; }
    LDS_WAIT();
    float gs[4];
#pragma unroll
    for (int d = 0; d < 4; ++d) gs[d] = T.gsub[32 * d + r32] * (1.0f - LAM_INIT);
    bf16_t* Ow = T.Amix + (rowbase + q0 + wid * 32 + 4 * hi) * 1024 + 512 + h * 128 + r32; asm volatile("" : "+v"(Ow));
#pragma unroll
    for (int r = 0; r < 16; ++r) { const int row = crow(r, hi); const float c1 = wsf[row], c2 = wsf[32 + row];
        float y[4], ss = 0.f;
#pragma unroll
        for (int d = 0; d < 4; ++d) { y[d] = o1[d][r] * c1 - o2[d][r] * c2; ss += y[d] * y[d]; }
        ss += __shfl_xor(ss, 1); ss += __shfl_xor(ss, 2); ss += __shfl_xor(ss, 4); ss += __shfl_xor(ss, 8); ss += __shfl_xor(ss, 16);
        const float rr = rsqrtf(ss * (1.0f / 128.0f) + EPS);
#pragma unroll
        for (int d = 0; d < 4; ++d) Ow[(size_t)((r & 3) + 8 * (r >> 2)) * 1024 + 32 * d] = (bf16_t)(cvt_pk_bf16(y[d] * rr * gs[d], 0.f) & 0xffffu); }
    __syncthreads();
}

constexpr int P_K = 0, P_V = 32768, P_Q = 81920;
#define A_RD128(dst, addr, off) asm volatile("ds_read_b128 %0, %1 offset:%2" : "=v"(dst) : "v"(addr), "i"(off))
#define A_RDTR(dst, addr, off) asm volatile("ds_read_b64_tr_b16 %0, %1 offset:%2" : "=v"(dst) : "v"(addr), "i"(off))
#define A_WAITL(n) asm volatile("s_waitcnt lgkmcnt(" #n ")" ::: "memory")
#define A_WAIT4(n, r0, r1, r2, r3) asm volatile("s_waitcnt lgkmcnt(" #n ")" : "+v"(r0), "+v"(r1), "+v"(r2), "+v"(r3) :: "memory")
#define A_MFMA0(d, a, b) asm volatile("s_nop 1\n\tv_mfma_f32_32x32x16_bf16 %0, %1, %2, 0" : "=&v"(d) : "v"(a), "v"(b))
#define A_MFMA(d, a, b) asm volatile("s_nop 1\n\tv_mfma_f32_32x32x16_bf16 %0, %1, %2, %0" : "+v"(d) : "v"(a), "v"(b))
#define A_PAD() asm volatile("s_nop 7\n\ts_nop 7" ::: "memory")

__device__ __forceinline__ void attn_unit2(LAS unsigned char* lds, const Tensors& T, int b, int h, int qb, const int wid_in) {
    const int lane = lane_now(), r32 = lane & 31, hi = lane >> 5; const int wid = __builtin_amdgcn_readfirstlane(wid_in); const int tid = wid * 64 + lane;
    const size_t rowbase = (size_t)b * SEQ; const int q0 = qb * QB;
    const bf16_t* Kh = T.K + rowbase * 512 + h * 128; const bf16_t* Vh = T.V + rowbase * 512 + h * 128; const bf16_t* Qh = T.Q + (rowbase + q0) * 512 + h * 128;
    LAS float* bt = (LAS float*)(lds + SP_BT); LAS float* wsf = (LAS float*)(lds + SP_WS) + wid * 64;
    unsigned ksrc[2], vsrc[2];
#pragma unroll
    for (int i = 0; i < 2; ++i) { const int p = wid * 2 + i; const int row = 4 * p + (lane >> 4), ch = (lane & 15) ^ (row & 7); ksrc[i] = (unsigned)(row * 512 + ch * 8) * 2u;
        const int st = 2 * p + (lane >> 5), kk = (st >> 2) * 8 + ((lane & 31) >> 2), cc = (st & 3) * 32 + (lane & 3) * 8; vsrc[i] = (unsigned)(kk * 512 + cc) * 2u; }
    const unsigned ldsw = (unsigned)wid * 2048u;
#define ATT_GLDS(sbase, vo, ldsdst) do { unsigned keep_; asm volatile("s_mov_b32 %0, m0\n\ts_mov_b32 m0, %3\n\ts_nop 0\n\tglobal_load_lds_dwordx4 %1, %2\n\ts_mov_b32 m0, %0" \
        : "=&s"(keep_) : "v"(vo), "s"(sbase), "s"(ldsdst) : "memory"); } while (0)
    const unsigned ldsb_ = (unsigned)(uintptr_t)lds;
#define DMA_KV(t) do { const char* kg = (const char*)(Kh + (size_t)(t) * KVB * 512); const char* vg = (const char*)(Vh + (size_t)(t) * KVB * 512); const int kb_ = ((t) & 1) * 16384, vb_ = ((t) % 3) * 16384; \
    _Pragma("unroll") for (int _i = 0; _i < 2; ++_i) { \
        ATT_GLDS(kg, ksrc[_i], (unsigned)__builtin_amdgcn_readfirstlane((int)(ldsb_ + P_K + kb_ + ldsw + _i * 1024))); \
        ATT_GLDS(vg, vsrc[_i], (unsigned)__builtin_amdgcn_readfirstlane((int)(ldsb_ + P_V + vb_ + ldsw + _i * 1024))); } } while (0)
    { int lq = lane; asm volatile("" : "+v"(lq));
      const int rq = lq >> 4; const unsigned qo0 = (unsigned)((32 * wid + rq) * 512 + (((lq & 15) ^ (rq & 7)) << 3)) * 2u, qo1 = (unsigned)((32 * wid + 4 + rq) * 512 + (((lq & 15) ^ ((4 + rq) & 7)) << 3)) * 2u;
#pragma unroll
      for (int i = 0; i < 8; ++i) { const int p = wid * 8 + i;
        __builtin_amdgcn_global_load_lds((const unsigned*)((const char*)Qh + ((i & 1) ? qo1 : qo0) + (size_t)(i >> 1) * 8192), (LAS unsigned*)(lds + P_Q + p * 1024), 16, 0, 0); } }
    DMA_KV(0); DMA_KV(1);
    if (tid < 255) bt[tid] = T.btab[h * 256 + tid];
    int kco[4]; const int qdelta = (P_Q - P_K) + wid * 8192;
#pragma unroll
    for (int d0 = 0; d0 < 4; ++d0) { const int c = r32 * 256 + (((2 * d0 + hi) ^ (r32 & 7)) << 4); kco[d0] = (int)(uintptr_t)(lds + P_K) + c; }
    const int vb0 = (int)(uintptr_t)(lds + P_V) + v_rd_base(lane);
    f32x16 o1[4], o2[4];
#pragma unroll
    for (int d = 0; d < 4; ++d) { o1[d] = f32x16{}; o2[d] = f32x16{}; }
    float l1 = 0.f, l2 = 0.f;
    const int qw = q0 + wid * 32;
    f32x16 P; bf16x8 pa[2], kf[4], qf[4]; unsigned pw[8]; s16x4 vA[4], vB[4];
#define TCLASS(t) ((64 * (t) <= qw - 154) ? 0 : ((64 * (t) >= qw + 122) ? 2 : 1))
#define LOAD_KQ(d0, ka, J2) do { A_RD128(kf[d0], ka, ((J2) & 1) * 8192 + ((J2) >> 1) * 128); A_RD128(qf[d0], kco[d0] + qdelta, ((J2) >> 1) * 128); } while (0)
#define LOAD_K(d0, ka, J2) do { A_RD128(kf[d0], ka, ((J2) & 1) * 8192 + ((J2) >> 1) * 128); } while (0)
#define SLICE(k) do { asm volatile("" : "+v"(P), "+v"(lsum)); const float a_ = __builtin_amdgcn_exp2f(P[2 * (k)]), b_ = __builtin_amdgcn_exp2f(P[2 * (k) + 1]); lsum += a_ + b_; pw[k] = cvt_pk_s(a_, b_); } while (0)
#define BIAS_P(t1, h1) do { const int rb_ = 64 * (t1) + 32 * (h1) - (qw + r32) + 127; _Pragma("unroll") for (int r = 0; r < 16; ++r) { const int i0 = rb_ + crow(r, hi); P[r] += bt[i0 < 0 ? 0 : (i0 > 254 ? 254 : i0)]; } } while (0)
#define PACK_PA() do { u32x4 w0_ = {pw[0], pw[1], pw[2], pw[3]}, w1_ = {pw[4], pw[5], pw[6], pw[7]}; pa[0] = __builtin_bit_cast(bf16x8, w0_); pa[1] = __builtin_bit_cast(bf16x8, w1_); } while (0)
#define RD_V(buf, vaddr, d0, hf) do { A_RDTR(buf[0], vaddr, v_rd_off(d0, 2 * (hf), 0)); A_RDTR(buf[1], vaddr, v_rd_off(d0, 2 * (hf), 1)); A_RDTR(buf[2], vaddr, v_rd_off(d0, 2 * (hf) + 1, 0)); A_RDTR(buf[3], vaddr, v_rd_off(d0, 2 * (hf) + 1, 1)); } while (0)
    asm volatile("s_waitcnt vmcnt(0)" ::: "memory");
    __syncthreads();
#define ITER(TT, J, MODE, QKF, LDF) do { const int t = (TT); \
    const int n_ = 4 * t + (J); constexpr int J1 = ((J) + 1) & 3, J2 = ((J) + 2) & 3, HF = (J) & 1; constexpr bool yq_ = ((J) & 1) != 0, xq_ = ((J) & 1) == 0;     \
    const int t1_ = t + ((J) == 3 ? 1 : 0), t2_ = t + ((J) >= 2 ? 1 : 0); \
    const int va_ = vb0 + (t % 3) * 16384; float lsum = 0.f; constexpr bool qk_ = (QKF), ld_ = (LDF); (void)n_; \
    const int kofs1_ = (t1_ & 1) * 16384, kofs2_ = (t2_ & 1) * 16384; \
    if (qk_) { if (yq_) { LOAD_KQ(2, kco[2] + kofs1_, J1); LOAD_KQ(3, kco[3] + kofs1_, J1); } else { LOAD_K(2, kco[2] + kofs1_, J1); LOAD_K(3, kco[3] + kofs1_, J1); } } \
    RD_V(vA, va_, 0, HF); \
    if (qk_) { if (yq_) A_WAIT4(8, kf[0], qf[0], kf[1], qf[1]); else A_WAIT4(6, kf[0], qf[0], kf[1], qf[1]); A_MFMA0(P, kf[0], qf[0]); A_MFMA(P, kf[1], qf[1]); A_WAIT4(4, kf[2], qf[2], kf[3], qf[3]); A_MFMA(P, kf[2], qf[2]); A_MFMA(P, kf[3], qf[3]); } \
    RD_V(vB, va_, 1, HF); \
    A_WAIT4(4, vA[0], vA[1], vA[2], vA[3]); \
    if ((J) >> 1) { A_MFMA(o2[0], pa[0], PKV(vA[0], vA[1])); } else { A_MFMA(o1[0], pa[0], PKV(vA[0], vA[1])); } \
    if (qk_) { A_PAD(); if (MODE) BIAS_P(t1_, J1 & 1); SLICE(0); } \
    if ((J) >> 1) { A_MFMA(o2[0], pa[1], PKV(vA[2], vA[3])); } else { A_MFMA(o1[0], pa[1], PKV(vA[2], vA[3])); } \
    if (qk_) SLICE(1); \
    A_WAIT4(0, vB[0], vB[1], vB[2], vB[3]); \
    if ((J) >> 1) { A_MFMA(o2[1], pa[0], PKV(vB[0], vB[1])); } else { A_MFMA(o1[1], pa[0], PKV(vB[0], vB[1])); } \
    RD_V(vA, va_, 2, HF); \
    if (qk_) SLICE(2); \
    if ((J) >> 1) { A_MFMA(o2[1], pa[1], PKV(vB[2], vB[3])); } else { A_MFMA(o1[1], pa[1], PKV(vB[2], vB[3])); } \
    if (qk_) SLICE(3); \
      \
    if ((J) == 2) { asm volatile("s_waitcnt vmcnt(0)" ::: "memory"); __syncthreads(); if (t + 2 < NT) DMA_KV(t + 2); } \
    if (ld_) { if (xq_) { LOAD_KQ(0, kco[0] + kofs2_, J2); LOAD_KQ(1, kco[1] + kofs2_, J2); A_WAIT4(4, vA[0], vA[1], vA[2], vA[3]); } else { LOAD_K(0, kco[0] + kofs2_, J2); LOAD_K(1, kco[1] + kofs2_, J2); A_WAIT4(2, vA[0], vA[1], vA[2], vA[3]); } } \
    else { A_WAIT4(0, vA[0], vA[1], vA[2], vA[3]); } \
    if ((J) >> 1) { A_MFMA(o2[2], pa[0], PKV(vA[0], vA[1])); } else { A_MFMA(o1[2], pa[0], PKV(vA[0], vA[1])); } \
    RD_V(vB, va_, 3, HF); \
    if (qk_) SLICE(4); \
    if ((J) >> 1) { A_MFMA(o2[2], pa[1], PKV(vA[2], vA[3])); } else { A_MFMA(o1[2], pa[1], PKV(vA[2], vA[3])); } \
    if (qk_) SLICE(5); \
    A_WAIT4(0, vB[0], vB[1], vB[2], vB[3]); \
    if ((J) >> 1) { A_MFMA(o2[3], pa[0], PKV(vB[0], vB[1])); } else { A_MFMA(o1[3], pa[0], PKV(vB[0], vB[1])); } \
    if (qk_) SLICE(6); \
    if ((J) >> 1) { A_MFMA(o2[3], pa[1], PKV(vB[2], vB[3])); } else { A_MFMA(o1[3], pa[1], PKV(vB[2], vB[3])); } \
    if (qk_) { SLICE(7); PACK_PA(); if (J1 >> 1) l2 += lsum; else l1 += lsum; } \
  } while (0)
#define PHASE(ta_, tbx_, MODE) do { const int tb_ = (tbx_); if ((ta_) < tb_) { float lsum = 0.f; const int t = (ta_); const int kofs0_ = (t & 1) * 16384; \
      _Pragma("unroll") for (int d0 = 0; d0 < 4; ++d0) LOAD_KQ(d0, kco[d0] + kofs0_, 0); \
      A_WAIT4(0, kf[0], qf[0], kf[1], qf[1]); A_WAIT4(0, kf[2], qf[2], kf[3], qf[3]); \
      A_MFMA0(P, kf[0], qf[0]); A_MFMA(P, kf[1], qf[1]); A_MFMA(P, kf[2], qf[2]); A_MFMA(P, kf[3], qf[3]); \
      LOAD_KQ(0, kco[0] + kofs0_, 1); LOAD_KQ(1, kco[1] + kofs0_, 1); \
      A_PAD(); A_PAD(); \
      if (MODE) BIAS_P(t, 0); \
      SLICE(0); SLICE(1); SLICE(2); SLICE(3); SLICE(4); SLICE(5); SLICE(6); SLICE(7); \
      PACK_PA(); l1 += lsum; } \
    for (int tt = (ta_); tt < tb_ - 1; ++tt) { ITER(tt, 0, MODE, true, true); ITER(tt, 1, MODE, true, true); ITER(tt, 2, MODE, true, true); ITER(tt, 3, MODE, true, true); } \
    if ((ta_) < tb_) { ITER(tb_ - 1, 0, MODE, true, true); ITER(tb_ - 1, 1, MODE, true, true); ITER(tb_ - 1, 2, MODE, true, false); ITER(tb_ - 1, 3, MODE, false, false); } } while (0)
#define RESCALE(f_) do { A_PAD(); A_PAD(); A_PAD(); A_PAD(); _Pragma("unroll") for (int d = 0; d < 4; ++d) { o1[d] *= (f_); o2[d] *= (f_); } l1 *= (f_); l2 *= (f_); } while (0)
    int tA = (qw - 154 < 0) ? 0 : ((qw - 154) >> 6) + 1; if (tA > NT) tA = NT;
    int tB = (qw + 122 + 63) >> 6; if (tB > NT) tB = NT; if (tB < tA) tB = tA;
    PHASE(0, tA, 0);
    { const float f_ = __builtin_amdgcn_exp2f(bt[0]); RESCALE(f_); }
    PHASE(tA, tB, 1);
    { const float f_ = __builtin_amdgcn_exp2f(-bt[254]); RESCALE(f_); }
    PHASE(tB, NT, 0);
#undef PHASE
#undef RESCALE
#undef ITER
#undef DMA_KV
#undef ATT_GLDS
#undef TCLASS
#undef LOAD_KQ
#undef LOAD_K
#undef SLICE
#undef BIAS_P
#undef PACK_PA
#undef RD_V
    A_PAD(); A_PAD();
    { const int lane_e = lane_now(), r32e = lane_e & 31, hie = lane_e >> 5;
      LAS float* wse = (LAS float*)(lds + SP_WS) + wid * 64;
      l1 += __shfl_xor(l1, 32); l2 += __shfl_xor(l2, 32);
      if (hie == 0) { wse[r32e] = 1.0f / l1; wse[32 + r32e] = T.lam / l2; }
      LDS_WAIT();
      float gs[4];
#pragma unroll
      for (int d = 0; d < 4; ++d) gs[d] = T.gsub[32 * d + r32e] * (1.0f - LAM_INIT);
      bf16_t* Ow = T.Amix + (rowbase + q0 + wid * 32 + 4 * hie) * 1024 + 512 + h * 128 + r32e; asm volatile("" : "+v"(Ow));
#pragma unroll
      for (int r = 0; r < 16; ++r) { const int row = crow(r, hie); const float c1 = wse[row], c2 = wse[32 + row];
        float y[4], ss = 0.f;
#pragma unroll
        for (int d = 0; d < 4; ++d) { y[d] = o1[d][r] * c1 - o2[d][r] * c2; ss += y[d] * y[d]; }
        ss += __shfl_xor(ss, 1); ss += __shfl_xor(ss, 2); ss += __shfl_xor(ss, 4); ss += __shfl_xor(ss, 8); ss += __shfl_xor(ss, 16);
        const float rr = rsqrtf(ss * (1.0f / 128.0f) + EPS);
#pragma unroll
        for (int d = 0; d < 4; ++d) Ow[(size_t)((r & 3) + 8 * (r >> 2)) * 1024 + 32 * d] = (bf16_t)(cvt_pk_bf16(y[d] * rr * gs[d], 0.f) & 0xffffu); } }
    __syncthreads();
}
__device__ __forceinline__ void attn_unit3(LAS unsigned char* lds, const Tensors& T, int b, int h, int qb, const int wid_in) {
    const int lane = lane_now(), r32 = lane & 31, hi = lane >> 5; const int wid = __builtin_amdgcn_readfirstlane(wid_in); const int tid = wid * 64 + lane;
    const size_t rowbase = (size_t)b * SEQ; const int q0 = qb * QB;
    const unsigned char* Kh = (const unsigned char*)T.K + rowbase * 512 + h * 128; const bf16_t* Vh = T.V + rowbase * 512 + h * 128; const unsigned char* Qh = (const unsigned char*)T.Q + (rowbase + q0) * 512 + h * 128;
    LAS float* bt = (LAS float*)(lds + SP_BT); LAS float* wsf = (LAS float*)(lds + SP_WS) + wid * 64;
    unsigned ksrc, vsrc[2];
    { const int row = 8 * wid + (lane >> 3), ch = (lane & 7) ^ ((row >> 1) & 7); ksrc = (unsigned)(row * 512 + ch * 16); }
#pragma unroll
    for (int i = 0; i < 2; ++i) { const int p = wid * 2 + i;
        const int st = 2 * p + (lane >> 5), kk = (st >> 2) * 8 + ((lane & 31) >> 2), cc = (st & 3) * 32 + (lane & 3) * 8; vsrc[i] = (unsigned)(kk * 512 + cc) * 2u; }
    const unsigned ldsw = (unsigned)wid * 2048u;
#define ATT_GLDS(sbase, vo, ldsdst) do { unsigned keep_; asm volatile("s_mov_b32 %0, m0\n\ts_mov_b32 m0, %3\n\ts_nop 0\n\tglobal_load_lds_dwordx4 %1, %2\n\ts_mov_b32 m0, %0" \
        : "=&s"(keep_) : "v"(vo), "s"(sbase), "s"(ldsdst) : "memory"); } while (0)
    const unsigned ldsb_ = (unsigned)(uintptr_t)lds;
#define DMA_KV(t) do { const char* kg = (const char*)(Kh + (size_t)(t) * KVB * 512); const char* vg = (const char*)(Vh + (size_t)(t) * KVB * 512); const int kb_ = ((t) & 1) * 8192, vb_ = ((t) % 3) * 16384; \
    ATT_GLDS(kg, ksrc, (unsigned)__builtin_amdgcn_readfirstlane((int)(ldsb_ + P_K + kb_ + wid * 1024))); \
    _Pragma("unroll") for (int _i = 0; _i < 2; ++_i) { \
        ATT_GLDS(vg, vsrc[_i], (unsigned)__builtin_amdgcn_readfirstlane((int)(ldsb_ + P_V + vb_ + ldsw + _i * 1024))); } } while (0)
    { int lq = lane; asm volatile("" : "+v"(lq));
      const int r8 = lq >> 3;
#pragma unroll
      for (int i = 0; i < 4; ++i) { const int p = wid * 4 + i, row = 8 * i + r8, ch = (lq & 7) ^ ((row >> 1) & 7);
        __builtin_amdgcn_global_load_lds((const unsigned*)((const char*)Qh + (size_t)(32 * wid + row) * 512 + ch * 16), (LAS unsigned*)(lds + P_Q + p * 1024), 16, 0, 0); } }
    DMA_KV(0); DMA_KV(1);
    if (tid < 255) bt[tid] = T.btab[h * 256 + tid];
    int kco[4]; const int qdelta = (P_Q - P_K) + wid * 4096;
#pragma unroll
    for (int d0 = 0; d0 < 4; ++d0) { const int c = r32 * 128 + ((((d0 >> 1) * 4 + 2 * hi + (d0 & 1)) ^ ((r32 >> 1) & 7)) << 4); kco[d0] = (int)(uintptr_t)(lds + P_K) + c; }
    const int sca = 127, scb = 124;
    const int vb0 = (int)(uintptr_t)(lds + P_V) + v_rd_base(lane);
    f32x16 o1[4], o2[4];
#pragma unroll
    for (int d = 0; d < 4; ++d) { o1[d] = f32x16{}; o2[d] = f32x16{}; }
    float l1 = 0.f, l2 = 0.f;
    const int qw = q0 + wid * 32;
    f32x16 P; bf16x8 pa[2]; pg8::i32x8 kf, qf; unsigned pw[8]; s16x4 vA[4], vB[4];
#define TCLASS(t) ((64 * (t) <= qw - 154) ? 0 : ((64 * (t) >= qw + 122) ? 2 : 1))
#define LD8(addr, off) __builtin_shufflevector(*(const LAS pg8::i32x4v*)(uintptr_t)(unsigned)((addr) + (off)), *(const LAS pg8::i32x4v*)(uintptr_t)(unsigned)((addr##1) + (off)), 0, 1, 2, 3, 4, 5, 6, 7)
#define LOAD_K(ko, J2) do { const int ka0_ = kco[2 * ((J2) >> 1)] + (ko), ka0_1 = kco[2 * ((J2) >> 1) + 1] + (ko); kf = LD8(ka0_, ((J2) & 1) * 4096); } while (0)
#define LOAD_Q(J2) do { const int qa0_ = kco[2 * ((J2) >> 1)] + qdelta, qa0_1 = kco[2 * ((J2) >> 1) + 1] + qdelta; qf = LD8(qa0_, 0); } while (0)
#define A_QK(d) asm volatile("s_nop 1\n\tv_mfma_scale_f32_32x32x64_f8f6f4 %0, %1, %2, 0, %3, %4 op_sel_hi:[0,0,0]" : "=&v"(d) : "v"(kf), "v"(qf), "v"(sca), "v"(scb))
#define A_NAMEKQ() asm volatile("" : "+v"(kf), "+v"(qf))
#define SLICE(k) do { asm volatile("" : "+v"(P), "+v"(lsum)); const float a_ = __builtin_amdgcn_exp2f(P[2 * (k)]), b_ = __builtin_amdgcn_exp2f(P[2 * (k) + 1]); lsum += a_ + b_; pw[k] = cvt_pk_s(a_, b_); } while (0)
#define BIAS_P(t1, h1) do { const int rb_ = 64 * (t1) + 32 * (h1) - (qw + r32) + 127; _Pragma("unroll") for (int r = 0; r < 16; ++r) { const int i0 = rb_ + crow(r, hi); P[r] += bt[i0 < 0 ? 0 : (i0 > 254 ? 254 : i0)]; } } while (0)
#define PACK_PA() do { u32x4 w0_ = {pw[0], pw[1], pw[2], pw[3]}, w1_ = {pw[4], pw[5], pw[6], pw[7]}; pa[0] = __builtin_bit_cast(bf16x8, w0_); pa[1] = __builtin_bit_cast(bf16x8, w1_); } while (0)
#define RD_V(buf, vaddr, d0, hf) do { A_RDTR(buf[0], vaddr, v_rd_off(d0, 2 * (hf), 0)); A_RDTR(buf[1], vaddr, v_rd_off(d0, 2 * (hf), 1)); A_RDTR(buf[2], vaddr, v_rd_off(d0, 2 * (hf) + 1, 0)); A_RDTR(buf[3], vaddr, v_rd_off(d0, 2 * (hf) + 1, 1)); } while (0)
    asm volatile("s_waitcnt vmcnt(0)" ::: "memory");
    __syncthreads();
#define ITER(TT, J, MODE, QKF, LDF) do { const int t = (TT); \
    const int n_ = 4 * t + (J); constexpr int J1 = ((J) + 1) & 3, J2 = ((J) + 2) & 3, HF = (J) & 1; constexpr bool xq_ = ((J) & 1) == 0;     \
    const int t1_ = t + ((J) == 3 ? 1 : 0), t2_ = t + ((J) >= 2 ? 1 : 0); \
    const int va_ = vb0 + (t % 3) * 16384; float lsum = 0.f; constexpr bool qk_ = (QKF), ld_ = (LDF); (void)n_; (void)t1_; \
    const int kofs2_ = (t2_ & 1) * 8192; \
    RD_V(vA, va_, 0, HF); \
    if (qk_) { A_QK(P); } \
    RD_V(vB, va_, 1, HF); \
    A_WAIT4(4, vA[0], vA[1], vA[2], vA[3]); \
    if ((J) >> 1) { A_MFMA(o2[0], pa[0], PKV(vA[0], vA[1])); } else { A_MFMA(o1[0], pa[0], PKV(vA[0], vA[1])); } \
    if (qk_) { A_PAD(); if (MODE) BIAS_P(t1_, J1 & 1); SLICE(0); } \
    if ((J) >> 1) { A_MFMA(o2[0], pa[1], PKV(vA[2], vA[3])); } else { A_MFMA(o1[0], pa[1], PKV(vA[2], vA[3])); } \
    if (qk_) SLICE(1); \
    A_WAIT4(0, vB[0], vB[1], vB[2], vB[3]); \
    if (ld_ && (J) != 2) { LOAD_K(kofs2_, J2); if (xq_) LOAD_Q(J2); }       \
    if ((J) >> 1) { A_MFMA(o2[1], pa[0], PKV(vB[0], vB[1])); } else { A_MFMA(o1[1], pa[0], PKV(vB[0], vB[1])); } \
    RD_V(vA, va_, 2, HF); \
    if (qk_) SLICE(2); \
    if ((J) >> 1) { A_MFMA(o2[1], pa[1], PKV(vB[2], vB[3])); } else { A_MFMA(o1[1], pa[1], PKV(vB[2], vB[3])); } \
    if (qk_) SLICE(3); \
      \
    if ((J) == 2) { asm volatile("s_waitcnt vmcnt(0)" ::: "memory"); __syncthreads(); if (t + 2 < NT) DMA_KV(t + 2); } \
    if (ld_ && (J) == 2) { LOAD_K(kofs2_, J2); if (xq_) LOAD_Q(J2); } \
    A_WAIT4(0, vA[0], vA[1], vA[2], vA[3]); \
    if (ld_) A_NAMEKQ(); \
    if ((J) >> 1) { A_MFMA(o2[2], pa[0], PKV(vA[0], vA[1])); } else { A_MFMA(o1[2], pa[0], PKV(vA[0], vA[1])); } \
    RD_V(vB, va_, 3, HF); \
    if (qk_) SLICE(4); \
    if ((J) >> 1) { A_MFMA(o2[2], pa[1], PKV(vA[2], vA[3])); } else { A_MFMA(o1[2], pa[1], PKV(vA[2], vA[3])); } \
    if (qk_) SLICE(5); \
    A_WAIT4(0, vB[0], vB[1], vB[2], vB[3]); \
    if ((J) >> 1) { A_MFMA(o2[3], pa[0], PKV(vB[0], vB[1])); } else { A_MFMA(o1[3], pa[0], PKV(vB[0], vB[1])); } \
    if (qk_) SLICE(6); \
    if ((J) >> 1) { A_MFMA(o2[3], pa[1], PKV(vB[2], vB[3])); } else { A_MFMA(o1[3], pa[1], PKV(vB[2], vB[3])); } \
    if (qk_) { SLICE(7); PACK_PA(); if (J1 >> 1) l2 += lsum; else l1 += lsum; } \
  } while (0)
#define PHASE(ta_, tbx_, MODE) do { const int tb_ = (tbx_); if ((ta_) < tb_) { float lsum = 0.f; const int t = (ta_); const int kofs0_ = (t & 1) * 8192; \
      LOAD_K(kofs0_, 0); LOAD_Q(0); A_WAITL(0); A_NAMEKQ(); \
      A_QK(P); \
      LOAD_K(kofs0_, 1); A_WAITL(0); \
      A_PAD(); A_PAD(); A_PAD(); A_PAD(); A_NAMEKQ(); \
      if (MODE) BIAS_P(t, 0); \
      SLICE(0); SLICE(1); SLICE(2); SLICE(3); SLICE(4); SLICE(5); SLICE(6); SLICE(7); \
      PACK_PA(); l1 += lsum; } \
    for (int tt = (ta_); tt < tb_ - 1; ++tt) { ITER(tt, 0, MODE, true, true); ITER(tt, 1, MODE, true, true); ITER(tt, 2, MODE, true, true); ITER(tt, 3, MODE, true, true); } \
    if ((ta_) < tb_) { ITER(tb_ - 1, 0, MODE, true, true); ITER(tb_ - 1, 1, MODE, true, true); ITER(tb_ - 1, 2, MODE, true, false); ITER(tb_ - 1, 3, MODE, false, false); } } while (0)
#define RESCALE(f_) do { A_PAD(); A_PAD(); A_PAD(); A_PAD(); _Pragma("unroll") for (int d = 0; d < 4; ++d) { o1[d] *= (f_); o2[d] *= (f_); } l1 *= (f_); l2 *= (f_); } while (0)
    int tA = (qw - 154 < 0) ? 0 : ((qw - 154) >> 6) + 1; if (tA > NT) tA = NT;
    int tB = (qw + 122 + 63) >> 6; if (tB > NT) tB = NT; if (tB < tA) tB = tA;
    PHASE(0, tA, 0);
    { const float f_ = __builtin_amdgcn_exp2f(bt[0]); RESCALE(f_); }
    PHASE(tA, tB, 1);
    { const float f_ = __builtin_amdgcn_exp2f(-bt[254]); RESCALE(f_); }
    PHASE(tB, NT, 0);
#undef PHASE
#undef RESCALE
#undef ITER
#undef DMA_KV
#undef ATT_GLDS
#undef TCLASS
#undef LOAD_K
#undef LOAD_Q
#undef LD8
#undef A_QK
#undef A_NAMEKQ
#undef SLICE
#undef BIAS_P
#undef PACK_PA
#undef RD_V
    A_PAD(); A_PAD();
    { const int lane_e = lane_now(), r32e = lane_e & 31, hie = lane_e >> 5;
      LAS float* wse = (LAS float*)(lds + SP_WS) + wid * 64;
      l1 += __shfl_xor(l1, 32); l2 += __shfl_xor(l2, 32);
      if (hie == 0) { wse[r32e] = 1.0f / l1; wse[32 + r32e] = T.lam / l2; }
      LDS_WAIT();
      float gs[4];
#pragma unroll
      for (int d = 0; d < 4; ++d) gs[d] = T.gsub[32 * d + r32e] * (1.0f - LAM_INIT);
      bf16_t* Ow = T.Amix + (rowbase + q0 + wid * 32 + 4 * hie) * 1024 + 512 + h * 128 + r32e; asm volatile("" : "+v"(Ow));
#pragma unroll
      for (int r = 0; r < 16; ++r) { const int row = crow(r, hie); const float c1 = wse[row], c2 = wse[32 + row];
        float y[4], ss = 0.f;
#pragma unroll
        for (int d = 0; d < 4; ++d) { y[d] = o1[d][r] * c1 - o2[d][r] * c2; ss += y[d] * y[d]; }
        ss += __shfl_xor(ss, 1); ss += __shfl_xor(ss, 2); ss += __shfl_xor(ss, 4); ss += __shfl_xor(ss, 8); ss += __shfl_xor(ss, 16);
        const float rr = rsqrtf(ss * (1.0f / 128.0f) + EPS);
#pragma unroll
        for (int d = 0; d < 4; ++d) Ow[(size_t)((r & 3) + 8 * (r >> 2)) * 1024 + 32 * d] = (bf16_t)(cvt_pk_bf16(y[d] * rr * gs[d], 0.f) & 0xffffu); } }
    __syncthreads();
}
__device__ __forceinline__ void attn_unit5(LAS unsigned char* lds, const Tensors& T, int b, int h, int qb, const int wid_in, const int cv0) {
    const int lane = lane_now(), r32 = lane & 31, hi = lane >> 5; const int wid = __builtin_amdgcn_readfirstlane(wid_in); const int tid = wid * 64 + lane;
    const size_t rowbase = (size_t)b * SEQ; const int q0 = qb * QB;
    const unsigned char* Kh = (const unsigned char*)T.K + rowbase * 512 + h * 128; const bf16_t* Vh = T.V + rowbase * 512 + h * 128; const unsigned char* Qh = (const unsigned char*)T.Q + (rowbase + q0) * 512 + h * 128;
    LAS float* bt = (LAS float*)(lds + SP_BT); LAS float* wsf = (LAS float*)(lds + SP_WS) + wid * 64;
    unsigned ksrc, vsrc[2];
    { const int row = 8 * wid + (lane >> 3), ch = (lane & 7) ^ ((row >> 1) & 7); ksrc = (unsigned)(row * 512 + ch * 16); }
#pragma unroll
    for (int i = 0; i < 2; ++i) { const int p = wid * 2 + i;
        const int st = 2 * p + (lane >> 5), kk = (st >> 2) * 8 + ((lane & 31) >> 2), cc = (st & 3) * 32 + (lane & 3) * 8; vsrc[i] = (unsigned)(kk * 512 + cc) * 2u; }
    const unsigned ldsw = (unsigned)wid * 2048u;
#define ATT_GLDS(sbase, vo, ldsdst) do { unsigned keep_; asm volatile("s_mov_b32 %0, m0\n\ts_mov_b32 m0, %3\n\ts_nop 0\n\tglobal_load_lds_dwordx4 %1, %2\n\ts_mov_b32 m0, %0" \
        : "=&s"(keep_) : "v"(vo), "s"(sbase), "s"(ldsdst) : "memory"); } while (0)
    const unsigned ldsb_ = (unsigned)(uintptr_t)lds;
#define DMA_KV(t) do { const char* kg = (const char*)(Kh + (size_t)(t) * KVB * 512); const char* vg = (const char*)(Vh + (size_t)(t) * KVB * 512); const int kb_ = ((t) & 1) * 8192, vb_ = ((t) % 3) * 16384; \
    ATT_GLDS(kg, ksrc, (unsigned)__builtin_amdgcn_readfirstlane((int)(ldsb_ + P_K + kb_ + wid * 1024))); \
    _Pragma("unroll") for (int _i = 0; _i < 2; ++_i) { \
        ATT_GLDS(vg, vsrc[_i], (unsigned)__builtin_amdgcn_readfirstlane((int)(ldsb_ + P_V + vb_ + ldsw + _i * 1024))); } } while (0)
    constexpr int CVB = 114688;
    const int cgw = T.gw0 + wid, ce = cgw >> 6, ckq = cgw & 63;
    unsigned cvp0 = 0u, cvp1 = 0u, cvp2 = 0u, cvp3 = 0u;
#define CV_ACT(hs_) ((hs_) >= 0 && (hs_) < 31 && cv0 + (hs_) < 48)
#define CV_DMA(s__) do { const int s_ = (s__); const bool w2_ = s_ < 16; const int nc_ = w2_ ? s_ : s_ - 16, ldw_ = w2_ ? 1024 : 2048; \
      const char* cb_ = (const char*)(w2_ ? T.w2 + (size_t)ce * 1048576 : T.w1 + (size_t)ce * 2097152) + ((size_t)(ckq * 16) * ldw_ + nc_ * 64) * 4; \
      const int l_ = lane_now(); const unsigned vo_ = (unsigned)((l_ >> 4) * ldw_ * 4 + (l_ & 15) * 16); \
      _Pragma("unroll") for (int i_ = 0; i_ < 4; ++i_) ATT_GLDS(cb_ + (size_t)(4 * i_) * ldw_ * 4, vo_, (unsigned)__builtin_amdgcn_readfirstlane((int)(ldsb_ + CVB + wid * 4096 + i_ * 1024))); } while (0)
#define CV_CHUNK(c_, s__, DST) do { const int s_ = (s__); const int l_ = lane_now(); const bool w2_ = s_ < 16; const int nl_ = w2_ ? l_ : ((l_ < 32) ? 2 * l_ : 2 * (l_ - 32) + 1); \
      const float sc_ = w2_ ? 64.f : ((l_ < 32) ? 64.f * SWG_C : 64.f / SWG_C); const LAS float* p_ = (const LAS float*)(lds + CVB + wid * 4096) + (4 * (c_)) * 64 + nl_; \
      DST = cvt_pk4_fp8(sc_ * p_[0], sc_ * p_[64], sc_ * p_[128], sc_ * p_[192]); } while (0)
#define CV_STORE(s__) do { const int s_ = (s__); const int l_ = lane_now(); const bool w2_ = s_ < 16; const int nc_ = w2_ ? s_ : s_ - 16; \
      const int row1_ = (nc_ >> 2) * 256 + ((l_ < 32) ? (32 * (nc_ & 3) + l_) : (128 + 32 * (nc_ & 3) + l_ - 32)); \
      unsigned char* d_ = w2_ ? T.w2t + (size_t)ce * 1048576 + (size_t)(nc_ * 64 + l_) * 1024 + ckq * 16 : T.w1t + (size_t)ce * 2097152 + (size_t)row1_ * 1024 + ckq * 16; \
      *(u32x4*)d_ = (u32x4){cvp0, cvp1, cvp2, cvp3}; } while (0)
    { int lq = lane; asm volatile("" : "+v"(lq));
      const int r8 = lq >> 3;
#pragma unroll
      for (int i = 0; i < 4; ++i) { const int p = wid * 4 + i, row = 8 * i + r8, ch = (lq & 7) ^ ((row >> 1) & 7);
        __builtin_amdgcn_global_load_lds((const unsigned*)((const char*)Qh + (size_t)(32 * wid + row) * 512 + ch * 16), (LAS unsigned*)(lds + P_Q + p * 1024), 16, 0, 0); } }
    DMA_KV(0); DMA_KV(1);
    if (tid < 255) bt[tid] = T.btab[h * 256 + tid];
    int kco[4]; const int qdelta = (P_Q - P_K) + wid * 4096;
#pragma unroll
    for (int d0 = 0; d0 < 4; ++d0) { const int c = r32 * 128 + ((((d0 >> 1) * 4 + 2 * hi + (d0 & 1)) ^ ((r32 >> 1) & 7)) << 4); kco[d0] = (int)(uintptr_t)(lds + P_K) + c; }
    const int sca = 127, scb = 124;
    const int vb0 = (int)(uintptr_t)(lds + P_V) + v_rd_base(lane);
    f32x16 o1[4], o2[4];
#pragma unroll
    for (int d = 0; d < 4; ++d) { o1[d] = f32x16{}; o2[d] = f32x16{}; }
    float l1 = 0.f, l2 = 0.f;
    const int qw = q0 + wid * 32;
    f32x16 P; bf16x8 pa[2]; pg8::i32x8 kf, qf; unsigned pw[8]; s16x4 vA[4], vB[4];
#define TCLASS(t) ((64 * (t) <= qw - 154) ? 0 : ((64 * (t) >= qw + 122) ? 2 : 1))
#define LD8(addr, off) __builtin_shufflevector(*(const LAS pg8::i32x4v*)(uintptr_t)(unsigned)((addr) + (off)), *(const LAS pg8::i32x4v*)(uintptr_t)(unsigned)((addr##1) + (off)), 0, 1, 2, 3, 4, 5, 6, 7)
#define LOAD_K(ko, J2) do { const int ka0_ = kco[2 * ((J2) >> 1)] + (ko), ka0_1 = kco[2 * ((J2) >> 1) + 1] + (ko); kf = LD8(ka0_, ((J2) & 1) * 4096); } while (0)
#define LOAD_Q(J2) do { const int qa0_ = kco[2 * ((J2) >> 1)] + qdelta, qa0_1 = kco[2 * ((J2) >> 1) + 1] + qdelta; qf = LD8(qa0_, 0); } while (0)
#define A_QK(d) asm volatile("s_nop 1\n\tv_mfma_scale_f32_32x32x64_f8f6f4 %0, %1, %2, 0, %3, %4 op_sel_hi:[0,0,0]" : "=&v"(d) : "v"(kf), "v"(qf), "v"(sca), "v"(scb))
#define A_NAMEKQ() asm volatile("" : "+v"(kf), "+v"(qf))
#define SLICE(k) do { asm volatile("" : "+v"(P), "+v"(lsum)); const float a_ = __builtin_amdgcn_exp2f(P[2 * (k)]), b_ = __builtin_amdgcn_exp2f(P[2 * (k) + 1]); lsum += a_ + b_; pw[k] = cvt_pk_s(a_, b_); } while (0)
#define BIAS_P(t1, h1) do { const int rb_ = 64 * (t1) + 32 * (h1) - (qw + r32) + 127; _Pragma("unroll") for (int r = 0; r < 16; ++r) { const int i0 = rb_ + crow(r, hi); P[r] += bt[i0 < 0 ? 0 : (i0 > 254 ? 254 : i0)]; } } while (0)
#define PACK_PA() do { u32x4 w0_ = {pw[0], pw[1], pw[2], pw[3]}, w1_ = {pw[4], pw[5], pw[6], pw[7]}; pa[0] = __builtin_bit_cast(bf16x8, w0_); pa[1] = __builtin_bit_cast(bf16x8, w1_); } while (0)
#define RD_V(buf, vaddr, d0, hf) do { A_RDTR(buf[0], vaddr, v_rd_off(d0, 2 * (hf), 0)); A_RDTR(buf[1], vaddr, v_rd_off(d0, 2 * (hf), 1)); A_RDTR(buf[2], vaddr, v_rd_off(d0, 2 * (hf) + 1, 0)); A_RDTR(buf[3], vaddr, v_rd_off(d0, 2 * (hf) + 1, 1)); } while (0)
    asm volatile("s_waitcnt vmcnt(0)" ::: "memory");
    __syncthreads();
#define ITER(TT, J, MODE, QKF, LDF) do { const int t = (TT); \
    const int n_ = 4 * t + (J); constexpr int J1 = ((J) + 1) & 3, J2 = ((J) + 2) & 3, HF = (J) & 1; constexpr bool xq_ = ((J) & 1) == 0;     \
    const int t1_ = t + ((J) == 3 ? 1 : 0), t2_ = t + ((J) >= 2 ? 1 : 0); \
    const int va_ = vb0 + (t % 3) * 16384; float lsum = 0.f; constexpr bool qk_ = (QKF), ld_ = (LDF); (void)n_; (void)t1_; \
    const int kofs2_ = (t2_ & 1) * 8192; \
    RD_V(vA, va_, 0, HF); \
    if (qk_) { A_QK(P); } \
    RD_V(vB, va_, 1, HF); \
    A_WAIT4(4, vA[0], vA[1], vA[2], vA[3]); \
    if ((J) >> 1) { A_MFMA(o2[0], pa[0], PKV(vA[0], vA[1])); } else { A_MFMA(o1[0], pa[0], PKV(vA[0], vA[1])); } \
    if (qk_) { A_PAD(); if (MODE) BIAS_P(t1_, J1 & 1); SLICE(0); } \
    if ((J) >> 1) { A_MFMA(o2[0], pa[1], PKV(vA[2], vA[3])); } else { A_MFMA(o1[0], pa[1], PKV(vA[2], vA[3])); } \
    if (qk_) SLICE(1); \
    A_WAIT4(0, vB[0], vB[1], vB[2], vB[3]); \
    if (ld_ && (J) != 2) { LOAD_K(kofs2_, J2); if (xq_) LOAD_Q(J2); }       \
    if ((J) >> 1) { A_MFMA(o2[1], pa[0], PKV(vB[0], vB[1])); } else { A_MFMA(o1[1], pa[0], PKV(vB[0], vB[1])); } \
    RD_V(vA, va_, 2, HF); \
    if (qk_) SLICE(2); \
    if ((J) >> 1) { A_MFMA(o2[1], pa[1], PKV(vB[2], vB[3])); } else { A_MFMA(o1[1], pa[1], PKV(vB[2], vB[3])); } \
    if (qk_) SLICE(3); \
      \
    if ((J) == 2) { asm volatile("s_waitcnt vmcnt(0)" ::: "memory"); __syncthreads(); if (t + 2 < NT) DMA_KV(t + 2); } \
      \
    if ((J) == 3) { const int hs_ = t >> 1; if (!(t & 1)) { if (CV_ACT(hs_)) CV_DMA(cv0 + hs_); } \
        else if (CV_ACT(hs_)) { CV_CHUNK(0, cv0 + hs_, cvp0); CV_CHUNK(1, cv0 + hs_, cvp1); CV_CHUNK(2, cv0 + hs_, cvp2); CV_CHUNK(3, cv0 + hs_, cvp3); CV_STORE(cv0 + hs_); } } \
    if (ld_ && (J) == 2) { LOAD_K(kofs2_, J2); if (xq_) LOAD_Q(J2); } \
    A_WAIT4(0, vA[0], vA[1], vA[2], vA[3]); \
    if (ld_) A_NAMEKQ(); \
    if ((J) >> 1) { A_MFMA(o2[2], pa[0], PKV(vA[0], vA[1])); } else { A_MFMA(o1[2], pa[0], PKV(vA[0], vA[1])); } \
    RD_V(vB, va_, 3, HF); \
    if (qk_) SLICE(4); \
    if ((J) >> 1) { A_MFMA(o2[2], pa[1], PKV(vA[2], vA[3])); } else { A_MFMA(o1[2], pa[1], PKV(vA[2], vA[3])); } \
    if (qk_) SLICE(5); \
    A_WAIT4(0, vB[0], vB[1], vB[2], vB[3]); \
    if ((J) >> 1) { A_MFMA(o2[3], pa[0], PKV(vB[0], vB[1])); } else { A_MFMA(o1[3], pa[0], PKV(vB[0], vB[1])); } \
    if (qk_) SLICE(6); \
    if ((J) >> 1) { A_MFMA(o2[3], pa[1], PKV(vB[2], vB[3])); } else { A_MFMA(o1[3], pa[1], PKV(vB[2], vB[3])); } \
    if (qk_) { SLICE(7); PACK_PA(); if (J1 >> 1) l2 += lsum; else l1 += lsum; } \
  } while (0)
#define PHASE(ta_, tbx_, MODE) do { const int tb_ = (tbx_); if ((ta_) < tb_) { float lsum = 0.f; const int t = (ta_); const int kofs0_ = (t & 1) * 8192; \
      LOAD_K(kofs0_, 0); LOAD_Q(0); A_WAITL(0); A_NAMEKQ(); \
      A_QK(P); \
      LOAD_K(kofs0_, 1); A_WAITL(0); \
      A_PAD(); A_PAD(); A_PAD(); A_PAD(); A_NAMEKQ(); \
      if (MODE) BIAS_P(t, 0); \
      SLICE(0); SLICE(1); SLICE(2); SLICE(3); SLICE(4); SLICE(5); SLICE(6); SLICE(7); \
      PACK_PA(); l1 += lsum; } \
    for (int tt = (ta_); tt < tb_ - 1; ++tt) { ITER(tt, 0, MODE, true, true); ITER(tt, 1, MODE, true, true); ITER(tt, 2, MODE, true, true); ITER(tt, 3, MODE, true, true); } \
    if ((ta_) < tb_) { ITER(tb_ - 1, 0, MODE, true, true); ITER(tb_ - 1, 1, MODE, true, true); ITER(tb_ - 1, 2, MODE, true, false); ITER(tb_ - 1, 3, MODE, false, false); } } while (0)
#define RESCALE(f_) do { A_PAD(); A_PAD(); A_PAD(); A_PAD(); _Pragma("unroll") for (int d = 0; d < 4; ++d) { o1[d] *= (f_); o2[d] *= (f_); } l1 *= (f_); l2 *= (f_); } while (0)
    int tA = (qw - 154 < 0) ? 0 : ((qw - 154) >> 6) + 1; if (tA > NT) tA = NT;
    int tB = (qw + 122 + 63) >> 6; if (tB > NT) tB = NT; if (tB < tA) tB = tA;
    PHASE(0, tA, 0);
    { const float f_ = __builtin_amdgcn_exp2f(bt[0]); RESCALE(f_); }
    PHASE(tA, tB, 1);
    { const float f_ = __builtin_amdgcn_exp2f(-bt[254]); RESCALE(f_); }
    PHASE(tB, NT, 0);
#undef PHASE
#undef RESCALE
#undef ITER
#undef DMA_KV
#undef CV_ACT
#undef CV_DMA
#undef CV_CHUNK
#undef CV_STORE
#undef ATT_GLDS
#undef TCLASS
#undef LOAD_K
#undef LOAD_Q
#undef LD8
#undef A_QK
#undef A_NAMEKQ
#undef SLICE
#undef BIAS_P
#undef PACK_PA
#undef RD_V
    A_PAD(); A_PAD();
    { const int lane_e = lane_now(), r32e = lane_e & 31, hie = lane_e >> 5;
      LAS float* wse = (LAS float*)(lds + SP_WS) + wid * 64;
      l1 += __shfl_xor(l1, 32); l2 += __shfl_xor(l2, 32);
      if (hie == 0) { wse[r32e] = 1.0f / l1; wse[32 + r32e] = T.lam / l2; }
      LDS_WAIT();
      float gs[4];
#pragma unroll
      for (int d = 0; d < 4; ++d) gs[d] = T.gsub[32 * d + r32e] * (1.0f - LAM_INIT);
      bf16_t* Ow = T.Amix + (rowbase + q0 + wid * 32 + 4 * hie) * 1024 + 512 + h * 128 + r32e; asm volatile("" : "+v"(Ow));
#pragma unroll
      for (int r = 0; r < 16; ++r) { const int row = crow(r, hie); const float c1 = wse[row], c2 = wse[32 + row];
        float y[4], ss = 0.f;
#pragma unroll
        for (int d = 0; d < 4; ++d) { y[d] = o1[d][r] * c1 - o2[d][r] * c2; ss += y[d] * y[d]; }
        ss += __shfl_xor(ss, 1); ss += __shfl_xor(ss, 2); ss += __shfl_xor(ss, 4); ss += __shfl_xor(ss, 8); ss += __shfl_xor(ss, 16);
        const float rr = rsqrtf(ss * (1.0f / 128.0f) + EPS);
#pragma unroll
        for (int d = 0; d < 4; ++d) Ow[(size_t)((r & 3) + 8 * (r >> 2)) * 1024 + 32 * d] = (bf16_t)(cvt_pk_bf16(y[d] * rr * gs[d], 0.f) & 0xffffu); } }
    __syncthreads();
}
#undef SBAR
#undef PKV
}

__device__ __forceinline__ void tr_item(const float* W, int ldw, bf16_t* WT, int ldt, LAS float* scr, int lane) {
    float tv[32]; const float* wb = W + (size_t)(lane >> 5) * ldw + (lane & 31);
#pragma unroll
    for (int i = 0; i < 32; ++i) tv[i] = wb[(size_t)(2 * i) * ldw];
#pragma unroll
    for (int i = 0; i < 32; ++i) scr[(2 * i + (lane >> 5)) * 33 + (lane & 31)] = tv[i];
    LDS_WAIT(); asm volatile("" ::: "memory");
    const int c = lane & 7;
#pragma unroll
    for (int j = 0; j < 4; ++j) { const int n = (lane >> 3) + 8 * j; const LAS float* s = scr + (8 * c) * 33 + n;
        u32x4 o; o.x = cvt_pk_bf16(s[0 * 33], s[1 * 33]); o.y = cvt_pk_bf16(s[2 * 33], s[3 * 33]); o.z = cvt_pk_bf16(s[4 * 33], s[5 * 33]); o.w = cvt_pk_bf16(s[6 * 33], s[7 * 33]);
        *(u32x4*)(WT + (size_t)n * ldt + 8 * c) = o; }
    LDS_WAIT(); asm volatile("" ::: "memory");
}
__device__ __forceinline__ bf16x8 pack8v(f32x4 a, f32x4 b) { const u32x4 w = {att::cvt_pk_s(a[0], a[1]), att::cvt_pk_s(a[2], a[3]), att::cvt_pk_s(b[0], b[1]), att::cvt_pk_s(b[2], b[3])}; return __builtin_bit_cast(bf16x8, w); }
__device__ __forceinline__ void tr_item_fp8(const float* W, int ldw, unsigned char* WT, int ldt, LAS float* scr, int lane) {
    float tv[32]; const float* wb = W + (size_t)(lane >> 5) * ldw + (lane & 31);
#pragma unroll
    for (int i = 0; i < 32; ++i) tv[i] = wb[(size_t)(2 * i) * ldw];
#pragma unroll
    for (int i = 0; i < 32; ++i) scr[(2 * i + (lane >> 5)) * 33 + (lane & 31)] = tv[i];
    LDS_WAIT(); asm volatile("" ::: "memory");
    const int n = lane & 31, kh = (lane >> 5) * 32; const LAS float* s = scr + kh * 33 + n;
#pragma unroll
    for (int q = 0; q < 2; ++q) { u32x4 o;
        o.x = cvt_pk4_fp8(64.f * s[(16 * q + 0) * 33], 64.f * s[(16 * q + 1) * 33], 64.f * s[(16 * q + 2) * 33], 64.f * s[(16 * q + 3) * 33]);
        o.y = cvt_pk4_fp8(64.f * s[(16 * q + 4) * 33], 64.f * s[(16 * q + 5) * 33], 64.f * s[(16 * q + 6) * 33], 64.f * s[(16 * q + 7) * 33]);
        o.z = cvt_pk4_fp8(64.f * s[(16 * q + 8) * 33], 64.f * s[(16 * q + 9) * 33], 64.f * s[(16 * q + 10) * 33], 64.f * s[(16 * q + 11) * 33]);
        o.w = cvt_pk4_fp8(64.f * s[(16 * q + 12) * 33], 64.f * s[(16 * q + 13) * 33], 64.f * s[(16 * q + 14) * 33], 64.f * s[(16 * q + 15) * 33]);
        *(u32x4*)(WT + (size_t)n * ldt + kh + 16 * q) = o; }
    LDS_WAIT(); asm volatile("" ::: "memory");
}
__device__ __forceinline__ int qk_logical(int p) { return 64 * ((p >> 5) & 3) + 32 * (p >> 7) + (p & 31); }

__device__ __forceinline__ int t5_bucket_idx(int rel) {
    const int ret = rel > 0 ? 16 : 0; const int n = rel < 0 ? -rel : rel;
    const float nf = (float)(n < 1 ? 1 : n);
    int large = 8 + (int)(logf(nf / 8.0f) / logf(16.0f) * 8.0f); large = large < 15 ? large : 15;
    if (n == 16) large = 10; if (n == 32) large = 12; if (n == 64) large = 14;
    return ret + (n < 8 ? n : large);
}

constexpr int P0_SCR = 16640;
constexpr int P0_CTAB = 8 * P0_SCR;
__device__ __forceinline__ float cos4096(const LAS float* tab, int m) { m &= 4095; if (m > 2048) m = 4096 - m; return (m <= 1024) ? tab[m] : -tab[2048 - m]; }
#define P0_WLOAD(v, r) do { const float* src_; int ld_; { int rr_ = (r); if (rr_ < I_W2) { const int e = rr_ >> 8, kc = (rr_ >> 4) & 15, nc = rr_ & 15; src_ = F.w2 + (size_t)e * 1048576 + (size_t)(kc * 64) * 1024 + nc * 64 + lane; ld_ = 1024; } \
        else { rr_ -= I_W2; const int e = rr_ >> 9, kc = (rr_ >> 5) & 15, nc = rr_ & 31; src_ = F.w1 + (size_t)e * 2097152 + (size_t)(kc * 64) * 2048 + nc * 64 + lane; ld_ = 2048; } } \
        _Pragma("unroll") for (int kk = 0; kk < 64; ++kk) v[kk] = __builtin_nontemporal_load(src_ + (size_t)kk * ld_); } while (0)
#define P0_WPROC(v, r) do { unsigned char* dst_; int nl_; float ws_ = 64.f; { int rr_ = (r); if (rr_ < I_W2) { const int e = rr_ >> 8, kc = (rr_ >> 4) & 15, nc = rr_ & 15; nl_ = lane; dst_ = wsp<unsigned char>(F, WS_W2) + (size_t)e * 1048576 + (size_t)(nc * 64 + lane) * 1024 + kc * 64; } \
        else { rr_ -= I_W2; const int e = rr_ >> 9, kc = (rr_ >> 5) & 15, nc = rr_ & 31, pn = nc >> 2, p0 = 32 * (nc & 3); nl_ = (lane < 32) ? 2 * lane : 2 * (lane - 32) + 1; ws_ = (lane < 32) ? 64.f * SWG_C : 64.f / SWG_C;     \
               dst_ = wsp<unsigned char>(F, WS_W1) + (size_t)e * 2097152 + (size_t)(pn * 256 + ((lane < 32) ? (p0 + lane) : (128 + p0 + lane - 32))) * 1024 + kc * 64; } } \
        _Pragma("unroll") for (int kk = 0; kk < 64; ++kk) scr[kk * 65 + lane] = v[kk]; \
        LDS_WAIT(); asm volatile("" ::: "memory"); \
        _Pragma("unroll") for (int q = 0; q < 4; ++q) { const LAS float* s_ = scr + (16 * q) * 65 + nl_; u32x4 o_; \
            o_.x = cvt_pk4_fp8(ws_ * s_[0], ws_ * s_[65], ws_ * s_[130], ws_ * s_[195]); o_.y = cvt_pk4_fp8(ws_ * s_[260], ws_ * s_[325], ws_ * s_[390], ws_ * s_[455]); \
            o_.z = cvt_pk4_fp8(ws_ * s_[520], ws_ * s_[585], ws_ * s_[650], ws_ * s_[715]); o_.w = cvt_pk4_fp8(ws_ * s_[780], ws_ * s_[845], ws_ * s_[910], ws_ * s_[975]); \
            *(u32x4*)(dst_ + 16 * q) = o_; } \
        LDS_WAIT(); asm volatile("" ::: "memory"); } while (0)
__device__ __forceinline__ void p0_prologue(Frame& F, const int skip) {
    LAS float* scr = (LAS float*)(F.lds + F.wave * P0_SCR);
    LAS float* ctab = (LAS float*)(F.lds + P0_CTAB);
    for (int m = F.tid(); m < 1025; m += 512) ctab[m] = cospif((float)m * (1.0f / 2048.0f));
    __syncthreads();
    const int NGW = F.G * NWAVES, lane = F.lane();
    const int gw = F.wave * F.G + F.vcu;
    constexpr int I_MOD = 96, I_QKV = 16 * 48, I_WOUT = 8 * 32, I_FCS = 256, I_FOUT = 256, I_ADFT = 4096, I_MISC = 65;
    constexpr int NITEMS = I_MOD + I_QKV + I_WOUT + I_FCS + I_FOUT + I_MISC + I_ADFT;
    constexpr int I_W2 = 32 * 16 * 16, I_W1 = 32 * 16 * 32, NW12 = I_W2 + I_W1;
    float* mod = wsp<float>(F, WS_MOD);
    const int lane0 = lane;
    const bool coop = (F.G >= I_MOD);
    if (coop && !(skip & 16) && F.vcu < I_MOD) {
        const int col = F.vcu * 64 + lane; float acc[8];
#pragma unroll
        for (int b = 0; b < 8; ++b) acc[b] = 0.f;
#pragma unroll 1
        for (int kc = 2 * F.wave; kc < 2 * F.wave + 2; ++kc) {
            float wv[64]; int ln = lane; asm volatile("" : "+v"(ln));
            const float* wb = F.w_ada + (size_t)(kc * 64) * 6144 + F.vcu * 64 + ln;
#pragma unroll
            for (int kk = 0; kk < 64; ++kk) wv[kk] = __builtin_nontemporal_load(wb + (size_t)kk * 6144);
#pragma unroll
            for (int b = 0; b < 8; ++b) { const float cv = F.c[b * 1024 + kc * 64 + ln]; scr[ln * 8 + b] = cv / (1.0f + __expf(-cv)); }
            LDS_WAIT(); asm volatile("" ::: "memory");
#pragma unroll
            for (int kk = 0; kk < 64; ++kk) { const float w = wv[kk];
                const f32x4 s0 = *(const LAS f32x4*)(scr + kk * 8), s1 = *(const LAS f32x4*)(scr + kk * 8 + 4);
                acc[0] += s0[0] * w; acc[1] += s0[1] * w; acc[2] += s0[2] * w; acc[3] += s0[3] * w; acc[4] += s1[0] * w; acc[5] += s1[1] * w; acc[6] += s1[2] * w; acc[7] += s1[3] * w; }
            LDS_WAIT(); asm volatile("" ::: "memory");
        }
#pragma unroll
        for (int b = 0; b < 8; ++b) scr[b * 64 + lane] = acc[b];
        __syncthreads();
        { const int t_ = F.tid(), b_ = t_ >> 6, c_ = t_ & 63; float sum = F.b_ada[F.vcu * 64 + c_];
#pragma unroll
          for (int w = 0; w < 8; ++w) sum += ((const LAS float*)(F.lds + w * P0_SCR))[b_ * 64 + c_];
          mod[b_ * 6144 + F.vcu * 64 + c_] = sum; }
        __syncthreads();
    }
    const int it0 = coop ? I_MOD : 0;
    if (!(skip & 16)) for (int it = gw + it0; it < NITEMS; it += NGW) {
        int r = it;
        int lane = lane0; asm volatile("" : "+v"(lane));
        if (r < I_MOD) {
            const int col = r * 64 + lane; float acc[8];
#pragma unroll
            for (int b = 0; b < 8; ++b) acc[b] = 0.f;
            for (int kc = 0; kc < 16; ++kc) {
                float wv[64];
#pragma unroll
                for (int kk = 0; kk < 64; ++kk) wv[kk] = __builtin_nontemporal_load(F.w_ada + (size_t)(kc * 64 + kk) * 6144 + col);
#pragma unroll
                for (int b = 0; b < 8; ++b) { const float cv = F.c[b * 1024 + kc * 64 + lane]; scr[lane * 8 + b] = cv / (1.0f + __expf(-cv)); }
                LDS_WAIT(); asm volatile("" ::: "memory");
#pragma unroll
                for (int kk = 0; kk < 64; ++kk) { const float w = wv[kk];
                    const f32x4 s0 = *(const LAS f32x4*)(scr + kk * 8), s1 = *(const LAS f32x4*)(scr + kk * 8 + 4);
                    acc[0] += s0[0] * w; acc[1] += s0[1] * w; acc[2] += s0[2] * w; acc[3] += s0[3] * w; acc[4] += s1[0] * w; acc[5] += s1[1] * w; acc[6] += s1[2] * w; acc[7] += s1[3] * w; }
                LDS_WAIT(); asm volatile("" ::: "memory");
            }
            const float bb = F.b_ada[col];
#pragma unroll
            for (int b = 0; b < 8; ++b) mod[b * 6144 + col] = acc[b] + bb;
            continue; }
        r -= I_MOD;
        if (r < I_QKV) {
            const int kb = r / 48, nb = r % 48, prow = nb * 32, tile = prow >> 8, p = prow & 255;
            const int lcol = 512 + tile * 256 + p;
            tr_item_fp8(F.w_in + (size_t)(kb * 64) * 2048 + lcol, 2048, wsp<unsigned char>(F, WS_WQKV) + (size_t)prow * 1024 + kb * 64, 1024, scr, lane);
            continue; }
        r -= I_QKV;
        if (r < I_WOUT) {
            const int kb = r / 32, nb = r % 32;
            tr_item(F.w_out + (size_t)(512 + kb * 64) * 1024 + nb * 32, 1024, wsp<bf16_t>(F, WS_WOUT) + (size_t)(nb * 32) * 1024 + 512 + kb * 64, 1024, scr, lane);
            continue; }
        r -= I_WOUT;
        if (r < I_FCS) {
            const int g = r >> 6, d0 = (r & 63) * 16, m = lane & 15, g4 = lane >> 4;
            LAS float* t128 = scr;
            t128[lane] = cos4096(ctab, lane * 32); t128[64 + lane] = cos4096(ctab, (64 + lane) * 32); t128[128 + lane] = cos4096(ctab, lane * 32); t128[192 + lane] = cos4096(ctab, (64 + lane) * 32);
            bf16x8 bw[4];
#pragma unroll
            for (int ks = 0; ks < 4; ++ks) { const float* p = F.w_in + (size_t)(d0 + m) * 2048 + g * 128 + ks * 32 + g4 * 8; bw[ks] = pack8v(*(const f32x4*)p, *(const f32x4*)(p + 4)); }
            LDS_WAIT(); asm volatile("" ::: "memory");
            const float sc = 0.08838834764831845f;
            bf16_t* wc = wsp<bf16_t>(F, WS_WCS);
#pragma unroll 1
            for (int mb = 0; mb < 16; ++mb) { const int kc = (mb & 7) * 16 + m; const LAS float* tb = t128 + ((mb >> 3) ? 96 : 0);
                f32x4 acc = {0.f, 0.f, 0.f, 0.f};
#pragma unroll
                for (int ks = 0; ks < 4; ++ks) { float v[8];
#pragma unroll
                    for (int j = 0; j < 8; ++j) v[j] = tb[((ks * 32 + g4 * 8 + j) * kc) & 127];
                    const bf16x8 a = pack8v((f32x4){v[0], v[1], v[2], v[3]}, (f32x4){v[4], v[5], v[6], v[7]});
                    acc = __builtin_amdgcn_mfma_f32_16x16x32_bf16(a, bw[ks], acc, 0, 0, 0); }
                const float sg = (mb >> 3) ? -sc : sc;
#pragma unroll
                for (int i = 0; i < 4; ++i) { const int n = (mb >> 3) * 512 + g * 128 + (mb & 7) * 16 + g4 * 4 + i;
                    wc[(size_t)n * 1024 + d0 + m] = (bf16_t)(cvt_pk_bf16(acc[i] * sg, 0.f) & 0xffffu); } }
            LDS_WAIT(); asm volatile("" ::: "memory");
            continue; }
        r -= I_FCS;
        if (r < I_FOUT) {
            const int g = r >> 6, dout0 = (r & 63) * 16, m = lane & 15, g4 = lane >> 4;
            bf16x8 bo[4];
#pragma unroll
            for (int ks = 0; ks < 4; ++ks) { const float* p = F.w_out + (size_t)(g * 128 + ks * 32 + g4 * 8) * 1024 + dout0 + m; float v[8];
#pragma unroll
                for (int j = 0; j < 8; ++j) v[j] = p[(size_t)j * 1024];
                bo[ks] = pack8v((f32x4){v[0], v[1], v[2], v[3]}, (f32x4){v[4], v[5], v[6], v[7]}); }
            bf16_t* dst = wsp<bf16_t>(F, WS_WOUT) + (size_t)(dout0 + m) * 1024 + g * 128 + g4 * 4;
#pragma unroll 2
            for (int mb = 0; mb < 8; ++mb) { const float* p = F.w_fourier + (size_t)(g * 128 + mb * 16 + m) * 128 + g4 * 8;
                f32x4 acc = {0.f, 0.f, 0.f, 0.f};
#pragma unroll
                for (int ks = 0; ks < 4; ++ks) { const bf16x8 a = pack8v(*(const f32x4*)(p + ks * 32), *(const f32x4*)(p + ks * 32 + 4));
                    acc = __builtin_amdgcn_mfma_f32_16x16x32_bf16(a, bo[ks], acc, 0, 0, 0); }
                u32x2 o; o.x = att::cvt_pk_s(acc[0], acc[1]); o.y = att::cvt_pk_s(acc[2], acc[3]);
                *(u32x2*)(dst + mb * 16) = o; }
            continue; }
        r -= I_FOUT;
        if (r < I_MISC) {
            if (r == 0) { float* bt = wsp<float>(F, WS_BTAB);
                for (int i = lane; i < 4 * 256; i += 64) { const int h = i >> 8, ri = i & 255; const int rel = (ri > 254 ? 254 : ri) - 127; bt[i] = F.rel_bias[t5_bucket_idx(rel) * 4 + h] * LOG2E; } }
            else { float* bp = wsp<float>(F, WS_B1P); const int base = (r - 1) * 1024;
                for (int i = lane; i < 1024; i += 64) { const int idx = base + i, e = idx >> 11, pc = idx & 2047, pn = pc >> 8, p = pc & 255;
                    const float bv_ = F.b1[e * 2048 + pn * 256 + (p < 128 ? 2 * p : 2 * (p - 128) + 1)]; bp[idx] = (p < 128) ? SWG_C * bv_ : (bv_ + 1.0f) / SWG_C; } }
            continue; }
        r -= I_MISC;
        {
            const int k = r; unsigned char* row = wsp<unsigned char>(F, WS_ADFT) + (size_t)k * 4096;
#pragma unroll
            for (int ch = 0; ch < 4; ++ch) { const int j0 = ch * 1024 + lane * 16; float v[16];
#pragma unroll
                for (int e = 0; e < 16; ++e) { const int j = j0 + e;
                    if (ch < 2) v[e] = __builtin_amdgcn_cosf((float)((k * j) & 4095) * (1.0f / 4096.0f));
                    else { const float sv = __builtin_amdgcn_sinf((float)((k * (j - 2048)) & 4095) * (1.0f / 4096.0f)); v[e] = (j == 2048) ? ((k & 1) ? -1.0f : 1.0f) : sv; } }
                u32x4 o; o.x = cvt_pk4_fp8(v[0], v[1], v[2], v[3]); o.y = cvt_pk4_fp8(v[4], v[5], v[6], v[7]); o.z = cvt_pk4_fp8(v[8], v[9], v[10], v[11]); o.w = cvt_pk4_fp8(v[12], v[13], v[14], v[15]);
                *(u32x4*)(row + j0) = o; }
        }
    }
    if (!(skip & 8) && F.G != 256) {
        constexpr int NHEAVY = I_MOD, HQ = 5;
        const bool heavy = (F.G == 256) && (gw < I_MOD);
        int r, stride, rend;
        if (F.G != 256) { r = gw; stride = NGW; rend = NW12; }
        else if (heavy) { r = gw; stride = NHEAVY; rend = NHEAVY * HQ; }
        else { r = NHEAVY * HQ + (gw - NHEAVY); stride = 2048 - NHEAVY; rend = NW12; }
        float va[64], vb[64];
        if (r < rend) P0_WLOAD(va, r);
        for (; r < rend; r += 2 * stride) {
            const int r1 = r + stride, r2 = r1 + stride;
            if (r1 < rend) P0_WLOAD(vb, r1);
            P0_WPROC(va, r);
            if (r2 < rend) P0_WLOAD(va, r2);
            if (r1 < rend) P0_WPROC(vb, r1);
        }
    }
}
#undef P0_WLOAD
#undef P0_WPROC

__device__ __forceinline__ void load_row(const float* xrow, int lane, f32x4 (&h)[4]) {
#pragma unroll
    for (int j = 0; j < 4; ++j) h[j] = *((const f32x4*)xrow + lane + 64 * j);
}
__device__ __forceinline__ void load_row_bf16(const bf16_t* xrow, int lane, f32x4 (&h)[4]) {
#pragma unroll
    for (int j = 0; j < 4; ++j) { const u32x2 w = *((const u32x2*)xrow + lane + 64 * j); h[j] = (f32x4){__uint_as_float(w.x << 16), __uint_as_float(w.x & 0xffff0000u), __uint_as_float(w.y << 16), __uint_as_float(w.y & 0xffff0000u)}; }
}
__device__ __forceinline__ void norm_row(const float* g, const float* sh, const float* sc, int lane, f32x4 (&h)[4]) {
    float s = 0.f;
#pragma unroll
    for (int j = 0; j < 4; ++j) s += (h[j][0] * h[j][0] + h[j][1] * h[j][1]) + (h[j][2] * h[j][2] + h[j][3] * h[j][3]);
    const float rr = rsqrtf(wave_sum(s) * (1.0f / 1024.0f) + EPS);
#pragma unroll
    for (int j = 0; j < 4; ++j) { const f32x4 gv = *((const f32x4*)g + lane + 64 * j), sv = *((const f32x4*)sc + lane + 64 * j), hv = *((const f32x4*)sh + lane + 64 * j);
        h[j] = h[j] * rr * gv * (sv + 1.0f) + hv; }
}
__device__ __forceinline__ void store_row_fp8(unsigned char* row, int lane, const f32x4 (&h)[4]) {
#pragma unroll
    for (int j = 0; j < 4; ++j) *((unsigned*)row + lane + 64 * j) = cvt_pk4_fp8(h[j][0], h[j][1], h[j][2], h[j][3]);
}
__device__ __forceinline__ void store_row_bf16(bf16_t* row, int lane, const f32x4 (&h)[4]) {
#pragma unroll
    for (int j = 0; j < 4; ++j) { u32x2 w; w.x = cvt_pk_bf16(h[j][0], h[j][1]); w.y = cvt_pk_bf16(h[j][2], h[j][3]); *((u32x2*)row + lane + 64 * j) = w; }
}
constexpr int P1_GEMV = 512, P1_NITEMS = P1_GEMV + NB * (HSEQ + 1);
__device__ __forceinline__ void p1_decode(int w, int& b, int& j) { if (w < P1_GEMV) { b = w >> 6; j = HSEQ; } else { w -= P1_GEMV; b = w / (HSEQ + 1); j = w % (HSEQ + 1); } }
__device__ __forceinline__ void p1_rows(Frame& F) {
    const int gw = F.vcu * NWAVES + F.wave, NGW = F.G * NWAVES, lane = F.lane();
    const float* mod = wsp<float>(F, WS_MOD);
    bf16_t* XN = wsp<bf16_t>(F, WS_XN); bf16_t* XS = wsp<bf16_t>(F, WS_XNSA); bf16_t* XA = XS + (size_t)NB * HSEQ * 1024;
    f32x4 h0[4], h1[4], n0[4], n1[4];
    int w = gw;
    if (w < P1_NITEMS) { int b, j; p1_decode(w, b, j); load_row(F.x + ((size_t)b * SEQ + j) * 1024, lane, h0); load_row(F.x + ((size_t)b * SEQ + ((SEQ - j) & (SEQ - 1))) * 1024, lane, h1); }
    for (; w < P1_NITEMS; w += NGW) {
        const int wn = w + NGW;
        if (wn < P1_NITEMS) { int b, j; p1_decode(wn, b, j); load_row(F.x + ((size_t)b * SEQ + j) * 1024, lane, n0); load_row(F.x + ((size_t)b * SEQ + ((SEQ - j) & (SEQ - 1))) * 1024, lane, n1); }
        int b, j; p1_decode(w, b, j);
        const float* sh = mod + b * 6144; const float* sc = sh + 1024;
        norm_row(F.g_mix, sh, sc, lane, h0);
        if (w < P1_GEMV) {
            const int nb = (w & 63) * 8; const bf16_t* wc = wsp<bf16_t>(F, WS_WCS) + (size_t)nb * 1024; float* vr = wsp<float>(F, WS_VR);
            float sacc[8];
#pragma unroll
            for (int n = 0; n < 8; ++n) { float sv = 0.f;
#pragma unroll
                for (int q = 0; q < 4; ++q) { const u32x2 wv = *((const u32x2*)(wc + (size_t)n * 1024) + lane + 64 * q);
                    sv += h0[q][0] * __uint_as_float(wv.x << 16) + h0[q][1] * __uint_as_float(wv.x & 0xffff0000u) + h0[q][2] * __uint_as_float(wv.y << 16) + h0[q][3] * __uint_as_float(wv.y & 0xffff0000u); }
                sacc[n] = sv; }
#pragma unroll
            for (int n = 0; n < 8; ++n) { const float t = wave_sum(sacc[n]); if (lane == 0) vr[b * 512 + nb + n] = t; }
        } else {
            store_row_fp8((unsigned char*)XN + ((size_t)b * SEQ + j) * 1024, lane, h0);
            if (j == 0) {
                store_row_bf16(XS + ((size_t)b * HSEQ) * 1024, lane, h0);
                f32x4 z[4];
#pragma unroll
                for (int q = 0; q < 4; ++q) z[q] = (f32x4){0.f, 0.f, 0.f, 0.f};
                store_row_bf16(XA + ((size_t)b * HSEQ) * 1024, lane, z);
            } else if (j != HSEQ) {
                f32x4 t[4];
                norm_row(F.g_mix, sh, sc, lane, h1);
                store_row_fp8((unsigned char*)XN + ((size_t)b * SEQ + (SEQ - j)) * 1024, lane, h1);
#pragma unroll
                for (int q = 0; q < 4; ++q) t[q] = h0[q] + h1[q];
                store_row_bf16(XS + ((size_t)b * HSEQ + j) * 1024, lane, t);
#pragma unroll
                for (int q = 0; q < 4; ++q) t[q] = h0[q] - h1[q];
                store_row_bf16(XA + ((size_t)b * HSEQ + j) * 1024, lane, t);
            }
        }
#pragma unroll
        for (int q = 0; q < 4; ++q) { h0[q] = n0[q]; h1[q] = n1[q]; }
    }
}

__device__ __forceinline__ void moe_tables(Frame& F) {
    LAS int* cnt = (LAS int*)(F.lds + SP_CNT); LAS int* tstart = (LAS int*)(F.lds + SP_TSTART); LAS unsigned char* tile_e = F.lds + SP_TILEE;
    int tid = F.tid(); asm volatile("" : "+v"(tid));
    __syncthreads();
    if (tid < 32) cnt[tid] = (int)__hip_atomic_load(F.ctl + CW_GCNT + 64 * tid, RLX_AGENT);
    __syncthreads();
    if (tid == 0) { int s = 0; for (int e = 0; e < 32; ++e) { tstart[e] = s; s += (cnt[e] + 255) >> 8; } tstart[32] = s; tstart[33] = s; }
    __syncthreads();
    const int total = tstart[32];
    for (int pm = tid; pm < total; pm += 512) { int e = 0;
        for (int q = 1; q < 32; ++q) e += (pm >= tstart[q]) ? 1 : 0;
        tile_e[pm] = (unsigned char)e; }
    __syncthreads();
}

constexpr int SP_LCNT = SP_OFF + 5120, SP_LBASE = SP_OFF + 5376, SP_STASH = SP_OFF + 6144;
constexpr int P5_HI = 0, P5_LO = 65536, P5_GM = 131072, P5_SH = 135168, P5_BP = 139264, P5_BIAS = 141312;
__device__ __forceinline__ void p5_router(Frame& F) {
    const int lane = F.lane(), tid = F.tid();
    const int trow0 = F.vcu * 128 + F.wave * 16, bq = trow0 >> 12;
    const int m = lane & 15, g = lane >> 4;
    const bf16_t* X1 = wsp<bf16_t>(F, WS_X1);
    u32x4 xv[16][2];
    { const u32x4* xr = (const u32x4*)(X1 + (size_t)(trow0 + m) * 1024 + g * 16);
#pragma unroll
      for (int s = 0; s < 16; ++s) { xv[s][0] = xr[s * 8]; xv[s][1] = xr[s * 8 + 1]; } }
    const float* mod = wsp<float>(F, WS_MOD);
    const float* shf = mod + bq * 6144 + 3072; const float* scf = mod + bq * 6144 + 4096;
    LAS float* gm = (LAS float*)(F.lds + P5_GM); LAS float* sh = (LAS float*)(F.lds + P5_SH); LAS float* bpart = (LAS float*)(F.lds + P5_BP); LAS float* bias = (LAS float*)(F.lds + P5_BIAS);
    LAS int* lcnt = (LAS int*)(F.lds + SP_LCNT); LAS int* lbase = (LAS int*)(F.lds + SP_LBASE); LAS int* stash = (LAS int*)(F.lds + SP_STASH);
    float wr_[8][8];
    { const float* wp_ = F.w_router + (size_t)((tid >> 5) * 8) * 32 + (tid & 31);
#pragma unroll
      for (int it = 0; it < 8; ++it)
#pragma unroll
          for (int j = 0; j < 8; ++j) wr_[it][j] = wp_[(size_t)(it * 128 + j) * 32]; }
    for (int k = tid; k < 1024; k += 512) { gm[k] = F.g_ffn[k] * (1.0f + scf[k]); sh[k] = shf[k]; }
    if (tid < 32) lcnt[tid] = 0;
    __syncthreads();
    { const int e = tid & 31; float bp = 0.f;
#pragma unroll
      for (int it = 0; it < 8; ++it) { const int c = (tid >> 5) + 16 * it; const float (&w)[8] = wr_[it];
          const f32x4 g0 = *(const LAS f32x4*)(gm + c * 8), g1 = *(const LAS f32x4*)(gm + c * 8 + 4), s0 = *(const LAS f32x4*)(sh + c * 8), s1 = *(const LAS f32x4*)(sh + c * 8 + 4);
          u32x4 hi, lo;
#pragma unroll
          for (int p = 0; p < 4; ++p) { const f32x4 gq = (p < 2) ? g0 : g1, sq = (p < 2) ? s0 : s1; const float ga = gq[(2 * p) & 3], gb = gq[(2 * p + 1) & 3], sa = sq[(2 * p) & 3], sb = sq[(2 * p + 1) & 3];
              const float a = w[2 * p] * ga, b2 = w[2 * p + 1] * gb; const unsigned hh = cvt_pk_bf16(a, b2);
              hi[p] = hh; lo[p] = cvt_pk_bf16(a - __uint_as_float(hh << 16), b2 - __uint_as_float(hh & 0xffff0000u));
              bp += w[2 * p] * sa + w[2 * p + 1] * sb; }
          *(LAS u32x4*)(F.lds + P5_HI + (c * 32 + e) * 16) = hi; *(LAS u32x4*)(F.lds + P5_LO + (c * 32 + e) * 16) = lo; }
      bpart[(tid >> 5) * 32 + e] = bp; }
    __syncthreads();
    if (tid < 32) { float sb = F.b_router[tid];
#pragma unroll
        for (int q = 0; q < 16; ++q) sb += bpart[q * 32 + tid];
        bias[tid] = sb; }
    __syncthreads();
    f32x4 ah0 = {0.f, 0.f, 0.f, 0.f}, ah1 = ah0, al0 = ah0, al1 = ah0; float ss = 0.f;
    { const LAS unsigned char* tb = F.lds + g * 1024 + m * 16;
#pragma unroll
      for (int s = 0; s < 16; ++s) {
#pragma unroll
          for (int h = 0; h < 2; ++h) { const bf16x8 xb = __builtin_bit_cast(bf16x8, xv[s][h]); const LAS unsigned char* p = tb + s * 4096 + h * 512; asm volatile("" : "+v"(p));
              const bf16x8 wh0 = *(const LAS bf16x8*)(p + P5_HI), wh1 = *(const LAS bf16x8*)(p + P5_HI + 256), wl0 = *(const LAS bf16x8*)(p + P5_LO), wl1 = *(const LAS bf16x8*)(p + P5_LO + 256);
              ah0 = __builtin_amdgcn_mfma_f32_16x16x32_bf16(wh0, xb, ah0, 0, 0, 0); ah1 = __builtin_amdgcn_mfma_f32_16x16x32_bf16(wh1, xb, ah1, 0, 0, 0);
              al0 = __builtin_amdgcn_mfma_f32_16x16x32_bf16(wl0, xb, al0, 0, 0, 0); al1 = __builtin_amdgcn_mfma_f32_16x16x32_bf16(wl1, xb, al1, 0, 0, 0);
#pragma unroll
              for (int q = 0; q < 4; ++q) { const unsigned wv = xv[s][h][q]; const float lo_ = __uint_as_float(wv << 16), hi_ = __uint_as_float(wv & 0xffff0000u); ss += lo_ * lo_ + hi_ * hi_; } } } }
    ss += __shfl_xor(ss, 16); ss += __shfl_xor(ss, 32);
    const float rinv = rsqrtf(ss * (1.0f / 1024.0f) + EPS);
    { unsigned char* xo = wsp<unsigned char>(F, WS_XN2) + (size_t)(trow0 + m) * 1024 + g * 16;
#pragma unroll
      for (int s = 0; s < 16; ++s) { const LAS f32x4* gp = (const LAS f32x4*)(gm + s * 64 + g * 16); const LAS f32x4* sp = (const LAS f32x4*)(sh + s * 64 + g * 16); asm volatile("" : "+v"(gp), "+v"(sp)); u32x4 o; u32x4 xq[2] = {xv[s][0], xv[s][1]}; asm volatile("" : "+v"(xq[0]), "+v"(xq[1]));
#pragma unroll
          for (int q = 0; q < 4; ++q) { const f32x4 gv = gp[q], sv = sp[q]; const unsigned w0 = xq[q >> 1][(q & 1) * 2], w1 = xq[q >> 1][(q & 1) * 2 + 1];
              o[q] = cvt_pk4_fp8(__uint_as_float(w0 << 16) * rinv * gv[0] + sv[0], __uint_as_float(w0 & 0xffff0000u) * rinv * gv[1] + sv[1],
                                 __uint_as_float(w1 << 16) * rinv * gv[2] + sv[2], __uint_as_float(w1 & 0xffff0000u) * rinv * gv[3] + sv[3]); }
          *(u32x4*)(xo + s * 64) = o; } }
    float vals[8];
    { const f32x4 b0 = *(const LAS f32x4*)(bias + g * 4), b1 = *(const LAS f32x4*)(bias + 16 + g * 4);
#pragma unroll
      for (int j = 0; j < 4; ++j) { vals[j] = (ah0[j] + al0[j]) * rinv + b0[j]; vals[4 + j] = (ah1[j] + al1[j]) * rinv + b1[j]; } }
    float tv[4]; int tx[4];
#pragma unroll
    for (int t = 0; t < 4; ++t) { float bv = vals[0]; int be = g * 4;
#pragma unroll
        for (int j = 1; j < 8; ++j) { const bool take = vals[j] > bv; bv = take ? vals[j] : bv; be = take ? ((j >> 2) * 16 + g * 4 + (j & 3)) : be; }
#pragma unroll
        for (int o = 16; o < 64; o <<= 1) { const float ov = __shfl_xor(bv, o); const int oe = __shfl_xor(be, o); const bool take = (ov > bv) || (ov == bv && oe < be); bv = take ? ov : bv; be = take ? oe : be; }
        tv[t] = bv; tx[t] = be;
#pragma unroll
        for (int j = 0; j < 8; ++j) vals[j] = (be == (j >> 2) * 16 + g * 4 + (j & 3)) ? -INFINITY : vals[j]; }
    { const float e1 = __expf(tv[1] - tv[0]), e2 = __expf(tv[2] - tv[0]), e3 = __expf(tv[3] - tv[0]); const float inv = 1.0f / (1.0f + e1 + e2 + e3);
      const int e = (g == 0) ? tx[0] : (g == 1) ? tx[1] : (g == 2) ? tx[2] : tx[3];
      const float gk = ((g == 0) ? 1.0f : (g == 1) ? e1 : (g == 2) ? e2 : e3) * inv;
      const int lr = atomicAdd((int*)(lcnt + e), 1);
      const int si = ((F.wave * 16 + m) * 4 + g) * 4; stash[si] = (trow0 + m) * 4 + g; stash[si + 1] = e; stash[si + 2] = lr; stash[si + 3] = __float_as_int(gk); }
    __syncthreads();
    if (tid < 32) lbase[tid] = (int)__hip_atomic_fetch_add(F.ctl + CW_GCNT + 64 * tid, (unsigned)lcnt[tid], RLX_AGENT);
    __syncthreads();
    { const int si = tid * 4; const int tk = stash[si], e = stash[si + 1], slot = lbase[e] + stash[si + 2];
      wsp<unsigned>(F, WS_SLOTTOK)[(size_t)e * CAP + slot] = (unsigned)(tk >> 2);
      wsp<int>(F, WS_SLOTGATE)[(size_t)e * CAP + slot] = stash[si + 3];
      wsp<unsigned>(F, WS_TOKSLOT)[tk] = (unsigned)(e * CAP + slot); }
}

__device__ __forceinline__ void p8_combine(Frame& F) {
    const int lane = F.lane(); const LAS int* tstart = (const LAS int*)(F.lds + SP_TSTART);
    const float* mod = wsp<float>(F, WS_MOD); const bf16_t* slab = wsp<bf16_t>(F, WS_SLAB); const unsigned* ts = wsp<unsigned>(F, WS_TOKSLOT);
    const int trow0 = F.vcu * 128 + F.wave * 16, b = trow0 >> 12;
    int myrow[4];
    { const u32x4 sl = *(const u32x4*)(ts + (size_t)(trow0 + (lane & 15)) * 4);
#pragma unroll
      for (int k = 0; k < 4; ++k) { const unsigned v = sl[k]; myrow[k] = tstart[v >> 15] * 256 + (int)(v & 32767u); } }
    f32x4 gt[4];
#pragma unroll
    for (int j = 0; j < 4; ++j) gt[j] = *((const f32x4*)(mod + b * 6144 + 5120) + lane + 64 * j) * (1.0f / 16.0f);
#define P8_LOAD(rl, SV, XV) do { _Pragma("unroll") for (int k = 0; k < 4; ++k) { const size_t ar = (size_t)__shfl(myrow[k], (rl)) * 1024; \
        _Pragma("unroll") for (int j = 0; j < 4; ++j) SV[k][j] = *((const unsigned*)((const unsigned char*)slab + ar) + lane + 64 * j); } \
        _Pragma("unroll") for (int j = 0; j < 4; ++j) XV[j] = *((const u32x2*)(X1 + (size_t)(trow0 + (rl)) * 1024) + lane + 64 * j); } while (0)
#define P8_PROC(rl, SV, XV) do { _Pragma("unroll") for (int j = 0; j < 4; ++j) { f32x4 s = (f32x4){0.f, 0.f, 0.f, 0.f}; \
        _Pragma("unroll") for (int k = 0; k < 4; ++k) { const unsigned wv = SV[k][j]; const f32x2 lo = __builtin_amdgcn_cvt_pk_f32_fp8(wv, false), hi = __builtin_amdgcn_cvt_pk_f32_fp8(wv, true); s[0] += lo[0]; s[1] += lo[1]; s[2] += hi[0]; s[3] += hi[1]; } \
        const f32x4 xv_ = (f32x4){__uint_as_float(XV[j].x << 16), __uint_as_float(XV[j].x & 0xffff0000u), __uint_as_float(XV[j].y << 16), __uint_as_float(XV[j].y & 0xffff0000u)}; \
        *((f32x4*)(F.out + (size_t)(trow0 + (rl)) * 1024) + lane + 64 * j) = xv_ + gt[j] * s; } } while (0)
    unsigned sa[4][4], sb[4][4]; u32x2 xa[4], xb[4]; const bf16_t* X1 = wsp<bf16_t>(F, WS_X1);
    P8_LOAD(0, sa, xa);
    for (int rl = 0; rl < 16; rl += 2) {
        P8_LOAD(rl + 1, sb, xb);
        P8_PROC(rl, sa, xa);
        if (rl + 2 < 16) P8_LOAD(rl + 2, sa, xa);
        P8_PROC(rl + 1, sb, xb);
    }
#undef P8_LOAD
#undef P8_PROC
}

constexpr int NPHASE = 9;
struct Args { const float* in[23]; float* out; unsigned char* ws; int ph_lo, ph_hi, skip, pad; };
__global__ void __launch_bounds__(NWAVES * 64, 2) mk_fwd(Args args) {
    extern __shared__ __attribute__((aligned(16))) unsigned char lds_[];
    Frame F;
    F.lds = (LAS unsigned char*)lds_;
    F.MISC = (volatile LAS unsigned*)(F.lds + SP_MISC);
    F.wave = __builtin_amdgcn_readfirstlane((int)(threadIdx.x >> 6));
    F.G = gridDim.x; { const int bx = blockIdx.x; F.vcu = (F.G % 8 == 0) ? (bx % 8) * (F.G / 8) + bx / 8 : bx; }
    F.ws = args.ws; F.ctl = (unsigned*)(args.ws + WS_CTL); F.out = args.out;
    F.x = args.in[0]; F.c = args.in[1]; F.w_ada = args.in[2]; F.b_ada = args.in[3]; F.g_mix = args.in[4]; F.w_in = args.in[5]; F.w_fourier = args.in[6];
    F.q_norm_g = args.in[7]; F.k_norm_g = args.in[8]; F.lq1 = args.in[9]; F.lk1 = args.in[10]; F.lq2 = args.in[11]; F.lk2 = args.in[12]; F.g_subln = args.in[13];
    F.w_out = args.in[14]; F.rel_bias = args.in[15]; F.g_ffn = args.in[16]; F.w_router = args.in[17]; F.b_router = args.in[18]; F.w1 = args.in[19]; F.b1 = args.in[20];
    F.w2 = args.in[21]; F.b2 = args.in[22];
    if (F.tid() < 64) ((LAS unsigned*)(F.lds + SP_MISC))[F.tid()] = 0u;
    __syncthreads();
    const int lo = args.ph_lo, hi = args.ph_hi;
    XcdBarrier bar; bar.bar = F.ctl + CW_BAR; bar.x = 0; bar.st = nullptr;
    if (hi - lo > 1) bar = xcd_barrier_post(F.ctl + CW_BAR, F.MISC + 8);
#ifndef PH_MASK
#define PH_MASK 0x1ff
#endif
#define IN(k) (((PH_MASK >> (k)) & 1) && lo <= (k) && (k) < hi)
#define SEAM(k) do { if (IN(k) && IN((k) + 1)) xcd_barrier(bar); if (MK_TIMER >= 0 && F.tid() == 0) ((volatile LAS unsigned long long*)(F.lds + SP_OFF + 15360))[(k) + 1] = __builtin_amdgcn_s_memrealtime(); } while (0)
    const int cblk = (int)blockIdx.x;
    if (MK_TIMER >= 0 && F.tid() == 0) ((volatile LAS unsigned long long*)(F.lds + SP_OFF + 15360))[0] = __builtin_amdgcn_s_memrealtime();

    if (IN(0)) { p0_prologue(F, args.skip); }
    SEAM(0);
    if (IN(1)) { p1_rows(F); }
    SEAM(1);
    if (IN(2)) {
        { SchedPlain S{(const char*)wsp<bf16_t>(F, WS_XN), (const char*)wsp<bf16_t>(F, WS_WQKV), NTOK / 256, NQKV / 256, F.G, cblk, (size_t)256 * 1024};
          EpiQKV E{wsp<bf16_t>(F, WS_Q), wsp<bf16_t>(F, WS_K), wsp<bf16_t>(F, WS_V), F.q_norm_g, F.k_norm_g};
          pg8::gemm_phase<EpiQKV, SchedPlain, true, 124>(F.lds, 1024, S, E, F.wave); }
        { SchedFourier S{(const char*)wsp<bf16_t>(F, WS_WCS), (const char*)wsp<bf16_t>(F, WS_XNSA), F.G, cblk, (size_t)256 * 1024 * 2};
          EpiFourier E{wsp<bf16_t>(F, WS_BDFT), wsp<float>(F, WS_VR)};
          pg8::gemm_phase<EpiFourier, SchedFourier>(F.lds, 2048, S, E, F.wave); }
    }
    SEAM(2);
    if (IN(3)) {
        float lam;
        { const float a = F.lq1[F.lane()] * F.lk1[F.lane()], b = F.lq2[F.lane()] * F.lk2[F.lane()]; lam = __expf(wave_sum(a)) - __expf(wave_sum(b)) + LAM_INIT; lam = __uint_as_float((unsigned)__builtin_amdgcn_readfirstlane((int)__float_as_uint(lam))); }
        att::Tensors T{wsp<bf16_t>(F, WS_Q), wsp<bf16_t>(F, WS_K), wsp<bf16_t>(F, WS_V), wsp<bf16_t>(F, WS_AMIX), wsp<float>(F, WS_BTAB), F.g_subln, lam, F.w1, F.w2, wsp<unsigned char>(F, WS_W1), wsp<unsigned char>(F, WS_W2), F.vcu * 8};
        if (!(args.skip & 1)) for (int L = F.vcu; L < NB * 4 * (SEQ / att::QB); L += F.G) { const int bh = L >> 4, qb = L & 15; att::attn_unit5(F.lds, T, bh >> 2, bh & 3, qb, F.wave, (F.G == 256) ? ((L - F.vcu) / F.G) * 31 : 4096); }
        if (!(args.skip & 2)) { SchedPlain S{(const char*)wsp<bf16_t>(F, WS_ADFT), (const char*)wsp<bf16_t>(F, WS_BDFT), 16, 16, F.G, cblk, (size_t)256 * 4096};
          EpiDft E{wsp<bf16_t>(F, WS_AMIX)};
          pg8::gemm_phase<EpiDft, SchedPlain, true, 124>(F.lds, 4096, S, E, F.wave); }
    }
    SEAM(3);
    if (IN(4)) {
        SchedPlain S{(const char*)wsp<bf16_t>(F, WS_AMIX), (const char*)wsp<bf16_t>(F, WS_WOUT), NTOK / 256, 4, F.G, cblk, (size_t)256 * 1024 * 2};
        EpiOut E{F.x, wsp<float>(F, WS_MOD), wsp<bf16_t>(F, WS_X1)};
        pg8::gemm_phase<EpiOut, SchedPlain>(F.lds, 2048, S, E, F.wave);
    }
    SEAM(4);
    if (IN(5)) { p5_router(F); }
    SEAM(5);
    if (IN(6)) {
        moe_tables(F);
        const LAS int* tstart = (const LAS int*)(F.lds + SP_TSTART);
        SchedMoe<true> S{(const char*)wsp<bf16_t>(F, WS_XN2), (const char*)wsp<bf16_t>(F, WS_W1), tstart[32], 8, F.G, cblk, 0, (size_t)256 * 1024, (size_t)2048 * 1024,
                         F.lds + SP_TILEE, tstart, (const LAS int*)(F.lds + SP_CNT), wsp<unsigned>(F, WS_SLOTTOK)};
        EpiSwiglu E{wsp<bf16_t>(F, WS_ACT), wsp<float>(F, WS_B1P), F.lds + SP_TILEE};
        pg8::gemm_phase<EpiSwiglu, SchedMoe<true>, true, 124>(F.lds, 1024, S, E, F.wave);
    }
    SEAM(6);
    if (IN(7)) {
        if (lo == 7) moe_tables(F);
        const LAS int* tstart = (const LAS int*)(F.lds + SP_TSTART);
        SchedMoe<false> S{(const char*)wsp<bf16_t>(F, WS_ACT), (const char*)wsp<bf16_t>(F, WS_W2), tstart[32], 4, F.G, cblk, (size_t)256 * 1024, (size_t)256 * 1024, (size_t)1024 * 1024,
                          F.lds + SP_TILEE, tstart, (const LAS int*)(F.lds + SP_CNT), wsp<unsigned>(F, WS_SLOTTOK)};
        EpiDown E{wsp<bf16_t>(F, WS_SLAB), F.b2, wsp<float>(F, WS_SLOTGATE), F.lds + SP_TILEE, tstart};
        pg8::gemm_phase<EpiDown, SchedMoe<false>, true, 124>(F.lds, 1024, S, E, F.wave);
    }
    SEAM(7);
    if (IN(8)) { if (lo == 8) moe_tables(F); p8_combine(F); }
    if (MK_TIMER >= 0) { __syncthreads(); if (blockIdx.x == 0 && F.tid() == 0) { volatile LAS unsigned long long* ts = (volatile LAS unsigned long long*)(F.lds + SP_OFF + 15360); ts[9] = __builtin_amdgcn_s_memrealtime();
        const int k = MK_TIMER < 9 ? MK_TIMER : 0; const unsigned long long d = (MK_TIMER < 9) ? (ts[k + 1] - ts[k]) : (ts[9] - ts[0]); const float us = (float)d * 0.01f; const float q = us > 100.f ? 16.f : 4.f; F.out[0] = q * floorf(us / q + 0.5f); } }
#undef IN
#undef SEAM
}

extern "C" void kernel_launch(void* const* d_in, const int* in_sizes, int n_in, void* d_out, int out_size, void* d_ws, size_t ws_size, hipStream_t stream) {
    static int grid = 0;
    if (grid == 0) {
        if (n_in != 23 || in_sizes[0] != NTOK * DM || out_size != NTOK * DM || ws_size < WS_END) {
            fprintf(stderr, "kernel_launch: unexpected shapes: n_in %d in0 %d out %d ws %zu (need >= %zu)\n", n_in, n_in > 0 ? in_sizes[0] : -1, out_size, ws_size, (size_t)WS_END); grid = -1; return; }
        int dev = 0, cus = 0, per_cu = 0;
        if (hipGetDevice(&dev) != hipSuccess || hipDeviceGetAttribute(&cus, hipDeviceAttributeMultiprocessorCount, dev) != hipSuccess) { fprintf(stderr, "kernel_launch: device query failed\n"); grid = -1; return; }
        if (hipFuncSetAttribute((const void*)mk_fwd, hipFuncAttributeMaxDynamicSharedMemorySize, LDS_BYTES) != hipSuccess) { fprintf(stderr, "kernel_launch: hipFuncSetAttribute failed\n"); grid = -1; return; }
        if (hipOccupancyMaxActiveBlocksPerMultiprocessor(&per_cu, (const void*)mk_fwd, NWAVES * 64, LDS_BYTES) != hipSuccess || per_cu < 1) { fprintf(stderr, "kernel_launch: occupancy query says %d blocks per CU\n", per_cu); grid = -1; (void)hipGetLastError(); return; }
        grid = cus;
        if (grid % 8 != 0 || grid < 8) fprintf(stderr, "kernel_launch: note: %d CUs\n", grid);
    }
    if (grid < 0) return;
    if (hipMemsetAsync((char*)d_ws + WS_CTL, 0, CTL_ZERO_BYTES, stream) != hipSuccess) { fprintf(stderr, "kernel_launch: memset failed\n"); return; }
    Args a{};
    for (int i = 0; i < 23; ++i) a.in[i] = (const float*)d_in[i];
    a.out = (float*)d_out; a.ws = (unsigned char*)d_ws;
#if MK_SPLIT
    for (int p = 0; p < NPHASE; ++p) { a.ph_lo = p; a.ph_hi = p + 1; a.skip = 0; hipLaunchKernelGGL(mk_fwd, dim3(grid), dim3(NWAVES * 64), LDS_BYTES, stream, a);
        if (p == MK_PROBE) { a.skip = MK_PROBE_SKIP; hipLaunchKernelGGL(mk_fwd, dim3(grid), dim3(NWAVES * 64), LDS_BYTES, stream, a); } }
#else
    a.ph_lo = 0; a.ph_hi = NPHASE;
    void* kargs[] = {(void*)&a};
    const hipError_t le = hipLaunchCooperativeKernel((const void*)mk_fwd, dim3(grid), dim3(NWAVES * 64), kargs, LDS_BYTES, stream);
    if (le != hipSuccess) fprintf(stderr, "kernel_launch: cooperative launch failed: %s (grid %d)\n", hipGetErrorName(le), grid);
#endif
}
```
